# Optimizing an MI355X kernel written in HIP

```python
import jax, jax.numpy as jnp
from jax import lax
import numpy as np

D_MODEL = 1024
BATCH = 8
SEQ = 4096
DEPTH = 4

POOL_WINDOWS = (2, 4, 8, 16)
POOL_GROUPS = len(POOL_WINDOWS)
POOL_WIDTH = D_MODEL // 2
POOL_GW = POOL_WIDTH // POOL_GROUPS
N_HEADS = 16
HEAD_DIM = 64
N_KV_GROUPS = 2
HPG = N_HEADS // N_KV_GROUPS
NSA_WIDTH = N_HEADS * HEAD_DIM
KV_WIDTH = N_KV_GROUPS * HEAD_DIM
CMP_LEN = 32
CMP_STRIDE = 16
CMP_HIDDEN = 256
SEL_BLOCK = 64
N_SEL = 16
WINDOW = 512
Q_BLOCK = 64
SEL_BONUS = 1e4
NEG_INF = -1e30
ROPE_THETA = 10000.0
D_FF = 4 * D_MODEL
RMS_EPS = 1e-6
IN_SIZES = (POOL_WIDTH, NSA_WIDTH, KV_WIDTH, KV_WIDTH, KV_WIDTH, KV_WIDTH, KV_WIDTH, KV_WIDTH, 3 * N_HEADS, 2 * D_MODEL)
N_IN = sum(IN_SIZES)
IN_SPLITS = tuple(int(v) for v in np.cumsum(IN_SIZES)[:-1])

kernel_name = 'hybrid_pool_nsa_gated_trunk'


def rms_norm(x, g):
    xf = x.astype(jnp.float32)
    y = xf * lax.rsqrt(jnp.mean(xf * xf, axis=-1, keepdims=True) + RMS_EPS)
    return (y * g.astype(jnp.float32)).astype(x.dtype)


def rope_tables(pos):
    inv = ROPE_THETA ** (-jnp.arange(0, HEAD_DIM, 2, dtype=jnp.float32) / HEAD_DIM)
    ang = pos.astype(jnp.float32)[:, None] * inv[None, :]
    ang = jnp.concatenate([ang, ang], axis=-1)
    return jnp.cos(ang), jnp.sin(ang)


def apply_rope(x, cos, sin):
    x1, x2 = jnp.split(x, 2, axis=-1)
    rot = jnp.concatenate([-x2, x1], axis=-1)
    y = x.astype(jnp.float32) * cos[:, None, :] + rot.astype(jnp.float32) * sin[:, None, :]
    return y.astype(x.dtype)


def masked_softmax(s, mask):
    s = jnp.where(mask, s.astype(jnp.float32), NEG_INF)
    return jnp.where(mask, jax.nn.softmax(s, axis=-1), 0.0)


def pool_mixer(u, w_pool, pool_scale):
    B, S, _ = u.shape
    uf = u.astype(jnp.float32)
    csum = jnp.pad(jnp.cumsum(uf, axis=1), ((0, 0), (1, 0), (0, 0)))
    t = jnp.arange(S)
    diffs = []
    for g, w in enumerate(POOL_WINDOWS):
        c = csum[:, :, g * POOL_GW:(g + 1) * POOL_GW]
        upper = c[:, 1:]
        lower = jnp.pad(c, ((0, 0), (w - 1, 0), (0, 0)))[:, :S]
        count = jnp.minimum(t + 1, w).astype(jnp.float32)[None, :, None]
        diffs.append((upper - lower) / count - uf[:, :, g * POOL_GW:(g + 1) * POOL_GW])
    d = jnp.stack(diffs, axis=2)
    y = jnp.einsum('bsgc,gcd->bsgd', d, w_pool.astype(jnp.float32)).reshape(B, S, POOL_WIDTH)
    return (y * pool_scale.astype(jnp.float32)).astype(u.dtype)


def compress(k, pe, w1, w2):
    B, S, G, dh = k.shape
    r = CMP_LEN // CMP_STRIDE
    n_chunks = S // CMP_STRIDE
    n_cmp = n_chunks - r + 1
    ch = k.reshape(B, n_chunks, CMP_STRIDE, G, dh)
    blocks = jnp.concatenate([ch[:, j:j + n_cmp] for j in range(r)], axis=2)
    blocks = blocks + pe[None, None, :, None, :]
    flat = blocks.transpose(0, 1, 3, 2, 4).reshape(B, n_cmp, G, CMP_LEN * dh)
    return jax.nn.gelu(flat @ w1) @ w2


def nsa_mixer(q, kc, vc, ks, vs, kw, vw, g_nsa, pe_k, pe_v, w_ck1, w_ck2, w_cv1, w_cv2):
    B, S = q.shape[:2]
    G, dh = N_KV_GROUPS, HEAD_DIM
    cos, sin = rope_tables(jnp.arange(S))
    q = apply_rope(q.reshape(B, S, N_HEADS, dh), cos, sin).reshape(B, S, G, HPG, dh)
    ks = apply_rope(ks.reshape(B, S, G, dh), cos, sin)
    kw = apply_rope(kw.reshape(B, S, G, dh), cos, sin)
    vs = vs.reshape(B, S, G, dh)
    vw = vw.reshape(B, S, G, dh)
    k_cmp = compress(kc.reshape(B, S, G, dh), pe_k, w_ck1, w_ck2)
    v_cmp = compress(vc.reshape(B, S, G, dh), pe_v, w_cv1, w_cv2)
    n_cmp = k_cmp.shape[1]
    cmp_start = jnp.arange(n_cmp) * CMP_STRIDE
    cmp_end = cmp_start + CMP_LEN - 1
    ccos, csin = rope_tables(cmp_end)
    k_cmp = apply_rope(k_cmp, ccos, csin)
    n_slc = S // SEL_BLOCK
    k_blk = ks.reshape(B, n_slc, SEL_BLOCK, G, dh).transpose(0, 3, 1, 2, 4)
    v_blk = vs.reshape(B, n_slc, SEL_BLOCK, G, dh).transpose(0, 3, 1, 2, 4)
    slc_start = jnp.arange(n_slc) * SEL_BLOCK
    slc_idx = jnp.arange(n_slc)
    overlap = ((cmp_start[:, None] <= slc_start[None, :] + SEL_BLOCK - 1)
               & (cmp_end[:, None] >= slc_start[None, :])).astype(jnp.float32)
    n_pick = min(N_SEL, n_slc)
    gather_blocks = jax.vmap(jax.vmap(lambda kb, i: kb[i]))
    win_len = Q_BLOCK + WINDOW - 1
    kw_pad = jnp.pad(kw, ((0, 0), (WINDOW - 1, 0), (0, 0), (0, 0)))
    vw_pad = jnp.pad(vw, ((0, 0), (WINDOW - 1, 0), (0, 0), (0, 0)))
    scale = HEAD_DIM ** -0.5
    gates = jax.nn.sigmoid(g_nsa.astype(jnp.float32)).reshape(B, S, G, HPG, 3)

    def block(s0):
        t = s0 + jnp.arange(Q_BLOCK)
        qb = lax.dynamic_slice_in_dim(q, s0, Q_BLOCK, axis=1)
        gb = lax.dynamic_slice_in_dim(gates, s0, Q_BLOCK, axis=1)
        s_c = jnp.einsum('bqghd,bngd->bghqn', qb, k_cmp) * scale
        p_c = masked_softmax(s_c, cmp_end[None, :] <= t[:, None])
        o_c = jnp.einsum('bghqn,bngd->bqghd', p_c, v_cmp)
        imp = jnp.einsum('bghqn,nj->bgqj', p_c, overlap)
        causal = slc_start[None, :] <= t[:, None]
        cur = t // SEL_BLOCK
        forced = causal & ((slc_idx[None, :] == 0) | (slc_idx[None, :] >= cur[:, None] - 1))
        score = jnp.where(forced, SEL_BONUS, jnp.where(causal, imp, NEG_INF))
        top_v, idx = lax.top_k(score, n_pick)
        sel_ok = top_v > 0.5 * NEG_INF
        idx_flat = idx.reshape(B, G, Q_BLOCK * n_pick)
        k_sel = gather_blocks(k_blk, idx_flat).reshape(B, G, Q_BLOCK, n_pick * SEL_BLOCK, dh)
        v_sel = gather_blocks(v_blk, idx_flat).reshape(B, G, Q_BLOCK, n_pick * SEL_BLOCK, dh)
        key_pos = idx[..., None] * SEL_BLOCK + jnp.arange(SEL_BLOCK)
        ok = (sel_ok[..., None] & (key_pos <= t[:, None, None])).reshape(B, G, Q_BLOCK, n_pick * SEL_BLOCK)
        s_s = jnp.einsum('bqghd,bgqkd->bghqk', qb, k_sel) * scale
        p_s = masked_softmax(s_s, ok[:, :, None])
        o_s = jnp.einsum('bghqk,bgqkd->bqghd', p_s, v_sel)
        kwb = lax.dynamic_slice_in_dim(kw_pad, s0, win_len, axis=1)
        vwb = lax.dynamic_slice_in_dim(vw_pad, s0, win_len, axis=1)
        kpos = s0 - (WINDOW - 1) + jnp.arange(win_len)
        wmask = (kpos[None, :] <= t[:, None]) & (kpos[None, :] > t[:, None] - WINDOW) & (kpos[None, :] >= 0)
        s_w = jnp.einsum('bqghd,bkgd->bghqk', qb, kwb) * scale
        p_w = masked_softmax(s_w, wmask)
        o_w = jnp.einsum('bghqk,bkgd->bqghd', p_w, vwb)
        o = gb[..., 0:1] * o_c + gb[..., 1:2] * o_s + gb[..., 2:3] * o_w
        return o.reshape(B, Q_BLOCK, NSA_WIDTH)

    out = lax.map(block, jnp.arange(S // Q_BLOCK) * Q_BLOCK)
    return out.transpose(1, 0, 2, 3).reshape(B, S, NSA_WIDTH)


def setup_inputs(seed: int = 0) -> dict:
    key = jax.random.key(seed)
    ks = jax.random.split(key, 20)
    f32 = jnp.float32

    def nrm(k, shape, fan_in):
        return jax.random.normal(k, shape, f32) * (fan_in ** -0.5)

    return {
        'x': jax.random.normal(ks[0], (BATCH, SEQ, D_MODEL), f32),
        'norm_mix': 1.0 + 0.05 * jax.random.normal(ks[1], (DEPTH, D_MODEL), f32),
        'w_in': nrm(ks[2], (DEPTH, D_MODEL, N_IN), D_MODEL),
        'w_pool': nrm(ks[3], (DEPTH, POOL_GROUPS, POOL_GW, POOL_GW), POOL_GW),
        'pool_scale': 1.0 + 0.1 * jax.random.normal(ks[4], (DEPTH, POOL_WIDTH), f32),
        'pe_k': 0.1 * jax.random.normal(ks[5], (DEPTH, CMP_LEN, HEAD_DIM), f32),
        'pe_v': 0.1 * jax.random.normal(ks[6], (DEPTH, CMP_LEN, HEAD_DIM), f32),
        'w_ck1': nrm(ks[7], (DEPTH, CMP_LEN * HEAD_DIM, CMP_HIDDEN), CMP_LEN * HEAD_DIM),
        'w_ck2': nrm(ks[8], (DEPTH, CMP_HIDDEN, HEAD_DIM), CMP_HIDDEN),
        'w_cv1': nrm(ks[9], (DEPTH, CMP_LEN * HEAD_DIM, CMP_HIDDEN), CMP_LEN * HEAD_DIM),
        'w_cv2': nrm(ks[10], (DEPTH, CMP_HIDDEN, HEAD_DIM), CMP_HIDDEN),
        'w_proj_pool': nrm(ks[11], (DEPTH, POOL_WIDTH, D_MODEL), POOL_WIDTH),
        'w_proj_nsa': nrm(ks[12], (DEPTH, NSA_WIDTH, D_MODEL), NSA_WIDTH),
        'w_out': nrm(ks[13], (DEPTH, D_MODEL, D_MODEL), D_MODEL),
        'norm_mlp': 1.0 + 0.05 * jax.random.normal(ks[14], (DEPTH, D_MODEL), f32),
        'w_ff1': nrm(ks[15], (DEPTH, D_MODEL, D_FF), D_MODEL),
        'w_ff2': nrm(ks[16], (DEPTH, D_FF, D_MODEL), D_FF),
        'norm_final': 1.0 + 0.05 * jax.random.normal(ks[17], (D_MODEL,), f32),
    }


def reference(x, norm_mix, w_in, w_pool, pool_scale, pe_k, pe_v, w_ck1, w_ck2, w_cv1, w_cv2,
              w_proj_pool, w_proj_nsa, w_out, norm_mlp, w_ff1, w_ff2, norm_final):
    for l in range(DEPTH):
        h = rms_norm(x, norm_mix[l])
        proj = h @ w_in[l]
        u, q, kc, vc, ksl, vsl, kwn, vwn, g_nsa, g_merge = jnp.split(proj, IN_SPLITS, axis=-1)
        y_pool = pool_mixer(u, w_pool[l], pool_scale[l])
        y_nsa = nsa_mixer(q, kc, vc, ksl, vsl, kwn, vwn, g_nsa, pe_k[l], pe_v[l],
                          w_ck1[l], w_ck2[l], w_cv1[l], w_cv2[l]).astype(x.dtype)
        g_a, g_b = jnp.split(jax.nn.sigmoid(g_merge.astype(jnp.float32)).astype(x.dtype), 2, axis=-1)
        merged = g_a * (y_pool @ w_proj_pool[l]) + g_b * (y_nsa @ w_proj_nsa[l])
        x = x + merged @ w_out[l]
        h = rms_norm(x, norm_mlp[l])
        x = x + jnp.square(jax.nn.relu(h @ w_ff1[l])) @ w_ff2[l]
    return rms_norm(x, norm_final)
```

```cpp
#include <hip/hip_runtime.h>
#include <hip/hip_cooperative_groups.h>
#include <cstdio>
#include <cstdint>
#include <cmath>
namespace cg = cooperative_groups;
namespace pg8 {
#define PG8_LAS __attribute__((address_space(3)))
typedef unsigned short bf16_t;
typedef short bf16x8 __attribute__((ext_vector_type(8)));
typedef float f32x4 __attribute__((ext_vector_type(4)));
typedef unsigned u32x4 __attribute__((ext_vector_type(4)));
constexpr int BM = 256, BK = 64, HALF = 128, HTB = HALF * BK * 2  , STAGE_BYTES = 8 * HTB, NXCD = 8, WGM = 8;

__host__ __device__ __forceinline__ int lds_byte(int r, int c) { const int st = (r >> 4) * 2 + (c >> 5), rr = r & 15, cc = c & 31, ob = rr * 64 + cc * 2; return st * 1024 + (ob ^ (((ob >> 9) & 1) << 5)); }
__host__ __device__ __forceinline__ void stage_rc(int b, int& R, int& C) { const int st = b / 1024, sb = b % 1024, swz = sb ^ (((sb >> 9) & 1) << 5); R = (st >> 1) * 16 + swz / 64; C = (st & 1) * 32 + (swz % 64) / 2; }
__host__ __device__ __forceinline__ int perm32(int rho) { const int n = rho >> 4, i = rho & 15; return 8 * (i >> 2) + 4 * n + (i & 3); }

struct Unit { int pm, pn; };
struct Gemm { const bf16_t* A; const bf16_t* Bt; int M, N, K, lda; };

struct StaticOrder {
    int nM, nN, nwg, G, c;
    __host__ __device__ void init(int M, int N, int G_, int c_) { nM = M / BM; nN = N / BM; nwg = nM * nN; G = G_; c = c_; }
    __host__ __device__ bool next(int i, Unit& u) const {
        const long L = (long)i * G + c; if (L >= nwg) return false;
        int wgid = (int)L; { const int q = nwg / NXCD, r = nwg % NXCD, xcd = wgid % NXCD, off = wgid / NXCD; wgid = (xcd < r ? xcd * (q + 1) : r * (q + 1) + (xcd - r) * q) + off; }
        const int nig = WGM * nN, gid = wgid / nig, fm = gid * WGM, gsz = (nM - fm) < WGM ? (nM - fm) : WGM;
        u.pm = fm + ((wgid % nig) % gsz); u.pn = (wgid % nig) / gsz; return true;
    }
    __device__ __forceinline__ void a_ready(const Unit&) const {}
    __device__ __forceinline__ void done(const Unit&) const {}
};

__device__ __forceinline__ unsigned cvt_pk_bf16(float lo, float hi) { unsigned r; asm volatile("v_cvt_pk_bf16_f32 %0, %1, %2" : "=v"(r) : "v"(lo), "v"(hi)); return r; }
typedef float f32x2 __attribute__((ext_vector_type(2)));
template <class Epi, class Sched, bool ALIGN_EPI = false, bool SP2 = false>
__device__ __forceinline__ void gemm_phase(PG8_LAS unsigned char* lds, const Gemm g, const Sched& S, const Epi& E) {
    int tid_ = threadIdx.x; asm volatile("" : "+v"(tid_));
    const int tid = tid_, wid = __builtin_amdgcn_readfirstlane(tid >> 6), lane = tid & 63, wr = wid >> 2, wc = wid & 3, fr = lane & 15, fq = lane >> 4;
    const int K = g.K, nt = K / BK;
    unsigned voffA[2], voffB[2];
#pragma unroll
    for (int i = 0; i < 2; ++i) { int R, C; stage_rc(tid * 16 + i * 8192, R, C); const int Rb = Epi::PERM ? ((R & ~31) + perm32(R & 31)) : R;
        voffA[i] = (unsigned)(R * g.lda + C) * 2u; voffB[i] = (unsigned)(Rb * K + C) * 2u; }
    const size_t kstep = (size_t)(BK * 2);
    const size_t hstepB = (size_t)HALF * K * 2, hstepA = (size_t)HALF * g.lda * 2;
    const size_t tstepA = 2 * hstepA, tstepB = 2 * hstepB;
    const unsigned ldsw = (unsigned)wid * 1024u;
    const int aoff = lds_byte(wr * 64 + fr, fq * 8), boff = lds_byte(wc * 32 + fr, fq * 8);
#define PG8_SA(b, h) (((b) * 2 + (h)) * HTB)
#define PG8_SB(b, h) ((4 + (b) * 2 + (h)) * HTB)
#define PG8_STAGE(bufoff, gbase, voff) do { _Pragma("unroll") for (int _i = 0; _i < 2; ++_i) \
        __builtin_amdgcn_global_load_lds((const unsigned*)((const char*)(gbase) + (voff)[_i]), (PG8_LAS unsigned*)(lds + (bufoff) + ldsw + _i * 8192), 16, 0, 0); } while (0)
#define PG8_LDA(dst, b, h) do { _Pragma("unroll") for (int m = 0; m < 4; ++m) _Pragma("unroll") for (int k = 0; k < 2; ++k) dst[m][k] = *(const PG8_LAS bf16x8*)(lds + PG8_SA(b, h) + aoff + m * 2048 + k * 1024); } while (0)
#define PG8_LDB(dst, b, h) do { _Pragma("unroll") for (int n = 0; n < 2; ++n) _Pragma("unroll") for (int k = 0; k < 2; ++k) dst[n][k] = *(const PG8_LAS bf16x8*)(lds + PG8_SB(b, h) + boff + n * 2048 + k * 1024); } while (0)
#define PG8_MMA(ai, bj, At, Bt) do { __builtin_amdgcn_s_setprio(1); _Pragma("unroll") for (int m = 0; m < 4; ++m) _Pragma("unroll") for (int n = 0; n < 2; ++n) _Pragma("unroll") for (int k = 0; k < 2; ++k) \
        acc[ai][bj][m][n] = __builtin_amdgcn_mfma_f32_16x16x32_bf16(Bt[n][k], At[m][k], acc[ai][bj][m][n], 0, 0, 0); __builtin_amdgcn_s_setprio(0); } while (0)
#define PG8_WAIT_V(n) asm volatile("s_waitcnt vmcnt(" #n ")" ::: "memory")
#define PG8_WAIT_L(n) asm volatile("s_waitcnt lgkmcnt(" #n ")" ::: "memory")
#define PG8_BAR __builtin_amdgcn_s_barrier()
#define PG8_SCHED __builtin_amdgcn_sched_barrier(0)
    Unit cur, nxt; int ui = 0;
    if (!S.next(0, cur)) return;
    f32x4 acc[2][2][4][2];
#pragma unroll
    for (int a = 0; a < 2; ++a)
#pragma unroll
        for (int b = 0; b < 2; ++b)
#pragma unroll
            for (int m = 0; m < 4; ++m)
#pragma unroll
                for (int n = 0; n < 2; ++n) acc[a][b][m][n] = (f32x4){0.f, 0.f, 0.f, 0.f};
    bf16x8 At[4][2], B0[2][2], B1[2][2];
    const char* cA = (const char*)g.A + (size_t)cur.pm * tstepA; const char* cB = (const char*)g.Bt + (size_t)cur.pn * tstepB;
    S.a_ready(cur);
    if constexpr (SP2) {
        PG8_STAGE(PG8_SB(0, 0), cB, voffB); PG8_STAGE(PG8_SB(0, 1), cB + hstepB, voffB); PG8_STAGE(PG8_SA(0, 0), cA, voffA); PG8_STAGE(PG8_SA(0, 1), cA + hstepA, voffA);
        if (wr == 1) PG8_BAR;
        PG8_WAIT_V(2); PG8_BAR;
        PG8_STAGE(PG8_SB(1, 0), cB + kstep, voffB); PG8_STAGE(PG8_SA(1, 0), cA + kstep, voffA); PG8_STAGE(PG8_SB(1, 1), cB + hstepB + kstep, voffB);
        PG8_WAIT_V(6); PG8_BAR;
    } else {
        PG8_STAGE(PG8_SB(0, 0), cB, voffB); PG8_STAGE(PG8_SA(0, 0), cA, voffA); PG8_STAGE(PG8_SB(0, 1), cB + hstepB, voffB); PG8_STAGE(PG8_SA(0, 1), cA + hstepA, voffA);
        if (wr == 1) PG8_BAR;
        PG8_WAIT_V(4); PG8_BAR;
        PG8_STAGE(PG8_SB(1, 0), cB + kstep, voffB); PG8_STAGE(PG8_SA(1, 0), cA + kstep, voffA); PG8_STAGE(PG8_SB(1, 1), cB + hstepB + kstep, voffB);
        PG8_WAIT_V(6); PG8_BAR;
    }
    for (;;) {
        const bool has_next = S.next(ui + 1, nxt);
        const char* nA = has_next ? (const char*)g.A + (size_t)nxt.pm * tstepA : cA; const char* nB = has_next ? (const char*)g.Bt + (size_t)nxt.pn * tstepB : cB;
        for (int t = 0; t < nt; t += 2) {
            const bool last = (t == nt - 2);
            const char* a1 = cA + (size_t)(t + 1) * kstep;
            const char* a2 = last ? nA : cA + (size_t)(t + 2) * kstep; const char* b2 = last ? nB : cB + (size_t)(t + 2) * kstep;
            const char* a3 = a2 + kstep; const char* b3 = b2 + kstep;
            if (last && has_next) S.a_ready(nxt);
            if constexpr (SP2) {
            PG8_LDB(B0, 0, 0); PG8_LDB(B1, 0, 1); PG8_SCHED; PG8_LDA(At, 0, 0); PG8_STAGE(PG8_SA(1, 1), a1 + hstepA, voffA);
            PG8_WAIT_V(8); PG8_WAIT_L(0); PG8_BAR; PG8_MMA(0, 0, At, B0); PG8_MMA(0, 1, At, B1); PG8_BAR; PG8_SCHED;
            PG8_LDA(At, 0, 1); PG8_STAGE(PG8_SB(0, 0), b2, voffB); PG8_STAGE(PG8_SB(0, 1), b2 + hstepB, voffB); PG8_STAGE(PG8_SA(0, 0), a2, voffA);
            PG8_WAIT_V(8); PG8_WAIT_L(0); PG8_BAR; PG8_MMA(1, 0, At, B0); PG8_MMA(1, 1, At, B1); PG8_BAR; PG8_SCHED;
            PG8_LDB(B0, 1, 0); PG8_LDB(B1, 1, 1); PG8_SCHED; PG8_LDA(At, 1, 0); PG8_STAGE(PG8_SA(0, 1), a2 + hstepA, voffA);
            PG8_WAIT_V(8); PG8_WAIT_L(0); PG8_BAR; PG8_MMA(0, 0, At, B0); PG8_MMA(0, 1, At, B1); PG8_BAR; PG8_SCHED;
            PG8_LDA(At, 1, 1); PG8_STAGE(PG8_SB(1, 0), b3, voffB); PG8_STAGE(PG8_SB(1, 1), b3 + hstepB, voffB); PG8_STAGE(PG8_SA(1, 0), a3, voffA);
            PG8_WAIT_V(8); PG8_WAIT_L(0); PG8_BAR; PG8_MMA(1, 0, At, B0); PG8_MMA(1, 1, At, B1); PG8_BAR; PG8_SCHED;
            } else {
            PG8_LDB(B0, 0, 0); PG8_SCHED; PG8_LDA(At, 0, 0); PG8_STAGE(PG8_SA(1, 1), a1 + hstepA, voffA);
            PG8_WAIT_L(8); PG8_BAR; PG8_WAIT_L(0); PG8_MMA(0, 0, At, B0); PG8_BAR; PG8_SCHED;
            PG8_LDB(B1, 0, 1); PG8_STAGE(PG8_SB(0, 0), b2, voffB);
            PG8_BAR; PG8_WAIT_L(0); PG8_MMA(0, 1, At, B1); PG8_BAR;
            PG8_LDA(At, 0, 1); PG8_STAGE(PG8_SA(0, 0), a2, voffA);
            PG8_BAR; PG8_WAIT_L(0); PG8_MMA(1, 0, At, B0); PG8_BAR; PG8_SCHED;
            PG8_STAGE(PG8_SB(0, 1), b2 + hstepB, voffB);
            PG8_WAIT_V(6); PG8_BAR; PG8_MMA(1, 1, At, B1); PG8_BAR;
            PG8_LDB(B0, 1, 0); PG8_SCHED; PG8_LDA(At, 1, 0); PG8_STAGE(PG8_SA(0, 1), a2 + hstepA, voffA);
            PG8_WAIT_L(8); PG8_BAR; PG8_WAIT_L(0); PG8_MMA(0, 0, At, B0); PG8_BAR; PG8_SCHED;
            PG8_LDB(B1, 1, 1); PG8_STAGE(PG8_SB(1, 0), b3, voffB);
            PG8_BAR; PG8_WAIT_L(0); PG8_MMA(0, 1, At, B1); PG8_BAR;
            PG8_LDA(At, 1, 1); PG8_STAGE(PG8_SA(1, 0), a3, voffA);
            PG8_BAR; PG8_WAIT_L(0); PG8_MMA(1, 0, At, B0); PG8_BAR; PG8_SCHED;
            PG8_STAGE(PG8_SB(1, 1), b3 + hstepB, voffB);
            PG8_WAIT_V(6); PG8_BAR; PG8_MMA(1, 1, At, B1); PG8_BAR;
            }
        }
        if constexpr (ALIGN_EPI) { if (wr == 0) PG8_BAR; }
        if constexpr (!Epi::AFTER_DRAIN) { E(acc, cur, wr, wc, fr, fq); S.done(cur); }
        if (!has_next) break;
#pragma unroll
        for (int a = 0; a < 2; ++a)
#pragma unroll
            for (int b = 0; b < 2; ++b)
#pragma unroll
                for (int m = 0; m < 4; ++m)
#pragma unroll
                    for (int n = 0; n < 2; ++n) acc[a][b][m][n] = (f32x4){0.f, 0.f, 0.f, 0.f};
        cur = nxt; cA = nA; cB = nB; ++ui;
        if constexpr (ALIGN_EPI) { if (wr == 1) PG8_BAR; }
    }
    PG8_WAIT_V(0);
    if constexpr (!ALIGN_EPI) { if (wr == 0) PG8_BAR; }
    PG8_BAR;
    if constexpr (Epi::AFTER_DRAIN) { E.fused(acc, cur, wr, wc, fr, fq, lds, wid, lane); S.done(cur); }
#undef PG8_SA
#undef PG8_SB
#undef PG8_STAGE
#undef PG8_LDA
#undef PG8_LDB
#undef PG8_MMA
#undef PG8_WAIT_V
#undef PG8_WAIT_L
#undef PG8_BAR
#undef PG8_SCHED
}
}
#define LAS __attribute__((address_space(3)))
#define XB_TMO      128
#define XB_XCNT(j)  (256  + 64 * (j))
#define XB_XSUB(j)  (1280 + 64 * (j))
#define XB_XGEN(j)  (2304 + 64 * (j))
#define XB_TOP      3328
#define XB_TOPGEN   3392
#define XCD_BAR_WORDS 3456
#define XB_SPIN_CAP (1u << 18)

__device__ __forceinline__ unsigned xb_ld(unsigned* p)              { return __hip_atomic_load(p, __ATOMIC_RELAXED, __HIP_MEMORY_SCOPE_AGENT); }
__device__ __forceinline__ unsigned xb_add(unsigned* p, unsigned v) { return __hip_atomic_fetch_add(p, v, __ATOMIC_RELAXED, __HIP_MEMORY_SCOPE_AGENT); }
__device__ __forceinline__ unsigned xb_xcc_id() { return (unsigned)__builtin_amdgcn_s_getreg((3 << 11) | 20) & 0xFu; }
#define XB_SPIN(cond, bar) do { unsigned _sp = 0; while (cond) { __builtin_amdgcn_s_sleep(1); \
    if ((++_sp & 255u) == 0u) { if (xb_ld(&(bar)[XB_TMO])) break; if (_sp > XB_SPIN_CAP) { atomicAdd(&(bar)[XB_TMO], 1u); break; } } } } while (0)

struct XcdBarrier {
    unsigned* bar; unsigned x;
    volatile LAS unsigned* st;
};

__device__ __forceinline__ XcdBarrier xcd_barrier_post(unsigned* bar, volatile LAS unsigned* st) {
    XcdBarrier b; b.bar = bar; b.x = xb_xcc_id(); b.st = st;
    if (threadIdx.x == 0) (void)xb_add(&bar[XB_XCNT(b.x)], 1u);
    return b;
}
__device__ __forceinline__ void xcd_barrier_complete(unsigned* bar, unsigned x, unsigned& nloc, unsigned& nx) {
    const unsigned G = gridDim.x * gridDim.y * gridDim.z;
    unsigned sum, cnt, mine, sp = 0u;
    for (;;) {
        sum = 0u; cnt = 0u; mine = 0u;
#pragma unroll
        for (unsigned j = 0; j < 16; ++j) { const unsigned c = xb_ld(&bar[XB_XCNT(j)]); sum += c; cnt += (c > 0u) ? 1u : 0u; mine = (j == x) ? c : mine; }
        if (sum == G) break;
        __builtin_amdgcn_s_sleep(1);
        if ((++sp & 255u) == 0u) { if (xb_ld(&bar[XB_TMO])) break; if (sp > XB_SPIN_CAP) { atomicAdd(&bar[XB_TMO], 1u); break; } }
    }
    nloc = mine > 0u ? mine : 1u; nx = cnt > 0u ? cnt : 1u;
}

__device__ __forceinline__ void xcd_barrier(const XcdBarrier& b) {
    asm volatile("s_waitcnt vmcnt(0)" ::: "memory");
    __syncthreads();
    if (threadIdx.x == 0) {
        unsigned* bar = b.bar;
        __builtin_amdgcn_s_waitcnt(0);
        unsigned nloc = b.st[0], nx = b.st[1];
        if (nloc == 0u) { xcd_barrier_complete(bar, b.x, nloc, nx); b.st[0] = nloc; b.st[1] = nx; }
        const unsigned old = xb_add(&bar[XB_XSUB(b.x)], 1u);
        const unsigned gen = old / nloc;
        if (old + 1u == (gen + 1u) * nloc) {
            __builtin_amdgcn_fence(__ATOMIC_RELEASE, "agent");
            asm volatile("s_waitcnt vmcnt(0)" ::: "memory");
            const unsigned og = xb_add(&bar[XB_TOP], 1u);
            const unsigned tg = og / nx;
            if (og + 1u == (tg + 1u) * nx) xb_add(&bar[XB_TOPGEN], 1u);
            else XB_SPIN(xb_ld(&bar[XB_TOPGEN]) == tg, bar);
            __builtin_amdgcn_fence(__ATOMIC_ACQUIRE, "agent");
            xb_add(&bar[XB_XGEN(b.x)], 1u);
            asm volatile("s_waitcnt vmcnt(0)" ::: "memory");
        } else {
            XB_SPIN(xb_ld(&bar[XB_XGEN(b.x)]) == gen, bar);
            __builtin_amdgcn_fence(__ATOMIC_ACQUIRE, "agent");
            asm volatile("s_waitcnt vmcnt(0)" ::: "memory");
        }
    }
    __syncthreads();
}
#undef LAS
using namespace pg8;
#define LAS __attribute__((address_space(3)))
typedef float f32x16 __attribute__((ext_vector_type(16)));
typedef unsigned u32x2 __attribute__((ext_vector_type(2)));
#define LDS_WAIT() asm volatile("s_waitcnt lgkmcnt(0)" ::: "memory")

constexpr int DM = 1024, NBATCH = 8, SEQ = 4096, MTOK = NBATCH * SEQ, DEPTH = 4, NIN = 4400, NPAD = 4608, DFF = 4096;
constexpr size_t MiB = 1u << 20;
constexpr size_t WS_ROPEC = 0, WS_ROPES = 512 * 1024, WS_CBIAS = 1 * MiB, WS_BAR = 1 * MiB + 64 * 1024;
constexpr size_t WS_W = 2 * MiB, WL_STRIDE = 33 * MiB;
constexpr size_t W_IN = 0, W_POOL = 9 * MiB, W_CK1 = W_POOL + MiB / 2, W_CV1 = W_CK1 + MiB, W_PP = W_CV1 + MiB, W_PN = W_PP + MiB,
                 W_OUT = W_PN + 2 * MiB, W_FF1 = W_OUT + 2 * MiB, W_FF2 = W_FF1 + 8 * MiB, W_CK2 = W_FF2 + 8 * MiB, W_CV2 = W_CK2 + 32 * 1024;
constexpr size_t WS_SS = 134 * MiB;
constexpr size_t WS_XN = 136 * MiB;
constexpr size_t WS_CK = 200 * MiB, WS_CVT = WS_CK + MiB / 2, WS_HIDK = 201 * MiB, WS_HIDV = 203 * MiB;
constexpr size_t WS_U = 206 * MiB, WS_Q = 238 * MiB, WS_KC = 302 * MiB, WS_VC = 310 * MiB, WS_KS = 318 * MiB, WS_VS = 326 * MiB, WS_KW = 334 * MiB,
                 WS_VW = 342 * MiB, WS_VST = 350 * MiB, WS_VWT = 358 * MiB, WS_GNSA = 366 * MiB, WS_GM = 370 * MiB;
constexpr size_t WS_H = 206 * MiB;
constexpr size_t WS_PPF = 500 * MiB;
constexpr size_t WS_END = 504 * MiB;
constexpr int LDS_BYTES = 135168;

__device__ __forceinline__ int launder_s(int i) { i = __builtin_amdgcn_readfirstlane(i); asm volatile("" : "+s"(i)); return i; }
#define GAS1 __attribute__((address_space(1)))
#define AIN(a, i) ((const float*)(const GAS1 float*)((a).in[launder_s(i)]))
struct Args { const float* in[18]; float* out; unsigned char* ws; double invf[32]; int ph_lo, ph_hi; };

__device__ __forceinline__ float bf2f(unsigned short u) { return __uint_as_float((unsigned)u << 16); }
__device__ __forceinline__ float bflo(unsigned w) { return __uint_as_float(w << 16); }
__device__ __forceinline__ float bfhi(unsigned w) { return __uint_as_float(w & 0xffff0000u); }
__device__ __forceinline__ unsigned short f2bf(float f) { return (unsigned short)(cvt_pk_bf16(f, f) & 0xffffu); }
__device__ __forceinline__ float wave_sum(float v) {
#pragma unroll
    for (int o = 1; o < 64; o <<= 1) v += __shfl_xor(v, o);
    return v;
}
__device__ __forceinline__ float sigmoidf_(float x) { return __builtin_amdgcn_rcpf(1.0f + __builtin_amdgcn_exp2f(-1.4426950408889634f * x)); }
__device__ __forceinline__ f32x4 sigmoid4(f32x4 v) { return (f32x4){sigmoidf_(v[0]), sigmoidf_(v[1]), sigmoidf_(v[2]), sigmoidf_(v[3])}; }
__device__ __forceinline__ float gelu_tanh(float x) {
    const float y = 0.7978845608028654f * (x + 0.044715f * x * x * x);
    const float e = __builtin_amdgcn_exp2f(2.0f * 1.4426950408889634f * y);
    const float th = 1.0f - 2.0f * __builtin_amdgcn_rcpf(1.0f + e);
    return 0.5f * x * (1.0f + th);
}
__device__ __forceinline__ void store8(bf16_t* dst, f32x4 v0, f32x4 v1) {
    u32x4 w; w.x = cvt_pk_bf16(v0[0], v0[1]); w.y = cvt_pk_bf16(v0[2], v0[3]); w.z = cvt_pk_bf16(v1[0], v1[1]); w.w = cvt_pk_bf16(v1[2], v1[3]);
    *(u32x4*)dst = w;
}

template <class Op, bool RS = false> struct EpiP {
    static constexpr bool PERM = true, AFTER_DRAIN = false; Op op; const float* ss;
    __device__ __forceinline__ void operator()(const f32x4 (&acc)[2][2][4][2], const Unit& u, int wr, int wc, int fr, int fq) const {
#pragma unroll
        for (int ai = 0; ai < 2; ++ai) {
            const int row0 = u.pm * 256 + ai * 128 + wr * 64 + fr; float r[4] = {1.0f, 1.0f, 1.0f, 1.0f};
            if (RS) { f32x4 t[4][4];
#pragma unroll
                for (int m = 0; m < 4; ++m) { const f32x4* sp = (const f32x4*)(ss + (size_t)(row0 + m * 16) * 16);
#pragma unroll
                    for (int k = 0; k < 4; ++k) t[m][k] = sp[k]; }
#pragma unroll
                for (int m = 0; m < 4; ++m) { const f32x4 q = (t[m][0] + t[m][1]) + (t[m][2] + t[m][3]); r[m] = 1.0f / sqrtf(((q.x + q.y) + (q.z + q.w)) * (1.0f / 1024.0f) + 1e-6f); } }
            typename Op::Pre pre[4][2];
#pragma unroll
            for (int m = 0; m < 4; ++m)
#pragma unroll
                for (int bj = 0; bj < 2; ++bj) pre[m][bj] = op.load(u.pn, row0 + m * 16, bj * 128 + wc * 32 + 8 * fq);
#pragma unroll
            for (int m = 0; m < 4; ++m)
#pragma unroll
                for (int bj = 0; bj < 2; ++bj) op.apply(u.pn, row0 + m * 16, bj * 128 + wc * 32 + 8 * fq, acc[ai][bj][m][0] * r[m], acc[ai][bj][m][1] * r[m], pre[m][bj]);
        }
    }
};
struct EpiResid {
    static constexpr bool PERM = true, AFTER_DRAIN = false; bf16_t* xb; float* ss;
    __device__ __forceinline__ void operator()(const f32x4 (&acc)[2][2][4][2], const Unit& u, int wr, int wc, int fr, int fq) const {
#pragma unroll
        for (int ai = 0; ai < 2; ++ai) {
            const int row0 = u.pm * 256 + ai * 128 + wr * 64 + fr; const int col0 = u.pn * 256 + wc * 32 + 8 * fq;
            u32x4 xv[4][2];
#pragma unroll
            for (int m = 0; m < 4; ++m)
#pragma unroll
                for (int bj = 0; bj < 2; ++bj) xv[m][bj] = *(const u32x4*)(xb + (size_t)(row0 + m * 16) * 1024 + col0 + bj * 128);
#pragma unroll
            for (int m = 0; m < 4; ++m) { const int row = row0 + m * 16; float sq = 0.f;
#pragma unroll
                for (int bj = 0; bj < 2; ++bj) { const size_t o = (size_t)row * 1024 + col0 + bj * 128; const u32x4 x = xv[m][bj];
                    const f32x4 v0 = (f32x4){bflo(x.x), bfhi(x.x), bflo(x.y), bfhi(x.y)} + acc[ai][bj][m][0], v1 = (f32x4){bflo(x.z), bfhi(x.z), bflo(x.w), bfhi(x.w)} + acc[ai][bj][m][1];
                    store8(xb + o, v0, v1);
                    sq += ((v0.x * v0.x + v0.y * v0.y) + (v0.z * v0.z + v0.w * v0.w)) + ((v1.x * v1.x + v1.y * v1.y) + (v1.z * v1.z + v1.w * v1.w)); }
                sq += __shfl_xor(sq, 16); sq += __shfl_xor(sq, 32);
                if (fq == 0) ss[(size_t)row * 16 + u.pn * 4 + wc] = sq; }
        }
    }
};
struct NoPre {};
struct OpProj { unsigned char* ws; typedef NoPre Pre;
    __device__ __forceinline__ Pre load(int, int, int) const { return Pre{}; }
    __device__ __forceinline__ void apply(int pn, int row, int lc, f32x4 v0, f32x4 v1, const Pre&) const {
        size_t off; bool sig = false;
        if (pn < 2) off = WS_U + ((size_t)row * 512 + pn * 256 + lc) * 2;
        else if (pn < 6) off = WS_Q + ((size_t)row * 1024 + (pn - 2) * 256 + lc) * 2;
        else if (pn < 9) { const int c = lc & 127, g = c >> 6, dh = c & 63, b = row >> 12, t = row & 4095;
            off = WS_KC + (size_t)((pn - 6) * 2 + (lc >> 7)) * (8 * MiB) + (((size_t)((b * 2 + g) * 4096 + t)) * 64 + dh) * 2; }
        else if (pn == 9) { if (lc >= 64) return; off = WS_GNSA + ((size_t)row * 64 + lc) * 2; sig = true; }
        else {
            v0 = sigmoid4(v0); v1 = sigmoid4(v1); u32x2 w;
            w.x = (unsigned)(v0[0] * 255.0f + 0.5f) | ((unsigned)(v0[1] * 255.0f + 0.5f) << 8) | ((unsigned)(v0[2] * 255.0f + 0.5f) << 16) | ((unsigned)(v0[3] * 255.0f + 0.5f) << 24);
            w.y = (unsigned)(v1[0] * 255.0f + 0.5f) | ((unsigned)(v1[1] * 255.0f + 0.5f) << 8) | ((unsigned)(v1[2] * 255.0f + 0.5f) << 16) | ((unsigned)(v1[3] * 255.0f + 0.5f) << 24);
            *(u32x2*)(ws + WS_GM + (size_t)row * 2048 + (pn - 10) * 256 + lc) = w; return; }
        if (sig) { v0 = sigmoid4(v0); v1 = sigmoid4(v1); }
        store8((bf16_t*)(ws + off), v0, v1);
    } };
struct OpBf16 { bf16_t* O; int ld; typedef NoPre Pre;
    __device__ __forceinline__ Pre load(int, int, int) const { return Pre{}; }
    __device__ __forceinline__ void apply(int pn, int row, int lc, f32x4 v0, f32x4 v1, const Pre&) const { store8(O + (size_t)row * ld + pn * 256 + lc, v0, v1); } };
struct OpCmp1 { bf16_t* H; const float* bias; struct Pre { f32x4 b0, b1; };
    __device__ __forceinline__ Pre load(int, int, int lc) const { return Pre{*(const f32x4*)(bias + lc), *(const f32x4*)(bias + lc + 4)}; }
    __device__ __forceinline__ void apply(int pn, int row, int lc, f32x4 v0, f32x4 v1, const Pre& p) const {
        v0 += p.b0; v1 += p.b1;
#pragma unroll
        for (int i = 0; i < 4; ++i) { v0[i] = gelu_tanh(v0[i]); v1[i] = gelu_tanh(v1[i]); }
        store8(H + (size_t)row * 256 + lc, v0, v1);
    } };
__device__ __forceinline__ void ungate8(u32x2 g, float (&f)[8]) { constexpr float k = 1.0f / 255.0f;
    f[0] = (float)(g.x & 255u) * k; f[1] = (float)((g.x >> 8) & 255u) * k; f[2] = (float)((g.x >> 16) & 255u) * k; f[3] = (float)(g.x >> 24) * k;
    f[4] = (float)(g.y & 255u) * k; f[5] = (float)((g.y >> 8) & 255u) * k; f[6] = (float)((g.y >> 16) & 255u) * k; f[7] = (float)(g.y >> 24) * k; }
struct OpMerge1 { const unsigned char* G8; bf16_t* MG; struct Pre { u32x2 g; };
    __device__ __forceinline__ Pre load(int pn, int row, int lc) const { return Pre{*(const u32x2*)(G8 + (size_t)row * 2048 + pn * 256 + lc)}; }
    __device__ __forceinline__ void apply(int pn, int row, int lc, f32x4 v0, f32x4 v1, const Pre& p) const {
        float g[8]; ungate8(p.g, g);
#pragma unroll
        for (int i = 0; i < 4; ++i) { v0[i] *= g[i]; v1[i] *= g[4 + i]; }
        store8(MG + (size_t)row * 1024 + pn * 256 + lc, v0, v1);
    } };
struct OpMerge2 { const unsigned char* G8; bf16_t* MG; struct Pre { u32x4 t; u32x2 g; };
    __device__ __forceinline__ Pre load(int pn, int row, int lc) const { return Pre{*(const u32x4*)(MG + (size_t)row * 1024 + pn * 256 + lc), *(const u32x2*)(G8 + (size_t)row * 2048 + 1024 + pn * 256 + lc)}; }
    __device__ __forceinline__ void apply(int pn, int row, int lc, f32x4 v0, f32x4 v1, const Pre& p) const {
        const u32x4 t = p.t; float g[8]; ungate8(p.g, g);
        v0[0] = v0[0] * g[0] + bflo(t.x); v0[1] = v0[1] * g[1] + bfhi(t.x); v0[2] = v0[2] * g[2] + bflo(t.y); v0[3] = v0[3] * g[3] + bfhi(t.y);
        v1[0] = v1[0] * g[4] + bflo(t.z); v1[1] = v1[1] * g[5] + bfhi(t.z); v1[2] = v1[2] * g[6] + bflo(t.w); v1[3] = v1[3] * g[7] + bfhi(t.w);
        store8(MG + (size_t)row * 1024 + pn * 256 + lc, v0, v1);
    } };
struct OpFF1 { bf16_t* H; typedef NoPre Pre;
    __device__ __forceinline__ Pre load(int, int, int) const { return Pre{}; }
    __device__ __forceinline__ void apply(int pn, int row, int lc, f32x4 v0, f32x4 v1, const Pre&) const {
#pragma unroll
        for (int i = 0; i < 4; ++i) { const float a = fmaxf(v0[i], 0.f), b = fmaxf(v1[i], 0.f); v0[i] = a * a; v1[i] = b * b; }
        store8(H + (size_t)row * 4096 + pn * 256 + lc, v0, v1);
    } };
struct EpiNull { static constexpr bool PERM = true, AFTER_DRAIN = false;
    __device__ __forceinline__ void operator()(const f32x4 (&acc)[2][2][4][2], const Unit& u, int wr, int wc, int fr, int fq) const {
#pragma unroll
        for (int ai = 0; ai < 2; ++ai)
#pragma unroll
            for (int bj = 0; bj < 2; ++bj)
#pragma unroll
                for (int m = 0; m < 4; ++m)
#pragma unroll
                    for (int n = 0; n < 2; ++n) asm volatile("" :: "v"(acc[ai][bj][m][n]));
    } };
template <class Epi> __device__ __forceinline__ void run_gemm(LAS unsigned char* lds, const bf16_t* A, int lda, const bf16_t* Bt, int M, int N, int K, const Epi& E, int G, int c) {
    Gemm g{A, Bt, M, N, K, lda}; StaticOrder S; S.init(M, N, G, c);
    gemm_phase<Epi, StaticOrder, true, true>(lds, g, S, E);
}

template <class F> __device__ __forceinline__ void conv_tile(F f, bf16_t* WT, int K, int n0, int k0, LAS float* scr, int lane) {
    float tv[32];
#pragma unroll
    for (int i = 0; i < 32; ++i) tv[i] = f(k0 + 2 * i + (lane >> 5), n0 + (lane & 31));
#pragma unroll
    for (int i = 0; i < 32; ++i) scr[(2 * i + (lane >> 5)) * 33 + (lane & 31)] = tv[i];
    LDS_WAIT(); asm volatile("" ::: "memory");
    const int c = lane & 7;
#pragma unroll
    for (int j = 0; j < 4; ++j) { const int n = (lane >> 3) + 8 * j; const LAS float* s = scr + (8 * c) * 33 + n;
        u32x4 o; o.x = cvt_pk_bf16(s[0 * 33], s[1 * 33]); o.y = cvt_pk_bf16(s[2 * 33], s[3 * 33]); o.z = cvt_pk_bf16(s[4 * 33], s[5 * 33]); o.w = cvt_pk_bf16(s[6 * 33], s[7 * 33]);
        *(u32x4*)(WT + (size_t)(n0 + n) * K + k0 + 8 * c) = o; }
    LDS_WAIT(); asm volatile("" ::: "memory");
}
struct FPlain { const float* W; int N; __device__ __forceinline__ float operator()(int k, int n) const { return W[(size_t)k * N + n]; } };
struct FWin { const float* W; const float* gk; __device__ __forceinline__ float operator()(int k, int p) const {
    int src; if (p < 2352) src = p; else if (p < 2560) src = -1; else src = p - 208; return src < 0 ? 0.f : W[(size_t)k * NIN + src] * gk[k]; } };
struct FPlainG { const float* W; int N; const float* gk; __device__ __forceinline__ float operator()(int k, int n) const { return W[(size_t)k * N + n] * gk[k]; } };
struct FPool { const float* W; const float* sc; __device__ __forceinline__ float operator()(int j, int k) const {
    return ((k >> 7) == (j >> 7)) ? W[(k >> 7) * 16384 + (k & 127) * 128 + (j & 127)] * sc[j] : 0.f; } };

__device__ __forceinline__ void rms_row_out(const bf16_t* xrow, const float* g, float* orow, int lane) {
    const u32x2* xr = (const u32x2*)xrow + lane; const f32x4* gr = (const f32x4*)g + lane;
    f32x4 v[4]; float s = 0.f;
#pragma unroll
    for (int j = 0; j < 4; ++j) { const u32x2 w = xr[64 * j]; v[j] = (f32x4){bflo(w.x), bfhi(w.x), bflo(w.y), bfhi(w.y)}; s += (v[j].x * v[j].x + v[j].y * v[j].y) + (v[j].z * v[j].z + v[j].w * v[j].w); }
    const float r = 1.0f / sqrtf(wave_sum(s) * (1.0f / 1024.0f) + 1e-6f);
    f32x4* o = (f32x4*)orow + lane;
#pragma unroll
    for (int j = 0; j < 4; ++j) { const f32x4 gg = gr[64 * j]; o[64 * j] = (v[j] * r) * gg; }
}
struct Ctx { LAS unsigned char* lds; unsigned char* ws; int tid, lane, wave, G, bx, gw, NGW; };

__device__ __forceinline__ void ph_prologue(const Args& a, const Ctx& C) {
    unsigned char* ws = C.ws;
    { float* rc = (float*)(ws + WS_ROPEC); float* rs = (float*)(ws + WS_ROPES);
      for (int idx = C.bx * 512 + C.tid; idx < SEQ * 32; idx += C.G * 512) {
        const int t = idx >> 5, i = idx & 31; const double ang = (double)t * a.invf[i];
        const double k = rint(ang * 0.15915494309189535); double r = fma(-k, 6.283185307179586, ang); r = fma(-k, 2.4492935982947064e-16, r);
        const double r2 = r * r; double s = 1.0, c = 1.0;
#pragma unroll
        for (int n = 15; n >= 1; --n) { s = 1.0 - r2 * (1.0 / (double)((2 * n) * (2 * n + 1))) * s; c = 1.0 - r2 * (1.0 / (double)((2 * n - 1) * (2 * n))) * c; }
        rc[idx] = (float)c; rs[idx] = (float)(r * s);
      } }
    LAS float* scr = (LAS float*)(C.lds + C.wave * 8448);
    constexpr int I_IN = 16 * 144, I_POOL = 8 * 16, I_CK = 32 * 8, I_PP = 8 * 32, I_PN = 16 * 32, I_OUT = 16 * 32, I_FF1 = 16 * 128, I_FF2 = 64 * 32, I_C2 = 4 * 2;
    constexpr int NITEMS = I_IN + I_POOL + 2 * I_CK + I_PP + I_PN + I_OUT + I_FF1 + I_FF2 + 2 * I_C2;
    for (int it = C.gw; it < DEPTH * NITEMS; it += C.NGW) {
        const int l = it / NITEMS; int r = it - l * NITEMS; unsigned char* wl = ws + WS_W + (size_t)l * WL_STRIDE;
        if (r < I_IN) { conv_tile(FWin{AIN(a, 2) + (size_t)l * DM * NIN, AIN(a, 1) + (size_t)l * 1024}, (bf16_t*)(wl + W_IN), 1024, (r % 144) * 32, (r / 144) * 64, scr, C.lane); continue; } r -= I_IN;
        if (r < I_POOL) { conv_tile(FPool{AIN(a, 3) + (size_t)l * 65536, AIN(a, 4) + (size_t)l * 512}, (bf16_t*)(wl + W_POOL), 512, (r % 16) * 32, (r / 16) * 64, scr, C.lane); continue; } r -= I_POOL;
        if (r < I_CK) { conv_tile(FPlain{AIN(a, 7) + (size_t)l * 2048 * 256, 256}, (bf16_t*)(wl + W_CK1), 2048, (r % 8) * 32, (r / 8) * 64, scr, C.lane); continue; } r -= I_CK;
        if (r < I_CK) { conv_tile(FPlain{AIN(a, 9) + (size_t)l * 2048 * 256, 256}, (bf16_t*)(wl + W_CV1), 2048, (r % 8) * 32, (r / 8) * 64, scr, C.lane); continue; } r -= I_CK;
        if (r < I_PP) { conv_tile(FPlain{AIN(a, 11) + (size_t)l * 512 * 1024, 1024}, (bf16_t*)(wl + W_PP), 512, (r % 32) * 32, (r / 32) * 64, scr, C.lane); continue; } r -= I_PP;
        if (r < I_PN) { conv_tile(FPlain{AIN(a, 12) + (size_t)l * 1024 * 1024, 1024}, (bf16_t*)(wl + W_PN), 1024, (r % 32) * 32, (r / 32) * 64, scr, C.lane); continue; } r -= I_PN;
        if (r < I_OUT) { conv_tile(FPlain{AIN(a, 13) + (size_t)l * 1024 * 1024, 1024}, (bf16_t*)(wl + W_OUT), 1024, (r % 32) * 32, (r / 32) * 64, scr, C.lane); continue; } r -= I_OUT;
        if (r < I_FF1) { conv_tile(FPlainG{AIN(a, 15) + (size_t)l * 1024 * 4096, 4096, AIN(a, 14) + (size_t)l * 1024}, (bf16_t*)(wl + W_FF1), 1024, (r % 128) * 32, (r / 128) * 64, scr, C.lane); continue; } r -= I_FF1;
        if (r < I_FF2) { conv_tile(FPlain{AIN(a, 16) + (size_t)l * 4096 * 1024, 1024}, (bf16_t*)(wl + W_FF2), 4096, (r % 32) * 32, (r / 32) * 64, scr, C.lane); continue; } r -= I_FF2;
        if (r < I_C2) { conv_tile(FPlain{AIN(a, 8) + (size_t)l * 256 * 64, 64}, (bf16_t*)(wl + W_CK2), 256, (r % 2) * 32, (r / 2) * 64, scr, C.lane); continue; } r -= I_C2;
        conv_tile(FPlain{AIN(a, 10) + (size_t)l * 256 * 64, 64}, (bf16_t*)(wl + W_CV2), 256, (r % 2) * 32, (r / 2) * 64, scr, C.lane);
    }
    { float* cb = (float*)(ws + WS_CBIAS);
      for (int it = C.gw; it < DEPTH * 512; it += C.NGW) { const int l = it >> 9, kv = (it >> 8) & 1, n = it & 255; const float* pe = AIN(a, kv ? 6 : 5) + (size_t)l * 2048; const float* w1 = AIN(a, kv ? 9 : 7) + (size_t)l * 2048 * 256;
          float s = 0.f; for (int kk = C.lane; kk < 2048; kk += 64) s += pe[kk] * w1[(size_t)kk * 256 + n];
          s = wave_sum(s); if (C.lane == 0) cb[it] = s; } }
    { const float* x = AIN(a, 0); bf16_t* XB = (bf16_t*)(ws + WS_XN); float* SS = (float*)(ws + WS_SS); const int lane = C.lane;
      for (int m = C.gw; m < MTOK; m += C.NGW) {
        const f32x4* xr = (const f32x4*)(x + (size_t)m * 1024) + lane; u32x2* o8 = (u32x2*)(XB + (size_t)m * 1024) + lane; float sq = 0.f;
#pragma unroll
        for (int j = 0; j < 4; ++j) { const f32x4 v = xr[64 * j]; sq += (v.x * v.x + v.y * v.y) + (v.z * v.z + v.w * v.w); u32x2 w; w.x = cvt_pk_bf16(v.x, v.y); w.y = cvt_pk_bf16(v.z, v.w); o8[64 * j] = w; }
        sq = wave_sum(sq); if (lane < 16) SS[(size_t)m * 16 + lane] = (lane == 0) ? sq : 0.f;
      } }
}

__device__ __forceinline__ constexpr int PIperm(int p) { return (p & ~12) | ((p & 8) >> 1) | ((p & 4) << 1); }
__device__ __forceinline__ void vt_tile(const bf16_t* src, bf16_t* dst, int lane) {
    unsigned pk[32];
#pragma unroll
    for (int pos = 0; pos < 64; pos += 2) { const int kv0 = PIperm(pos); const unsigned lo = src[kv0 * 64 + lane], hi = src[(kv0 + 1) * 64 + lane]; pk[pos >> 1] = lo | (hi << 16); }
    u32x4* d = (u32x4*)(dst + lane * 64);
#pragma unroll
    for (int j = 0; j < 8; ++j) d[j] = (u32x4){pk[4 * j], pk[4 * j + 1], pk[4 * j + 2], pk[4 * j + 3]};
}
__device__ __forceinline__ void ph_post(const Ctx& C, bool do_rope, const int pgw, const int pngw, bf16_t* Dbuf) {
    unsigned char* ws = C.ws; const int lane = C.lane;
    const float* rc = (const float*)(ws + WS_ROPEC); const float* rs = (const float*)(ws + WS_ROPES);
    if (do_rope) for (int it = pgw; it < 2 * 16 * 4096 / 8; it += pngw) {
        const int rr = it * 8 + (lane >> 3); bf16_t* base = (bf16_t*)(ws + (rr < 65536 ? WS_KS : WS_KW)); const int r = rr & 65535, t = r & 4095, d0 = (lane & 7) * 4;
        bf16_t* p = base + (size_t)r * 64 + d0; const u32x2 a = *(const u32x2*)p, b = *(const u32x2*)(p + 32);
        const f32x4 c = *(const f32x4*)(rc + t * 32 + d0), s = *(const f32x4*)(rs + t * 32 + d0);
        const float x1[4] = {bflo(a.x), bfhi(a.x), bflo(a.y), bfhi(a.y)}, x2[4] = {bflo(b.x), bfhi(b.x), bflo(b.y), bfhi(b.y)};
        float y1[4], y2[4];
#pragma unroll
        for (int i = 0; i < 4; ++i) { y1[i] = x1[i] * c[i] - x2[i] * s[i]; y2[i] = x2[i] * c[i] + x1[i] * s[i]; }
        u32x2 oa, ob; oa.x = cvt_pk_bf16(y1[0], y1[1]); oa.y = cvt_pk_bf16(y1[2], y1[3]); ob.x = cvt_pk_bf16(y2[0], y2[1]); ob.y = cvt_pk_bf16(y2[2], y2[3]);
        *(u32x2*)p = oa; *(u32x2*)(p + 32) = ob;
    }
    { const bf16_t* U = (const bf16_t*)(ws + WS_U); bf16_t* D = Dbuf;
#define UNPK8(NAME_, VEC_) const float NAME_[8] = {bflo(VEC_[0]), bfhi(VEC_[0]), bflo(VEC_[1]), bfhi(VEC_[1]), bflo(VEC_[2]), bfhi(VEC_[2]), bflo(VEC_[3]), bfhi(VEC_[3])}
      for (int it = pgw; it < MTOK / 32; it += pngw) {
        const int tt0 = it * 32, t0 = tt0 & 4095, w = 2 << (lane >> 4); const bf16_t* up = U + (size_t)tt0 * 512 + lane * 8; bf16_t* dp = D + (size_t)tt0 * 512 + lane * 8;
        float s[8] = {0.f, 0.f, 0.f, 0.f, 0.f, 0.f, 0.f, 0.f};
#pragma unroll
        for (int i = 1; i < 16; ++i) if (i < w && t0 - i >= 0) { const u32x4 v = *(const u32x4*)(up - (ptrdiff_t)i * 512); UNPK8(x, v);
#pragma unroll
            for (int j2 = 0; j2 < 8; ++j2) s[j2] += x[j2]; }
#pragma unroll 8
        for (int k = 0; k < 32; ++k) {
            const int t = t0 + k; const u32x4 v = *(const u32x4*)(up + (size_t)k * 512); UNPK8(x, v);
            const int cnt = (t + 1 < w) ? t + 1 : w; const float inv = 1.0f / (float)cnt; f32x4 d0, d1;
#pragma unroll
            for (int j2 = 0; j2 < 8; ++j2) s[j2] += x[j2];
#pragma unroll
            for (int j2 = 0; j2 < 4; ++j2) { d0[j2] = s[j2] * inv - x[j2]; d1[j2] = s[j2 + 4] * inv - x[j2 + 4]; }
            store8(dp + (size_t)k * 512, d0, d1);
            if (t - w + 1 >= 0) { const u32x4 vo = *(const u32x4*)(up + (ptrdiff_t)(k - w + 1) * 512); UNPK8(y, vo);
#pragma unroll
                for (int j2 = 0; j2 < 8; ++j2) s[j2] -= y[j2]; }
        }
      }
#undef UNPK8
    }
    for (int it = pgw; it < 2048; it += pngw) {
        const int which = it >> 10, ti = it & 1023;
        vt_tile((const bf16_t*)(ws + (which ? WS_VW : WS_VS)) + (size_t)ti * 4096, (bf16_t*)(ws + (which ? WS_VWT : WS_VST)) + (size_t)ti * 4096, lane);
    }
}

__device__ __forceinline__ constexpr int crow_c(int r) { return (r & 3) + 8 * (r >> 2); }
#define MFMA32(a, b, c) __builtin_amdgcn_mfma_f32_32x32x16_bf16((a), (b), (c), 0, 0, 0)
__device__ __forceinline__ void ph_cmp2(const Ctx& C, int l) {
    unsigned char* ws = C.ws; const int lane = C.lane, c = lane & 31, hh = lane >> 5;
    const float* rc = (const float*)(ws + WS_ROPEC); const float* rs = (const float*)(ws + WS_ROPES);
    for (int it = C.bx + C.G * C.wave; it < 256; it += C.G * 8) {
        const int kv = it >> 7, r0 = (it & 127) * 32;
        const bf16_t* hid = (const bf16_t*)(ws + (kv ? WS_HIDV : WS_HIDK)) + (size_t)(r0 + c) * 256 + hh * 8;
        const bf16_t* w2t = (const bf16_t*)(ws + WS_W + (size_t)l * WL_STRIDE + (kv ? W_CV2 : W_CK2)) + hh * 8;
        f32x16 a0 = (f32x16){}, a1 = (f32x16){};
#pragma unroll 4
        for (int ks = 0; ks < 16; ++ks) { const bf16x8 af = *(const bf16x8*)(hid + ks * 16), b0 = *(const bf16x8*)(w2t + (size_t)c * 256 + ks * 16), b1 = *(const bf16x8*)(w2t + (size_t)(c + 32) * 256 + ks * 16);
            a0 = MFMA32(af, b0, a0); a1 = MFMA32(af, b1, a1); }
#pragma unroll
        for (int r = 0; r < 16; ++r) { const int row = r0 + crow_c(r) + 4 * hh, bg = row >> 8, n = row & 255; float v0 = a0[r], v1 = a1[r];
            if (n == 255) { v0 = 0.f; v1 = 0.f; }
            if (kv == 0) { const int pos = (n == 255) ? 0 : 16 * n + 31; const float cc = rc[pos * 32 + c], sn = rs[pos * 32 + c];
                bf16_t* o = (bf16_t*)(ws + WS_CK) + (size_t)row * 64; o[c] = f2bf(v0 * cc - v1 * sn); o[c + 32] = f2bf(v1 * cc + v0 * sn); }
            else { bf16_t* o = (bf16_t*)(ws + WS_CVT) + (size_t)bg * 16384 + (n >> 6) * 4096 + PIperm(n & 63); o[c * 64] = f2bf(v0); o[(c + 32) * 64] = f2bf(v1); } }
    }
}

constexpr int AT_KB = 0, AT_VB = 18432, AT_SLAB = 36864, AT_SELM = AT_SLAB + 65536, AT_UNION = AT_SELM + 256, KPITCH = 144;
constexpr float SM_C = 0.125f * 1.4426950408889634f;
__device__ __forceinline__ void qk_tile(LAS const unsigned char* kb, const bf16x8 (&qf)[4], f32x16& p0, f32x16& p1, int lane) {
    LAS const unsigned char* ka = kb + (lane & 31) * KPITCH + (lane >> 5) * 16;
    p0 = (f32x16){}; p1 = (f32x16){};
#pragma unroll
    for (int ks = 0; ks < 4; ++ks) { const bf16x8 a0 = *(LAS const bf16x8*)(ka + ks * 32), a1 = *(LAS const bf16x8*)(ka + 32 * KPITCH + ks * 32);
        p0 = MFMA32(a0, qf[ks], p0); p1 = MFMA32(a1, qf[ks], p1); }
    __builtin_amdgcn_sched_group_barrier(0x100, 8, 0); __builtin_amdgcn_sched_group_barrier(0x008, 8, 0);
}
typedef float f32x2v __attribute__((ext_vector_type(2)));
__device__ __forceinline__ float fmax3(float a, float b, float c) { return fmaxf(fmaxf(a, b), c); }
struct ImpCtx { LAS float* row; float carry, mr0, mr1, mr2, mr3; };
template <bool IMP>
__device__ __forceinline__ void attn_tile(LAS const unsigned char* kb, LAS const unsigned char* vb, const bf16x8 (&qf)[4], float& m, float& l, f32x16& o0, f32x16& o1, int lo, int hi_, int lane, ImpCtx& ic, int T) {
    const int hh = lane >> 5; f32x16 p0, p1;
    qk_tile(kb, qf, p0, p1, lane);
    const bool lane_full = (lo <= 0) && (hi_ >= 63), lane_empty = lo > hi_;
    const bool simple = __all((lane_full || lane_empty) ? 1 : 0) != 0;
    if (!simple) { const int lo2 = lo - 4 * hh, hi2 = hi_ - 4 * hh;
#pragma unroll
        for (int r = 0; r < 16; ++r) { const int c0 = crow_c(r), c1 = c0 + 32; p0[r] = (c0 >= lo2 && c0 <= hi2) ? p0[r] : -INFINITY; p1[r] = (c1 >= lo2 && c1 <= hi2) ? p1[r] : -INFINITY; } }
    float mxa = fmax3(p0[0], p0[1], p1[0]), mxb = fmax3(p0[2], p0[3], p1[1]); mxa = fmax3(mxa, p1[2], p1[3]);
#pragma unroll
    for (int r = 4; r < 16; r += 4) { mxa = fmax3(mxa, p0[r], p0[r + 1]); mxb = fmax3(mxb, p0[r + 2], p0[r + 3]); mxa = fmax3(mxa, p1[r], p1[r + 1]); mxb = fmax3(mxb, p1[r + 2], p1[r + 3]); }
    float mx = fmaxf(mxa, mxb);
    const bool dead = simple && lane_empty;
    if (dead) mx = -INFINITY;
    mx = fmaxf(mx, __shfl_xor(mx, 32));
    const float mx2 = mx * SM_C;
    if (__any((mx2 > m + 8.0f) ? 1 : 0)) {
        const float mn = fmaxf(m, mx2), alpha = __builtin_amdgcn_exp2f(m - mn);
        l *= alpha; m = mn; if (IMP) ic.carry *= alpha;
#pragma unroll
        for (int r = 0; r < 16; ++r) { o0[r] *= alpha; o1[r] *= alpha; }
    }
    const float neg = dead ? -INFINITY : -m;
    float sa = 0.f, sb = 0.f;
#pragma unroll
    for (int r = 0; r < 16; r += 2) {
        p0[r] = __builtin_amdgcn_exp2f(__builtin_fmaf(p0[r], SM_C, neg)); p0[r + 1] = __builtin_amdgcn_exp2f(__builtin_fmaf(p0[r + 1], SM_C, neg));
        p1[r] = __builtin_amdgcn_exp2f(__builtin_fmaf(p1[r], SM_C, neg)); p1[r + 1] = __builtin_amdgcn_exp2f(__builtin_fmaf(p1[r + 1], SM_C, neg));
        sa += p0[r] + p0[r + 1]; sb += p1[r] + p1[r + 1];
    }
    l += sa + sb;
    if (IMP) {
        float g4[8], last[8], oth[8];
#pragma unroll
        for (int i = 0; i < 8; ++i) { const int r0 = 4 * (i & 3); if (i < 4) { g4[i] = (p0[r0] + p0[r0 + 1]) + (p0[r0 + 2] + p0[r0 + 3]); last[i] = p0[r0 + 3]; } else { g4[i] = (p1[r0] + p1[r0 + 1]) + (p1[r0 + 2] + p1[r0 + 3]); last[i] = p1[r0 + 3]; } }
#pragma unroll
        for (int i = 0; i < 8; ++i) oth[i] = __shfl_xor(last[i], 32);
#pragma unroll
        for (int i = 0; i < 8; ++i) { const float add = hh ? oth[i] : (i ? oth[i > 0 ? i - 1 : 0] : ic.carry); ic.row[16 * T + 2 * i + hh] = g4[i] + add; }
        ic.carry = oth[7];
        ic.mr0 = (T == 0) ? m : ic.mr0; ic.mr1 = (T == 1) ? m : ic.mr1; ic.mr2 = (T == 2) ? m : ic.mr2; ic.mr3 = (T == 3) ? m : ic.mr3;
    }
    bf16x8 pf[4];
#pragma unroll
    for (int s = 0; s < 2; ++s) {
        u32x4 w0, w1;
        w0.x = cvt_pk_bf16(p0[8 * s + 0], p0[8 * s + 1]); w0.y = cvt_pk_bf16(p0[8 * s + 2], p0[8 * s + 3]); w0.z = cvt_pk_bf16(p0[8 * s + 4], p0[8 * s + 5]); w0.w = cvt_pk_bf16(p0[8 * s + 6], p0[8 * s + 7]);
        w1.x = cvt_pk_bf16(p1[8 * s + 0], p1[8 * s + 1]); w1.y = cvt_pk_bf16(p1[8 * s + 2], p1[8 * s + 3]); w1.z = cvt_pk_bf16(p1[8 * s + 4], p1[8 * s + 5]); w1.w = cvt_pk_bf16(p1[8 * s + 6], p1[8 * s + 7]);
        pf[s] = __builtin_bit_cast(bf16x8, w0); pf[2 + s] = __builtin_bit_cast(bf16x8, w1);
    }
    LAS const unsigned char* va = vb + (lane & 31) * KPITCH + hh * 16;
#pragma unroll
    for (int ts = 0; ts < 4; ++ts) {
        const bf16x8 v0 = *(LAS const bf16x8*)(va + ts * 32), v1 = *(LAS const bf16x8*)(va + 32 * KPITCH + ts * 32);
        o0 = MFMA32(v0, pf[ts], o0); o1 = MFMA32(v1, pf[ts], o1);
    }
    __builtin_amdgcn_sched_group_barrier(0x100, 8, 1); __builtin_amdgcn_sched_group_barrier(0x008, 8, 1);
}
template <int MODE>
__device__ __forceinline__ void run_branch(LAS unsigned char* lds, const unsigned char* Kg, const unsigned char* Vg, unsigned long long tiles, const bf16x8 (&qf)[4],
                                           float& m, float& l, f32x16& o0, f32x16& o1, int cur, int tq, int nvalid, unsigned long long selm, int tid, int lane, ImpCtx& ic) {
    const int soff = (tid >> 3) * KPITCH + (tid & 7) * 16;
    unsigned long long rem = tiles;
    int T = __ffsll(rem) - 1; rem &= rem - 1;
    u32x4 kr = *(const u32x4*)(Kg + (size_t)T * 8192 + tid * 16), vr = *(const u32x4*)(Vg + (size_t)T * 8192 + tid * 16);
    *(LAS u32x4*)(lds + AT_KB + soff) = kr; *(LAS u32x4*)(lds + AT_VB + soff) = vr;
    __syncthreads();
    int bi = 0;
    for (;;) {
        const bool more = rem != 0ull;
        const int Tn = more ? (__ffsll(rem) - 1) : T; rem &= rem - 1;
        kr = *(const u32x4*)(Kg + (size_t)Tn * 8192 + tid * 16); vr = *(const u32x4*)(Vg + (size_t)Tn * 8192 + tid * 16);
        int lo, hi_;
        if (MODE == 0) { lo = 0; hi_ = nvalid - 64 * T - 1; }
        else if (MODE == 1) { const bool sb = ((selm >> T) & 1ull) != 0; lo = sb ? 0 : 1; hi_ = sb ? (T < cur ? 63 : tq) : 0; }
        else { lo = (T == cur - 8) ? tq + 1 : 0; hi_ = (T == cur) ? tq : 63; }
        attn_tile<MODE == 0>(lds + AT_KB + bi * 9216, lds + AT_VB + bi * 9216, qf, m, l, o0, o1, lo, hi_, lane, ic, T);
        *(LAS u32x4*)(lds + AT_KB + (bi ^ 1) * 9216 + soff) = kr; *(LAS u32x4*)(lds + AT_VB + (bi ^ 1) * 9216 + soff) = vr;
        __syncthreads();
        if (!more) break;
        T = Tn; bi ^= 1;
    }
}
__device__ __forceinline__ void ph_attn(const Ctx& C, size_t yoff) {
    unsigned char* ws = C.ws; LAS unsigned char* lds = C.lds; const int tid = C.tid, lane = C.lane, w = C.wave, q = lane & 31, hh = lane >> 5;
    bf16_t* Q = (bf16_t*)(ws + WS_Q); const bf16_t* GN = (const bf16_t*)(ws + WS_GNSA);
    LAS float* slab = (LAS float*)(lds + AT_SLAB); LAS unsigned long long* selmp = (LAS unsigned long long*)(lds + AT_SELM); LAS unsigned* unionp = (LAS unsigned*)(lds + AT_UNION);
    const int vcu = (C.G % 8 == 0) ? (C.bx % 8) * (C.G / 8) + C.bx / 8 : C.bx;
    for (int it = vcu; it < 2048; it += C.G) {
        int bg, qb;
        if (C.G == 256) { const int i = it >> 8, v = it & 255, s = v & 15; bg = v >> 4; qb = 32 * (i >> 1) + ((i & 1) ? 31 - s : s); }
        else { bg = it & 15; qb = it >> 4; }
        const int b = bg >> 1, g = bg & 1, h = g * 8 + w, t0 = qb * 32, cur = t0 >> 6, t = t0 + q, tq = t & 63;
        const size_t tokrow = (size_t)b * 4096 + t;
        bf16_t* qp = Q + tokrow * 1024 + h * 64;
        bf16x8 qf[4];
#pragma unroll
        for (int ks = 0; ks < 4; ++ks) qf[ks] = *(const bf16x8*)(qp + ks * 16 + hh * 8);
        { const float* rcp = (const float*)(ws + WS_ROPEC) + t * 32 + hh * 8; const float* rsp = (const float*)(ws + WS_ROPES) + t * 32 + hh * 8;
#pragma unroll
          for (int ks = 0; ks < 2; ++ks) { const f32x4 c0 = *(const f32x4*)(rcp + ks * 16), c1 = *(const f32x4*)(rcp + ks * 16 + 4), s0 = *(const f32x4*)(rsp + ks * 16), s1 = *(const f32x4*)(rsp + ks * 16 + 4);
              const u32x4 xa = __builtin_bit_cast(u32x4, qf[ks]), xb = __builtin_bit_cast(u32x4, qf[ks + 2]);
              const float x1[8] = {bflo(xa.x), bfhi(xa.x), bflo(xa.y), bfhi(xa.y), bflo(xa.z), bfhi(xa.z), bflo(xa.w), bfhi(xa.w)}, x2[8] = {bflo(xb.x), bfhi(xb.x), bflo(xb.y), bfhi(xb.y), bflo(xb.z), bfhi(xb.z), bflo(xb.w), bfhi(xb.w)};
              const float cc[8] = {c0[0], c0[1], c0[2], c0[3], c1[0], c1[1], c1[2], c1[3]}, sn[8] = {s0[0], s0[1], s0[2], s0[3], s1[0], s1[1], s1[2], s1[3]};
              float y1[8], y2[8];
#pragma unroll
              for (int i = 0; i < 8; ++i) { y1[i] = x1[i] * cc[i] - x2[i] * sn[i]; y2[i] = x2[i] * cc[i] + x1[i] * sn[i]; }
              u32x4 oa, ob; oa.x = cvt_pk_bf16(y1[0], y1[1]); oa.y = cvt_pk_bf16(y1[2], y1[3]); oa.z = cvt_pk_bf16(y1[4], y1[5]); oa.w = cvt_pk_bf16(y1[6], y1[7]);
              ob.x = cvt_pk_bf16(y2[0], y2[1]); ob.y = cvt_pk_bf16(y2[2], y2[3]); ob.z = cvt_pk_bf16(y2[4], y2[5]); ob.w = cvt_pk_bf16(y2[6], y2[7]);
              qf[ks] = __builtin_bit_cast(bf16x8, oa); qf[ks + 2] = __builtin_bit_cast(bf16x8, ob); } }
        const float gc = bf2f(GN[tokrow * 64 + h * 3 + 0]), gs = bf2f(GN[tokrow * 64 + h * 3 + 1]), gwn = bf2f(GN[tokrow * 64 + h * 3 + 2]);
        if (tid == 0) { unionp[0] = 0u; unionp[1] = 0u; }
        const int nvalid = (t >= 31) ? ((t - 15) >> 4) : 0; const int nvmax = (t0 + 16) >> 4; const int ntile = (nvmax + 63) >> 6;
        const unsigned char* CKg = ws + WS_CK + (size_t)bg * 32768; const unsigned char* CVg = ws + WS_CVT + (size_t)bg * 32768;
        float m = -1e30f, l = 0.f; f32x16 o0 = (f32x16){}, o1 = (f32x16){};
        ImpCtx ic; ic.row = slab + (w * 32 + q) * 64; ic.carry = 0.f; ic.mr0 = ic.mr1 = ic.mr2 = ic.mr3 = -1e30f;
        run_branch<0>(lds, CKg, CVg, (1ull << ntile) - 1ull, qf, m, l, o0, o1, cur, tq, nvalid, 0ull, tid, lane, ic);
        l += __shfl_xor(l, 32);
        const float invl = (l > 0.f) ? 1.0f / l : 0.f;
        f32x16 out0 = o0 * (gc * invl), out1 = o1 * (gc * invl);
        {
#pragma unroll
          for (int T = 0; T < 4; ++T) if (T < ntile) { const float mrT = (T == 0) ? ic.mr0 : (T == 1) ? ic.mr1 : (T == 2) ? ic.mr2 : ic.mr3; const float f = __builtin_amdgcn_exp2f(mrT - m) * invl;
#pragma unroll
              for (int i = 0; i < 8; ++i) ic.row[16 * T + 2 * i + hh] *= f; }
          __syncthreads(); }
#pragma unroll 1
        for (int qq = 0; qq < 4; ++qq) {
            const int qi = 4 * w + qq, J = lane; float v = 0.f;
#pragma unroll
            for (int w2 = 0; w2 < 8; ++w2) v += slab[(w2 * 32 + qi) * 64 + J];
            const bool cand = (J >= 1) && (J <= cur - 2);
            if (!cand) v = -1.0f;
            bool selc = cand;
            if (cur - 2 > 13) { int cnt = 0; const int vb = __float_as_int(v);
#pragma unroll 8
                for (int j2 = 0; j2 < 64; ++j2) { const float vj = __int_as_float(__builtin_amdgcn_readlane(vb, j2)); cnt += ((vj > v) || (vj == v && j2 < J)) ? 1 : 0; }
                selc = cand && (cnt < 13); }
            const bool forced = (J <= cur) && (J == 0 || J >= cur - 1);
            const unsigned long long mk = __ballot((selc || forced) ? 1 : 0);
            if (lane == 0) { selmp[qi] = mk; atomicOr((unsigned*)&unionp[0], (unsigned)mk); atomicOr((unsigned*)&unionp[1], (unsigned)(mk >> 32)); }
        }
        __syncthreads();
        const unsigned long long selm = selmp[q];
        const unsigned ulo = __builtin_amdgcn_readfirstlane(unionp[0]), uhi = __builtin_amdgcn_readfirstlane(unionp[1]);
        const unsigned long long uni = ((unsigned long long)uhi << 32) | ulo;
        m = -1e30f; l = 0.f; o0 = (f32x16){}; o1 = (f32x16){};
        run_branch<1>(lds, ws + WS_KS + (size_t)bg * 524288, ws + WS_VST + (size_t)bg * 524288, uni, qf, m, l, o0, o1, cur, tq, 0, selm, tid, lane, ic);
        { l += __shfl_xor(l, 32); const float f = gs / l; out0 += o0 * f; out1 += o1 * f; }
        m = -1e30f; l = 0.f; o0 = (f32x16){}; o1 = (f32x16){};
        { const int j0 = cur - 8 > 0 ? cur - 8 : 0; const unsigned long long wm = ((cur == 63) ? ~0ull : ((1ull << (cur + 1)) - 1ull)) & ~((1ull << j0) - 1ull);
          run_branch<2>(lds, ws + WS_KW + (size_t)bg * 524288, ws + WS_VWT + (size_t)bg * 524288, wm, qf, m, l, o0, o1, cur, tq, 0, 0ull, tid, lane, ic); }
        { l += __shfl_xor(l, 32); const float f = gwn / l; out0 += o0 * f; out1 += o1 * f; }
#pragma unroll
        for (int i = 0; i < 4; ++i) {
            u32x2 a0, a1; a0.x = cvt_pk_bf16(out0[4 * i], out0[4 * i + 1]); a0.y = cvt_pk_bf16(out0[4 * i + 2], out0[4 * i + 3]); a1.x = cvt_pk_bf16(out1[4 * i], out1[4 * i + 1]); a1.y = cvt_pk_bf16(out1[4 * i + 2], out1[4 * i + 3]);
            bf16_t* yp = (bf16_t*)((unsigned char*)qp + yoff); *(u32x2*)(yp + 8 * i + 4 * hh) = a0; *(u32x2*)(yp + 32 + 8 * i + 4 * hh) = a1;
        }
    }
}

constexpr int NPHASE = 8 * DEPTH + 3;
#ifndef ONLY_MASK
#define ONLY_MASK 0xffff
#endif
#define HAS(k) ((ONLY_MASK >> (k)) & 1)
__global__ void __launch_bounds__(512, 2) mega_fwd(Args a) {
    extern __shared__ __attribute__((aligned(16))) unsigned char lds_raw[];
    Ctx C; C.lds = (LAS unsigned char*)lds_raw; C.ws = a.ws; C.tid = threadIdx.x; C.lane = C.tid & 63; C.wave = __builtin_amdgcn_readfirstlane(C.tid >> 6);
    C.G = gridDim.x; C.bx = blockIdx.x; C.gw = C.bx * 8 + C.wave; C.NGW = C.G * 8;
    cg::grid_group grid = cg::this_grid();
    { volatile LAS unsigned* st = (volatile LAS unsigned*)(C.lds + LDS_BYTES - 64); if (C.tid < 16) st[C.tid] = 0u; __syncthreads(); }
    XcdBarrier xbar = xcd_barrier_post((unsigned*)(a.ws + WS_BAR), (volatile LAS unsigned*)(C.lds + LDS_BYTES - 64));
    unsigned char* ws = a.ws; float* X = a.out;
    int ph = 0;
#define IN_PH() (ph >= a.ph_lo && ph < a.ph_hi)
#define FRESH() do { int t_ = threadIdx.x; asm volatile("" : "+v"(t_)); C.tid = t_; C.lane = t_ & 63; C.wave = __builtin_amdgcn_readfirstlane(t_ >> 6); C.gw = C.bx * 8 + C.wave; \
    unsigned wl_ = __builtin_amdgcn_readfirstlane((unsigned)(unsigned long long)a.ws), wh_ = __builtin_amdgcn_readfirstlane((unsigned)((unsigned long long)a.ws >> 32)); asm volatile("" : "+s"(wl_), "+s"(wh_)); \
    ws = (unsigned char*)(GAS1 unsigned char*)(((unsigned long long)wh_ << 32) | wl_); C.ws = ws; \
    unsigned xl_ = __builtin_amdgcn_readfirstlane((unsigned)(unsigned long long)a.out), xh_ = __builtin_amdgcn_readfirstlane((unsigned)((unsigned long long)a.out >> 32)); asm volatile("" : "+s"(xl_), "+s"(xh_)); \
    X = (float*)(GAS1 float*)(((unsigned long long)xh_ << 32) | xl_); } while (0)
#define SEAM() do { ++ph; if (ph > a.ph_lo && ph < a.ph_hi) { if (ph == 1) grid.sync(); else xcd_barrier(xbar); } FRESH(); } while (0)
    FRESH();
    if (HAS(0) && IN_PH()) ph_prologue(a, C);
    SEAM();
    if (IN_PH() && C.bx < 8 * DEPTH) {
        const int l = C.bx >> 3; unsigned char* wl = ws + WS_W + (size_t)l * WL_STRIDE;
        EpiP<OpBf16> E{OpBf16{(bf16_t*)(ws + WS_PPF) + (size_t)l * 1024 * 512, 512}, nullptr};
        run_gemm(C.lds, (const bf16_t*)(wl + W_PP), 512, (const bf16_t*)(wl + W_POOL), 1024, 512, 512, E, 8, C.bx & 7);
    }
    SEAM();
    for (int l = 0; l < DEPTH; ++l) {
        const float* xin = (l == 0) ? AIN(a, 0) : X;
        unsigned char* wl = ws + WS_W + (size_t)l * WL_STRIDE;
        if (HAS(1) && IN_PH()) {
            EpiP<OpProj, true> E{OpProj{ws}, (const float*)(ws + WS_SS)};
            run_gemm(C.lds, (const bf16_t*)(ws + WS_XN), 1024, (const bf16_t*)(wl + W_IN), MTOK, NPAD, 1024, E, C.G, C.bx);
        }
        SEAM();
        if (IN_PH()) {
            const int ncc = (C.G >= 64) ? 32 : 0;
            if (HAS(2) && (ncc == 0 || C.bx >= ncc)) ph_post(C, true, (C.bx - ncc) * 8 + C.wave, (C.G - ncc) * 8, (bf16_t*)X);
            FRESH(); wl = ws + WS_W + (size_t)l * WL_STRIDE;
            if (HAS(4) && (ncc == 0 || C.bx < 16)) { EpiP<OpCmp1> E{OpCmp1{(bf16_t*)(ws + WS_HIDK), (const float*)(ws + WS_CBIAS) + l * 512}, nullptr}; run_gemm(C.lds, (const bf16_t*)(ws + WS_KC), 1024, (const bf16_t*)(wl + W_CK1), 4096, 256, 2048, E, ncc ? 16 : C.G, C.bx); }
            FRESH(); wl = ws + WS_W + (size_t)l * WL_STRIDE;
            if (HAS(5) && (ncc == 0 || (C.bx >= 16 && C.bx < 32))) { EpiP<OpCmp1> E{OpCmp1{(bf16_t*)(ws + WS_HIDV), (const float*)(ws + WS_CBIAS) + l * 512 + 256}, nullptr}; run_gemm(C.lds, (const bf16_t*)(ws + WS_VC), 1024, (const bf16_t*)(wl + W_CV1), 4096, 256, 2048, E, ncc ? 16 : C.G, ncc ? C.bx - 16 : C.bx); }
        }
        SEAM();
        wl = ws + WS_W + (size_t)l * WL_STRIDE;
        if (IN_PH()) {
            FRESH();
            if (HAS(6)) ph_cmp2(C, l);
        }
        SEAM();
        if (HAS(7) && IN_PH()) ph_attn(C, 0);
        SEAM();
        wl = ws + WS_W + (size_t)l * WL_STRIDE;
        if (IN_PH()) {
            if (HAS(8)) { EpiP<OpMerge1> E{OpMerge1{ws + WS_GM, (bf16_t*)(ws + WS_GM + 64 * MiB)}, nullptr}; run_gemm(C.lds, (const bf16_t*)X, 512, (const bf16_t*)(ws + WS_PPF) + (size_t)l * 1024 * 512, MTOK, 1024, 512, E, C.G, C.bx); }
            FRESH(); wl = ws + WS_W + (size_t)l * WL_STRIDE;
            if (HAS(9)) { EpiP<OpMerge2> E{OpMerge2{ws + WS_GM, (bf16_t*)(ws + WS_GM + 64 * MiB)}, nullptr}; run_gemm(C.lds, (const bf16_t*)(ws + WS_Q), 1024, (const bf16_t*)(wl + W_PN), MTOK, 1024, 1024, E, C.G, C.bx); }
        }
        SEAM();
        wl = ws + WS_W + (size_t)l * WL_STRIDE;
        if (HAS(10) && IN_PH()) { EpiResid E{(bf16_t*)(ws + WS_XN), (float*)(ws + WS_SS)}; run_gemm(C.lds, (const bf16_t*)(ws + WS_GM + 64 * MiB), 1024, (const bf16_t*)(wl + W_OUT), MTOK, 1024, 1024, E, C.G, C.bx); }
        SEAM();
        wl = ws + WS_W + (size_t)l * WL_STRIDE;
        if (HAS(11) && IN_PH()) { EpiP<OpFF1, true> E{OpFF1{(bf16_t*)(ws + WS_H)}, (const float*)(ws + WS_SS)}; run_gemm(C.lds, (const bf16_t*)(ws + WS_XN), 1024, (const bf16_t*)(wl + W_FF1), MTOK, DFF, 1024, E, C.G, C.bx); }
        SEAM();
        wl = ws + WS_W + (size_t)l * WL_STRIDE;
        if (HAS(12) && IN_PH()) { EpiResid E{(bf16_t*)(ws + WS_XN), (float*)(ws + WS_SS)}; run_gemm(C.lds, (const bf16_t*)(ws + WS_H), 4096, (const bf16_t*)(wl + W_FF2), MTOK, 1024, DFF, E, C.G, C.bx); }
        SEAM();
    }
    if (IN_PH()) { for (int m = C.gw; m < MTOK; m += C.NGW) rms_row_out((const bf16_t*)(ws + WS_XN) + (size_t)m * 1024, AIN(a, 17), X + (size_t)m * 1024, C.lane); }
#undef IN_PH
#undef SEAM
}

#ifndef MK_PER_PHASE
#define MK_PER_PHASE 0
#endif
extern "C" void kernel_launch(void* const* d_in, const int* in_sizes, int n_in, void* d_out, int out_size, void* d_ws, size_t ws_size, hipStream_t stream) {
    static int grid = 0;
    if (grid == 0) {
        if (n_in != 18 || out_size != MTOK * DM || ws_size < WS_END) { fprintf(stderr, "kernel_launch: unexpected shapes (n_in %d out %d ws %zu)\n", n_in, out_size, ws_size); grid = -1; return; }
        int dev = 0, cus = 0, per_cu = 0;
        (void)hipGetDevice(&dev); (void)hipDeviceGetAttribute(&cus, hipDeviceAttributeMultiprocessorCount, dev);
        if (hipFuncSetAttribute((const void*)mega_fwd, hipFuncAttributeMaxDynamicSharedMemorySize, LDS_BYTES) != hipSuccess) { fprintf(stderr, "kernel_launch: hipFuncSetAttribute failed\n"); grid = -1; return; }
        if (hipOccupancyMaxActiveBlocksPerMultiprocessor(&per_cu, (const void*)mega_fwd, 512, LDS_BYTES) != hipSuccess || per_cu < 1) { fprintf(stderr, "kernel_launch: occupancy query %d\n", per_cu); per_cu = 1; }
        (void)hipGetLastError();
        grid = cus * (per_cu > 1 ? 1 : per_cu);
        if (grid <= 0) grid = 256;
    }
    if (grid < 0) return;
    Args a{};
    for (int i = 0; i < 18; ++i) a.in[i] = (const float*)d_in[i];
    a.out = (float*)d_out; a.ws = (unsigned char*)d_ws;
    for (int i = 0; i < 32; ++i) a.invf[i] = pow(10000.0, -(double)(2 * i) / 64.0);
#if MK_PER_PHASE
    for (int p = 0; p < NPHASE; ++p) { a.ph_lo = p; a.ph_hi = p + 1; hipLaunchKernelGGL(mega_fwd, dim3(grid), dim3(512), LDS_BYTES, stream, a); }
#else
    a.ph_lo = 0; a.ph_hi = NPHASE;
    (void)hipMemsetAsync((unsigned char*)d_ws + WS_BAR, 0, 16384, stream);
    void* args[] = {&a};
    hipError_t e = hipLaunchCooperativeKernel((const void*)mega_fwd, dim3(grid), dim3(512), args, LDS_BYTES, stream);
    if (e != hipSuccess) fprintf(stderr, "cooperative launch failed: %s (grid %d)\n", hipGetErrorString(e), grid);
#endif
}
```

```cpp
#include <hip/hip_runtime.h>
#include <hip/hip_cooperative_groups.h>
#include <cstdio>
#include <cstdint>
#include <cmath>
#include <type_traits>
namespace cg = cooperative_groups;
namespace pg8 {
#define PG8_LAS __attribute__((address_space(3)))
typedef unsigned short bf16_t;
typedef short bf16x8 __attribute__((ext_vector_type(8)));
typedef float f32x4 __attribute__((ext_vector_type(4)));
typedef unsigned u32x4 __attribute__((ext_vector_type(4)));
constexpr int BM = 256, BK = 64, HALF = 128, HTB = HALF * BK * 2  , STAGE_BYTES = 8 * HTB, NXCD = 8, WGM = 8;

__host__ __device__ __forceinline__ int lds_byte(int r, int c) { const int st = (r >> 4) * 2 + (c >> 5), rr = r & 15, cc = c & 31, ob = rr * 64 + cc * 2; return st * 1024 + (ob ^ (((ob >> 9) & 1) << 5)); }
__host__ __device__ __forceinline__ void stage_rc(int b, int& R, int& C) { const int st = b / 1024, sb = b % 1024, swz = sb ^ (((sb >> 9) & 1) << 5); R = (st >> 1) * 16 + swz / 64; C = (st & 1) * 32 + (swz % 64) / 2; }
__host__ __device__ __forceinline__ int perm32(int rho) { const int n = rho >> 4, i = rho & 15; return 8 * (i >> 2) + 4 * n + (i & 3); }

struct Unit { int pm, pn; };
struct Gemm { const bf16_t* A; const bf16_t* Bt; int M, N, K, lda; };

struct StaticOrder {
    int nM, nN, nwg, G, c;
    __host__ __device__ void init(int M, int N, int G_, int c_) { nM = M / BM; nN = N / BM; nwg = nM * nN; G = G_; c = c_; }
    __host__ __device__ bool next(int i, Unit& u) const {
        const long L = (long)i * G + c; if (L >= nwg) return false;
        int wgid = (int)L; { const int q = nwg / NXCD, r = nwg % NXCD, xcd = wgid % NXCD, off = wgid / NXCD; wgid = (xcd < r ? xcd * (q + 1) : r * (q + 1) + (xcd - r) * q) + off; }
        const int nig = WGM * nN, gid = wgid / nig, fm = gid * WGM, gsz = (nM - fm) < WGM ? (nM - fm) : WGM;
        u.pm = fm + ((wgid % nig) % gsz); u.pn = (wgid % nig) / gsz; return true;
    }
    __device__ __forceinline__ void a_ready(const Unit&) const {}
    __device__ __forceinline__ void done(const Unit&) const {}
};

__device__ __forceinline__ unsigned cvt_pk_bf16(float lo, float hi) { unsigned r; asm volatile("v_cvt_pk_bf16_f32 %0, %1, %2" : "=v"(r) : "v"(lo), "v"(hi)); return r; }
typedef float f32x2 __attribute__((ext_vector_type(2)));
template <class Epi, class Sched, bool ALIGN_EPI = false, bool SP2 = false>
__device__ __forceinline__ void gemm_phase(PG8_LAS unsigned char* lds, const Gemm g, const Sched& S, const Epi& E) {
    int tid_ = threadIdx.x; asm volatile("" : "+v"(tid_));
    const int tid = tid_, wid = __builtin_amdgcn_readfirstlane(tid >> 6), lane = tid & 63, wr = wid >> 2, wc = wid & 3, fr = lane & 15, fq = lane >> 4;
    const int K = g.K, nt = K / BK;
    unsigned voffA[2], voffB[2];
#pragma unroll
    for (int i = 0; i < 2; ++i) { int R, C; stage_rc(tid * 16 + i * 8192, R, C); const int Rb = Epi::PERM ? ((R & ~31) + perm32(R & 31)) : R;
        voffA[i] = (unsigned)(R * g.lda + C) * 2u; voffB[i] = (unsigned)(Rb * K + C) * 2u; }
    const size_t kstep = (size_t)(BK * 2);
    const size_t hstepB = (size_t)HALF * K * 2, hstepA = (size_t)HALF * g.lda * 2;
    const size_t tstepA = 2 * hstepA, tstepB = 2 * hstepB;
    const unsigned ldsw = (unsigned)wid * 1024u;
    const int aoff = lds_byte(wr * 64 + fr, fq * 8), boff = lds_byte(wc * 32 + fr, fq * 8);
#define PG8_SA(b, h) (((b) * 2 + (h)) * HTB)
#define PG8_SB(b, h) ((4 + (b) * 2 + (h)) * HTB)
#define PG8_STAGE(bufoff, gbase, voff) do { _Pragma("unroll") for (int _i = 0; _i < 2; ++_i) \
        __builtin_amdgcn_global_load_lds((const unsigned*)((const char*)(gbase) + (voff)[_i]), (PG8_LAS unsigned*)(lds + (bufoff) + ldsw + _i * 8192), 16, 0, 0); } while (0)
#define PG8_LDA(dst, b, h) do { _Pragma("unroll") for (int m = 0; m < 4; ++m) _Pragma("unroll") for (int k = 0; k < 2; ++k) dst[m][k] = *(const PG8_LAS bf16x8*)(lds + PG8_SA(b, h) + aoff + m * 2048 + k * 1024); } while (0)
#define PG8_LDB(dst, b, h) do { _Pragma("unroll") for (int n = 0; n < 2; ++n) _Pragma("unroll") for (int k = 0; k < 2; ++k) dst[n][k] = *(const PG8_LAS bf16x8*)(lds + PG8_SB(b, h) + boff + n * 2048 + k * 1024); } while (0)
#define PG8_MMA(ai, bj, At, Bt) do { __builtin_amdgcn_s_setprio(1); _Pragma("unroll") for (int m = 0; m < 4; ++m) _Pragma("unroll") for (int n = 0; n < 2; ++n) _Pragma("unroll") for (int k = 0; k < 2; ++k) \
        acc[ai][bj][m][n] = __builtin_amdgcn_mfma_f32_16x16x32_bf16(Bt[n][k], At[m][k], acc[ai][bj][m][n], 0, 0, 0); __builtin_amdgcn_s_setprio(0); } while (0)
#define PG8_WAIT_V(n) asm volatile("s_waitcnt vmcnt(" #n ")" ::: "memory")
#define PG8_WAIT_L(n) asm volatile("s_waitcnt lgkmcnt(" #n ")" ::: "memory")
#define PG8_BAR __builtin_amdgcn_s_barrier()
#define PG8_SCHED __builtin_amdgcn_sched_barrier(0)
    Unit cur, nxt; int ui = 0;
    if (!S.next(0, cur)) return;
    f32x4 acc[2][2][4][2];
#pragma unroll
    for (int a = 0; a < 2; ++a)
#pragma unroll
        for (int b = 0; b < 2; ++b)
#pragma unroll
            for (int m = 0; m < 4; ++m)
#pragma unroll
                for (int n = 0; n < 2; ++n) acc[a][b][m][n] = (f32x4){0.f, 0.f, 0.f, 0.f};
    bf16x8 At[4][2], B0[2][2], B1[2][2];
    const char* cA = (const char*)g.A + (size_t)cur.pm * tstepA; const char* cB = (const char*)g.Bt + (size_t)cur.pn * tstepB;
    S.a_ready(cur);
    if constexpr (SP2) {
        PG8_STAGE(PG8_SB(0, 0), cB, voffB); PG8_STAGE(PG8_SB(0, 1), cB + hstepB, voffB); PG8_STAGE(PG8_SA(0, 0), cA, voffA); PG8_STAGE(PG8_SA(0, 1), cA + hstepA, voffA);
        if (wr == 1) PG8_BAR;
        PG8_WAIT_V(2); PG8_BAR;
        PG8_STAGE(PG8_SB(1, 0), cB + kstep, voffB); PG8_STAGE(PG8_SA(1, 0), cA + kstep, voffA); PG8_STAGE(PG8_SB(1, 1), cB + hstepB + kstep, voffB);
        PG8_WAIT_V(6); PG8_BAR;
    } else {
        PG8_STAGE(PG8_SB(0, 0), cB, voffB); PG8_STAGE(PG8_SA(0, 0), cA, voffA); PG8_STAGE(PG8_SB(0, 1), cB + hstepB, voffB); PG8_STAGE(PG8_SA(0, 1), cA + hstepA, voffA);
        if (wr == 1) PG8_BAR;
        PG8_WAIT_V(4); PG8_BAR;
        PG8_STAGE(PG8_SB(1, 0), cB + kstep, voffB); PG8_STAGE(PG8_SA(1, 0), cA + kstep, voffA); PG8_STAGE(PG8_SB(1, 1), cB + hstepB + kstep, voffB);
        PG8_WAIT_V(6); PG8_BAR;
    }
    for (;;) {
        const bool has_next = S.next(ui + 1, nxt);
        const char* nA = has_next ? (const char*)g.A + (size_t)nxt.pm * tstepA : cA; const char* nB = has_next ? (const char*)g.Bt + (size_t)nxt.pn * tstepB : cB;
        for (int t = 0; t < nt; t += 2) {
            const bool last = (t == nt - 2);
            const char* a1 = cA + (size_t)(t + 1) * kstep;
            const char* a2 = last ? nA : cA + (size_t)(t + 2) * kstep; const char* b2 = last ? nB : cB + (size_t)(t + 2) * kstep;
            const char* a3 = a2 + kstep; const char* b3 = b2 + kstep;
            if (last && has_next) S.a_ready(nxt);
            if constexpr (SP2) {
            PG8_LDB(B0, 0, 0); PG8_LDB(B1, 0, 1); PG8_SCHED; PG8_LDA(At, 0, 0); PG8_STAGE(PG8_SA(1, 1), a1 + hstepA, voffA);
            PG8_WAIT_V(8); PG8_WAIT_L(0); PG8_BAR; PG8_MMA(0, 0, At, B0); PG8_MMA(0, 1, At, B1); PG8_BAR; PG8_SCHED;
            PG8_LDA(At, 0, 1); PG8_STAGE(PG8_SB(0, 0), b2, voffB); PG8_STAGE(PG8_SB(0, 1), b2 + hstepB, voffB); PG8_STAGE(PG8_SA(0, 0), a2, voffA);
            PG8_WAIT_V(8); PG8_WAIT_L(0); PG8_BAR; PG8_MMA(1, 0, At, B0); PG8_MMA(1, 1, At, B1); PG8_BAR; PG8_SCHED;
            PG8_LDB(B0, 1, 0); PG8_LDB(B1, 1, 1); PG8_SCHED; PG8_LDA(At, 1, 0); PG8_STAGE(PG8_SA(0, 1), a2 + hstepA, voffA);
            PG8_WAIT_V(8); PG8_WAIT_L(0); PG8_BAR; PG8_MMA(0, 0, At, B0); PG8_MMA(0, 1, At, B1); PG8_BAR; PG8_SCHED;
            PG8_LDA(At, 1, 1); PG8_STAGE(PG8_SB(1, 0), b3, voffB); PG8_STAGE(PG8_SB(1, 1), b3 + hstepB, voffB); PG8_STAGE(PG8_SA(1, 0), a3, voffA);
            PG8_WAIT_V(8); PG8_WAIT_L(0); PG8_BAR; PG8_MMA(1, 0, At, B0); PG8_MMA(1, 1, At, B1); PG8_BAR; PG8_SCHED;
            } else {
            PG8_LDB(B0, 0, 0); PG8_SCHED; PG8_LDA(At, 0, 0); PG8_STAGE(PG8_SA(1, 1), a1 + hstepA, voffA);
            PG8_WAIT_L(8); PG8_BAR; PG8_WAIT_L(0); PG8_MMA(0, 0, At, B0); PG8_BAR; PG8_SCHED;
            PG8_LDB(B1, 0, 1); PG8_STAGE(PG8_SB(0, 0), b2, voffB);
            PG8_BAR; PG8_WAIT_L(0); PG8_MMA(0, 1, At, B1); PG8_BAR;
            PG8_LDA(At, 0, 1); PG8_STAGE(PG8_SA(0, 0), a2, voffA);
            PG8_BAR; PG8_WAIT_L(0); PG8_MMA(1, 0, At, B0); PG8_BAR; PG8_SCHED;
            PG8_STAGE(PG8_SB(0, 1), b2 + hstepB, voffB);
            PG8_WAIT_V(6); PG8_BAR; PG8_MMA(1, 1, At, B1); PG8_BAR;
            PG8_LDB(B0, 1, 0); PG8_SCHED; PG8_LDA(At, 1, 0); PG8_STAGE(PG8_SA(0, 1), a2 + hstepA, voffA);
            PG8_WAIT_L(8); PG8_BAR; PG8_WAIT_L(0); PG8_MMA(0, 0, At, B0); PG8_BAR; PG8_SCHED;
            PG8_LDB(B1, 1, 1); PG8_STAGE(PG8_SB(1, 0), b3, voffB);
            PG8_BAR; PG8_WAIT_L(0); PG8_MMA(0, 1, At, B1); PG8_BAR;
            PG8_LDA(At, 1, 1); PG8_STAGE(PG8_SA(1, 0), a3, voffA);
            PG8_BAR; PG8_WAIT_L(0); PG8_MMA(1, 0, At, B0); PG8_BAR; PG8_SCHED;
            PG8_STAGE(PG8_SB(1, 1), b3 + hstepB, voffB);
            PG8_WAIT_V(6); PG8_BAR; PG8_MMA(1, 1, At, B1); PG8_BAR;
            }
        }
        if constexpr (ALIGN_EPI) { if (wr == 0) PG8_BAR; }
        if constexpr (!Epi::AFTER_DRAIN) { E(acc, cur, wr, wc, fr, fq); S.done(cur); }
        if (!has_next) break;
#pragma unroll
        for (int a = 0; a < 2; ++a)
#pragma unroll
            for (int b = 0; b < 2; ++b)
#pragma unroll
                for (int m = 0; m < 4; ++m)
#pragma unroll
                    for (int n = 0; n < 2; ++n) acc[a][b][m][n] = (f32x4){0.f, 0.f, 0.f, 0.f};
        cur = nxt; cA = nA; cB = nB; ++ui;
        if constexpr (ALIGN_EPI) { if (wr == 1) PG8_BAR; }
    }
    PG8_WAIT_V(0);
    if constexpr (!ALIGN_EPI) { if (wr == 0) PG8_BAR; }
    PG8_BAR;
    if constexpr (Epi::AFTER_DRAIN) { E.fused(acc, cur, wr, wc, fr, fq, lds, wid, lane); S.done(cur); }
#undef PG8_SA
#undef PG8_SB
#undef PG8_STAGE
#undef PG8_LDA
#undef PG8_LDB
#undef PG8_MMA
#undef PG8_WAIT_V
#undef PG8_WAIT_L
#undef PG8_BAR
#undef PG8_SCHED
}
}
#define LAS __attribute__((address_space(3)))
#define XB_TMO      128
#define XB_XCNT(j)  (256  + 64 * (j))
#define XB_XSUB(j)  (1280 + 64 * (j))
#define XB_XGEN(j)  (2304 + 64 * (j))
#define XB_TOP      3328
#define XB_TOPGEN   3392
#define XCD_BAR_WORDS 3456
#define XB_SPIN_CAP (1u << 18)

__device__ __forceinline__ unsigned xb_ld(unsigned* p)              { return __hip_atomic_load(p, __ATOMIC_RELAXED, __HIP_MEMORY_SCOPE_AGENT); }
__device__ __forceinline__ unsigned xb_add(unsigned* p, unsigned v) { return __hip_atomic_fetch_add(p, v, __ATOMIC_RELAXED, __HIP_MEMORY_SCOPE_AGENT); }
__device__ __forceinline__ unsigned xb_xcc_id() { return (unsigned)__builtin_amdgcn_s_getreg((3 << 11) | 20) & 0xFu; }
#define XB_SPIN(cond, bar) do { unsigned _sp = 0; while (cond) { __builtin_amdgcn_s_sleep(1); \
    if ((++_sp & 255u) == 0u) { if (xb_ld(&(bar)[XB_TMO])) break; if (_sp > XB_SPIN_CAP) { atomicAdd(&(bar)[XB_TMO], 1u); break; } } } } while (0)

struct XcdBarrier {
    unsigned* bar; unsigned x;
    volatile LAS unsigned* st;
};

__device__ __forceinline__ XcdBarrier xcd_barrier_post(unsigned* bar, volatile LAS unsigned* st) {
    XcdBarrier b; b.bar = bar; b.x = xb_xcc_id(); b.st = st;
    if (threadIdx.x == 0) (void)xb_add(&bar[XB_XCNT(b.x)], 1u);
    return b;
}
__device__ __forceinline__ void xcd_barrier_complete(unsigned* bar, unsigned x, unsigned& nloc, unsigned& nx) {
    const unsigned G = gridDim.x * gridDim.y * gridDim.z;
    unsigned sum, cnt, mine, sp = 0u;
    for (;;) {
        sum = 0u; cnt = 0u; mine = 0u;
#pragma unroll
        for (unsigned j = 0; j < 16; ++j) { const unsigned c = xb_ld(&bar[XB_XCNT(j)]); sum += c; cnt += (c > 0u) ? 1u : 0u; mine = (j == x) ? c : mine; }
        if (sum == G) break;
        __builtin_amdgcn_s_sleep(1);
        if ((++sp & 255u) == 0u) { if (xb_ld(&bar[XB_TMO])) break; if (sp > XB_SPIN_CAP) { atomicAdd(&bar[XB_TMO], 1u); break; } }
    }
    nloc = mine > 0u ? mine : 1u; nx = cnt > 0u ? cnt : 1u;
}

__device__ __forceinline__ void xcd_barrier(const XcdBarrier& b) {
    asm volatile("s_waitcnt vmcnt(0)" ::: "memory");
    __syncthreads();
    if (threadIdx.x == 0) {
        unsigned* bar = b.bar;
        __builtin_amdgcn_s_waitcnt(0);
        unsigned nloc = b.st[0], nx = b.st[1];
        if (nloc == 0u) { xcd_barrier_complete(bar, b.x, nloc, nx); b.st[0] = nloc; b.st[1] = nx; }
        const unsigned old = xb_add(&bar[XB_XSUB(b.x)], 1u);
        const unsigned gen = old / nloc;
        if (old + 1u == (gen + 1u) * nloc) {
            __builtin_amdgcn_fence(__ATOMIC_RELEASE, "agent");
            asm volatile("s_waitcnt vmcnt(0)" ::: "memory");
            const unsigned og = xb_add(&bar[XB_TOP], 1u);
            const unsigned tg = og / nx;
            if (og + 1u == (tg + 1u) * nx) xb_add(&bar[XB_TOPGEN], 1u);
            else XB_SPIN(xb_ld(&bar[XB_TOPGEN]) == tg, bar);
            __builtin_amdgcn_fence(__ATOMIC_ACQUIRE, "agent");
            xb_add(&bar[XB_XGEN(b.x)], 1u);
            asm volatile("s_waitcnt vmcnt(0)" ::: "memory");
        } else {
            XB_SPIN(xb_ld(&bar[XB_XGEN(b.x)]) == gen, bar);
            __builtin_amdgcn_fence(__ATOMIC_ACQUIRE, "agent");
            asm volatile("s_waitcnt vmcnt(0)" ::: "memory");
        }
    }
    __syncthreads();
}
#undef LAS
using namespace pg8;
#define LAS __attribute__((address_space(3)))
typedef float f32x16 __attribute__((ext_vector_type(16)));
typedef unsigned u32x2 __attribute__((ext_vector_type(2)));
#define LDS_WAIT() asm volatile("s_waitcnt lgkmcnt(0)" ::: "memory")

constexpr int DM = 1024, NBATCH = 8, SEQ = 4096, MTOK = NBATCH * SEQ, DEPTH = 4, NIN = 4400, NPAD = 4608, DFF = 4096;
constexpr size_t MiB = 1u << 20;
constexpr size_t WS_ROPEC = 0, WS_ROPES = 512 * 1024, WS_CBIAS = 1 * MiB, WS_BAR = 1 * MiB + 64 * 1024;
constexpr size_t WS_W = 2 * MiB, WL_STRIDE = 33 * MiB;
constexpr size_t W_IN = 0, W_POOL = 9 * MiB, W_CK1 = W_POOL + MiB / 2, W_CV1 = W_CK1 + MiB, W_PP = W_CV1 + MiB, W_PN = W_PP + MiB,
                 W_OUT = W_PN + 2 * MiB, W_FF1 = W_OUT + 2 * MiB, W_FF2 = W_FF1 + 8 * MiB, W_CK2 = W_FF2 + 8 * MiB, W_CV2 = W_CK2 + 32 * 1024;
constexpr size_t WS_SS = 134 * MiB;
constexpr size_t WS_XN = 136 * MiB;
constexpr size_t WS_CK = 200 * MiB, WS_CVT = WS_CK + MiB / 2, WS_HIDK = 201 * MiB, WS_HIDV = 203 * MiB;
constexpr size_t WS_U = 206 * MiB, WS_Q = 238 * MiB, WS_KC = 302 * MiB, WS_VC = 310 * MiB, WS_KS = 318 * MiB, WS_VS = 326 * MiB, WS_KW = 334 * MiB,
                 WS_VW = 342 * MiB, WS_VST = 350 * MiB, WS_VWT = 358 * MiB, WS_GNSA = 366 * MiB, WS_GM = 370 * MiB;
constexpr size_t WS_H = 206 * MiB;
constexpr size_t WS_PPF = 500 * MiB;
constexpr size_t WS_END = 504 * MiB;
constexpr int LDS_BYTES = 135168;

__device__ __forceinline__ int launder_s(int i) { i = __builtin_amdgcn_readfirstlane(i); asm volatile("" : "+s"(i)); return i; }
#define GAS1 __attribute__((address_space(1)))
#define AIN(a, i) ((const float*)(const GAS1 float*)((a).in[launder_s(i)]))
struct Args { const float* in[18]; float* out; unsigned char* ws; double invf[32]; int ph_lo, ph_hi; };

__device__ __forceinline__ float bf2f(unsigned short u) { return __uint_as_float((unsigned)u << 16); }
__device__ __forceinline__ float bflo(unsigned w) { return __uint_as_float(w << 16); }
__device__ __forceinline__ float bfhi(unsigned w) { return __uint_as_float(w & 0xffff0000u); }
__device__ __forceinline__ unsigned short f2bf(float f) { return (unsigned short)(cvt_pk_bf16(f, f) & 0xffffu); }
__device__ __forceinline__ float wave_sum(float v) {
#pragma unroll
    for (int o = 1; o < 64; o <<= 1) v += __shfl_xor(v, o);
    return v;
}
__device__ __forceinline__ float sigmoidf_(float x) { return __builtin_amdgcn_rcpf(1.0f + __builtin_amdgcn_exp2f(-1.4426950408889634f * x)); }
__device__ __forceinline__ f32x4 sigmoid4(f32x4 v) { return (f32x4){sigmoidf_(v[0]), sigmoidf_(v[1]), sigmoidf_(v[2]), sigmoidf_(v[3])}; }
__device__ __forceinline__ float gelu_tanh(float x) {
    const float y = 0.7978845608028654f * (x + 0.044715f * x * x * x);
    const float e = __builtin_amdgcn_exp2f(2.0f * 1.4426950408889634f * y);
    const float th = 1.0f - 2.0f * __builtin_amdgcn_rcpf(1.0f + e);
    return 0.5f * x * (1.0f + th);
}
__device__ __forceinline__ void store8(bf16_t* dst, f32x4 v0, f32x4 v1) {
    u32x4 w; w.x = cvt_pk_bf16(v0[0], v0[1]); w.y = cvt_pk_bf16(v0[2], v0[3]); w.z = cvt_pk_bf16(v1[0], v1[1]); w.w = cvt_pk_bf16(v1[2], v1[3]);
    *(u32x4*)dst = w;
}

template <class T, class = void> struct has_pair : std::false_type {};
template <class T> struct has_pair<T, std::void_t<decltype(T::HAS_PAIR)>> : std::true_type {};
template <class Op, bool RS = false> struct EpiP {
    static constexpr bool PERM = true, AFTER_DRAIN = false; Op op; const float* ss;
    __device__ __forceinline__ void operator()(const f32x4 (&acc)[2][2][4][2], const Unit& u, int wr, int wc, int fr, int fq) const {
#pragma unroll
        for (int ai = 0; ai < 2; ++ai) {
            const int row0 = u.pm * 256 + ai * 128 + wr * 64 + fr; float r[4] = {1.0f, 1.0f, 1.0f, 1.0f};
            if (RS) { f32x4 t[4][4];
#pragma unroll
                for (int m = 0; m < 4; ++m) { const f32x4* sp = (const f32x4*)(ss + (size_t)(row0 + m * 16) * 16);
#pragma unroll
                    for (int k = 0; k < 4; ++k) t[m][k] = sp[k]; }
#pragma unroll
                for (int m = 0; m < 4; ++m) { const f32x4 q = (t[m][0] + t[m][1]) + (t[m][2] + t[m][3]); r[m] = 1.0f / sqrtf(((q.x + q.y) + (q.z + q.w)) * (1.0f / 1024.0f) + 1e-6f); } }
            if constexpr (has_pair<Op>::value) { if (op.is_pair(u.pn)) {
#pragma unroll
                for (int m = 0; m < 4; ++m) op.apply_pair(row0 + m * 16, wc, fq, acc[ai][0][m][0] * r[m], acc[ai][0][m][1] * r[m], acc[ai][1][m][0] * r[m], acc[ai][1][m][1] * r[m]);
                continue; } }
            typename Op::Pre pre[4][2];
#pragma unroll
            for (int m = 0; m < 4; ++m)
#pragma unroll
                for (int bj = 0; bj < 2; ++bj) pre[m][bj] = op.load(u.pn, row0 + m * 16, bj * 128 + wc * 32 + 8 * fq);
#pragma unroll
            for (int m = 0; m < 4; ++m)
#pragma unroll
                for (int bj = 0; bj < 2; ++bj) op.apply(u.pn, row0 + m * 16, bj * 128 + wc * 32 + 8 * fq, acc[ai][bj][m][0] * r[m], acc[ai][bj][m][1] * r[m], pre[m][bj]);
        }
    }
};
struct EpiResid {
    static constexpr bool PERM = true, AFTER_DRAIN = false; bf16_t* xb; float* ss;
    __device__ __forceinline__ void operator()(const f32x4 (&acc)[2][2][4][2], const Unit& u, int wr, int wc, int fr, int fq) const {
#pragma unroll
        for (int ai = 0; ai < 2; ++ai) {
            const int row0 = u.pm * 256 + ai * 128 + wr * 64 + fr; const int col0 = u.pn * 256 + wc * 32 + 8 * fq;
            u32x4 xv[4][2];
#pragma unroll
            for (int m = 0; m < 4; ++m)
#pragma unroll
                for (int bj = 0; bj < 2; ++bj) xv[m][bj] = *(const u32x4*)(xb + (size_t)(row0 + m * 16) * 1024 + col0 + bj * 128);
#pragma unroll
            for (int m = 0; m < 4; ++m) { const int row = row0 + m * 16; float sq = 0.f;
#pragma unroll
                for (int bj = 0; bj < 2; ++bj) { const size_t o = (size_t)row * 1024 + col0 + bj * 128; const u32x4 x = xv[m][bj];
                    const f32x4 v0 = (f32x4){bflo(x.x), bfhi(x.x), bflo(x.y), bfhi(x.y)} + acc[ai][bj][m][0], v1 = (f32x4){bflo(x.z), bfhi(x.z), bflo(x.w), bfhi(x.w)} + acc[ai][bj][m][1];
                    store8(xb + o, v0, v1);
                    sq += ((v0.x * v0.x + v0.y * v0.y) + (v0.z * v0.z + v0.w * v0.w)) + ((v1.x * v1.x + v1.y * v1.y) + (v1.z * v1.z + v1.w * v1.w)); }
                sq += __shfl_xor(sq, 16); sq += __shfl_xor(sq, 32);
                if (fq == 0) ss[(size_t)row * 16 + u.pn * 4 + wc] = sq; }
        }
    }
};
__device__ __forceinline__ constexpr int PIperm(int p) { return (p & ~12) | ((p & 8) >> 1) | ((p & 4) << 1); }
struct NoPre {};
struct OpProj { unsigned char* ws; typedef NoPre Pre; static constexpr bool HAS_PAIR = true;
    __device__ __forceinline__ bool is_pair(int pn) const { return pn == 7; }
    __device__ __forceinline__ void apply_pair(int row, int wc, int fq, f32x4 a0, f32x4 a1, f32x4 b0, f32x4 b1) const {
        const unsigned g = wc & 1, d0 = 8 * fq, b = (unsigned)row >> 12, t = row & 4095;
        const unsigned ro = (t * 32 + d0) * 4;
        const unsigned ko = (unsigned)((wc >> 1) ? WS_KW : WS_KS) + (((b * 2 + g) * 4096 + t) * 64 + d0) * 2;
        { const f32x4 c0 = *(const f32x4*)(ws + WS_ROPEC + ro), s0 = *(const f32x4*)(ws + WS_ROPES + ro);
          const f32x4 y1 = a0 * c0 - b0 * s0, y2 = b0 * c0 + a0 * s0; u32x2 w1, w2; w1.x = cvt_pk_bf16(y1[0], y1[1]); w1.y = cvt_pk_bf16(y1[2], y1[3]); w2.x = cvt_pk_bf16(y2[0], y2[1]); w2.y = cvt_pk_bf16(y2[2], y2[3]);
          *(u32x2*)(ws + ko) = w1; *(u32x2*)(ws + ko + 64) = w2; }
        { const f32x4 c1 = *(const f32x4*)(ws + WS_ROPEC + ro + 16), s1 = *(const f32x4*)(ws + WS_ROPES + ro + 16);
          const f32x4 y1 = a1 * c1 - b1 * s1, y2 = b1 * c1 + a1 * s1; u32x2 w1, w2; w1.x = cvt_pk_bf16(y1[0], y1[1]); w1.y = cvt_pk_bf16(y1[2], y1[3]); w2.x = cvt_pk_bf16(y2[0], y2[1]); w2.y = cvt_pk_bf16(y2[2], y2[3]);
          *(u32x2*)(ws + ko + 8) = w1; *(u32x2*)(ws + ko + 72) = w2; }
    }
    __device__ __forceinline__ Pre load(int, int, int) const { return Pre{}; }
    __device__ __forceinline__ void apply(int pn, int row, int lc, f32x4 v0, f32x4 v1, const Pre&) const {
        size_t off; bool sig = false;
        if (pn < 2) off = WS_U + ((size_t)row * 512 + pn * 256 + lc) * 2;
        else if (pn < 6) off = WS_Q + ((size_t)row * 1024 + (pn - 2) * 256 + lc) * 2;
        else if (pn == 6) { const int c = lc & 127, g = c >> 6, dh = c & 63, b = row >> 12, t = row & 4095;
            off = WS_KC + (size_t)(lc >> 7) * (8 * MiB) + (((size_t)((b * 2 + g) * 4096 + t)) * 64 + dh) * 2; }
        else if (pn == 8) {
            const int c = lc & 127, g = c >> 6, dh = c & 63, b = row >> 12, t = row & 4095;
            bf16_t* vt = (bf16_t*)(ws + ((lc >> 7) ? WS_VWT : WS_VST)) + ((size_t)(b * 2 + g) * 64 + (t >> 6)) * 4096 + dh * 64 + PIperm(t & 63);
#pragma unroll
            for (int j = 0; j < 4; ++j) { vt[j * 64] = f2bf(v0[j]); vt[(4 + j) * 64] = f2bf(v1[j]); }
            return; }
        else if (pn == 7) return;
        else if (pn == 9) { if (lc >= 64) return; off = WS_GNSA + ((size_t)row * 64 + lc) * 2; sig = true; }
        else {
            v0 = sigmoid4(v0); v1 = sigmoid4(v1); u32x2 w;
            w.x = (unsigned)(v0[0] * 255.0f + 0.5f) | ((unsigned)(v0[1] * 255.0f + 0.5f) << 8) | ((unsigned)(v0[2] * 255.0f + 0.5f) << 16) | ((unsigned)(v0[3] * 255.0f + 0.5f) << 24);
            w.y = (unsigned)(v1[0] * 255.0f + 0.5f) | ((unsigned)(v1[1] * 255.0f + 0.5f) << 8) | ((unsigned)(v1[2] * 255.0f + 0.5f) << 16) | ((unsigned)(v1[3] * 255.0f + 0.5f) << 24);
            *(u32x2*)(ws + WS_GM + (size_t)row * 2048 + (pn - 10) * 256 + lc) = w; return; }
        if (sig) { v0 = sigmoid4(v0); v1 = sigmoid4(v1); }
        store8((bf16_t*)(ws + off), v0, v1);
    } };
struct OpBf16 { bf16_t* O; int ld; typedef NoPre Pre;
    __device__ __forceinline__ Pre load(int, int, int) const { return Pre{}; }
    __device__ __forceinline__ void apply(int pn, int row, int lc, f32x4 v0, f32x4 v1, const Pre&) const { store8(O + (size_t)row * ld + pn * 256 + lc, v0, v1); } };
struct OpCmp1 { bf16_t* H; const float* bias; struct Pre { f32x4 b0, b1; };
    __device__ __forceinline__ Pre load(int, int, int lc) const { return Pre{*(const f32x4*)(bias + lc), *(const f32x4*)(bias + lc + 4)}; }
    __device__ __forceinline__ void apply(int pn, int row, int lc, f32x4 v0, f32x4 v1, const Pre& p) const {
        v0 += p.b0; v1 += p.b1;
#pragma unroll
        for (int i = 0; i < 4; ++i) { v0[i] = gelu_tanh(v0[i]); v1[i] = gelu_tanh(v1[i]); }
        store8(H + (size_t)row * 256 + lc, v0, v1);
    } };
__device__ __forceinline__ void ungate8(u32x2 g, float (&f)[8]) { constexpr float k = 1.0f / 255.0f;
    f[0] = (float)(g.x & 255u) * k; f[1] = (float)((g.x >> 8) & 255u) * k; f[2] = (float)((g.x >> 16) & 255u) * k; f[3] = (float)(g.x >> 24) * k;
    f[4] = (float)(g.y & 255u) * k; f[5] = (float)((g.y >> 8) & 255u) * k; f[6] = (float)((g.y >> 16) & 255u) * k; f[7] = (float)(g.y >> 24) * k; }
struct OpMerge1 { const unsigned char* G8; bf16_t* MG; struct Pre { u32x2 g; };
    __device__ __forceinline__ Pre load(int pn, int row, int lc) const { return Pre{*(const u32x2*)(G8 + (size_t)row * 2048 + pn * 256 + lc)}; }
    __device__ __forceinline__ void apply(int pn, int row, int lc, f32x4 v0, f32x4 v1, const Pre& p) const {
        float g[8]; ungate8(p.g, g);
#pragma unroll
        for (int i = 0; i < 4; ++i) { v0[i] *= g[i]; v1[i] *= g[4 + i]; }
        store8(MG + (size_t)row * 1024 + pn * 256 + lc, v0, v1);
    } };
struct OpMerge2 { const unsigned char* G8; bf16_t* MG; struct Pre { u32x4 t; u32x2 g; };
    __device__ __forceinline__ Pre load(int pn, int row, int lc) const { return Pre{*(const u32x4*)(MG + (size_t)row * 1024 + pn * 256 + lc), *(const u32x2*)(G8 + (size_t)row * 2048 + 1024 + pn * 256 + lc)}; }
    __device__ __forceinline__ void apply(int pn, int row, int lc, f32x4 v0, f32x4 v1, const Pre& p) const {
        const u32x4 t = p.t; float g[8]; ungate8(p.g, g);
        v0[0] = v0[0] * g[0] + bflo(t.x); v0[1] = v0[1] * g[1] + bfhi(t.x); v0[2] = v0[2] * g[2] + bflo(t.y); v0[3] = v0[3] * g[3] + bfhi(t.y);
        v1[0] = v1[0] * g[4] + bflo(t.z); v1[1] = v1[1] * g[5] + bfhi(t.z); v1[2] = v1[2] * g[6] + bflo(t.w); v1[3] = v1[3] * g[7] + bfhi(t.w);
        store8(MG + (size_t)row * 1024 + pn * 256 + lc, v0, v1);
    } };
struct OpFF1 { bf16_t* H; typedef NoPre Pre;
    __device__ __forceinline__ Pre load(int, int, int) const { return Pre{}; }
    __device__ __forceinline__ void apply(int pn, int row, int lc, f32x4 v0, f32x4 v1, const Pre&) const {
#pragma unroll
        for (int i = 0; i < 4; ++i) { const float a = fmaxf(v0[i], 0.f), b = fmaxf(v1[i], 0.f); v0[i] = a * a; v1[i] = b * b; }
        store8(H + (size_t)row * 4096 + pn * 256 + lc, v0, v1);
    } };
struct EpiNull { static constexpr bool PERM = true, AFTER_DRAIN = false;
    __device__ __forceinline__ void operator()(const f32x4 (&acc)[2][2][4][2], const Unit& u, int wr, int wc, int fr, int fq) const {
#pragma unroll
        for (int ai = 0; ai < 2; ++ai)
#pragma unroll
            for (int bj = 0; bj < 2; ++bj)
#pragma unroll
                for (int m = 0; m < 4; ++m)
#pragma unroll
                    for (int n = 0; n < 2; ++n) asm volatile("" :: "v"(acc[ai][bj][m][n]));
    } };
template <class Epi> __device__ __forceinline__ void run_gemm(LAS unsigned char* lds, const bf16_t* A, int lda, const bf16_t* Bt, int M, int N, int K, const Epi& E, int G, int c) {
    Gemm g{A, Bt, M, N, K, lda}; StaticOrder S; S.init(M, N, G, c);
    gemm_phase<Epi, StaticOrder, true, true>(lds, g, S, E);
}

template <class F> __device__ __forceinline__ void conv_tile(F f, bf16_t* WT, int K, int n0, int k0, LAS float* scr, int lane) {
    float tv[32];
#pragma unroll
    for (int i = 0; i < 32; ++i) tv[i] = f(k0 + 2 * i + (lane >> 5), n0 + (lane & 31));
#pragma unroll
    for (int i = 0; i < 32; ++i) scr[(2 * i + (lane >> 5)) * 33 + (lane & 31)] = tv[i];
    LDS_WAIT(); asm volatile("" ::: "memory");
    const int c = lane & 7;
#pragma unroll
    for (int j = 0; j < 4; ++j) { const int n = (lane >> 3) + 8 * j; const LAS float* s = scr + (8 * c) * 33 + n;
        u32x4 o; o.x = cvt_pk_bf16(s[0 * 33], s[1 * 33]); o.y = cvt_pk_bf16(s[2 * 33], s[3 * 33]); o.z = cvt_pk_bf16(s[4 * 33], s[5 * 33]); o.w = cvt_pk_bf16(s[6 * 33], s[7 * 33]);
        *(u32x4*)(WT + (size_t)(n0 + n) * K + k0 + 8 * c) = o; }
    LDS_WAIT(); asm volatile("" ::: "memory");
}
struct FPlain { const float* W; int N; __device__ __forceinline__ float operator()(int k, int n) const { return W[(size_t)k * N + n]; } };
struct FWin { const float* W; const float* gk; __device__ __forceinline__ float operator()(int k, int p) const {
    int src;
    if (p < 1792) src = p;
    else if (p < 2048) { const int lc = p - 1792, bj = lc >> 7, wc = (lc >> 5) & 3, r = lc & 31;
        src = ((wc >> 1) ? 2048 : 1792) + (wc & 1) * 64 + bj * 32 + r; }
    else if (p < 2304) { const int lc = p - 2048; src = (lc < 128) ? 1920 + lc : 2176 + (lc - 128); }
    else if (p < 2352) src = p; else if (p < 2560) src = -1; else src = p - 208; return src < 0 ? 0.f : W[(size_t)k * NIN + src] * gk[k]; } };
struct FPlainG { const float* W; int N; const float* gk; __device__ __forceinline__ float operator()(int k, int n) const { return W[(size_t)k * N + n] * gk[k]; } };
struct FPool { const float* W; const float* sc; __device__ __forceinline__ float operator()(int j, int k) const {
    return ((k >> 7) == (j >> 7)) ? W[(k >> 7) * 16384 + (k & 127) * 128 + (j & 127)] * sc[j] : 0.f; } };

__device__ __forceinline__ void rms_row_out(const bf16_t* xrow, const float* g, float* orow, int lane) {
    const u32x2* xr = (const u32x2*)xrow + lane; const f32x4* gr = (const f32x4*)g + lane;
    f32x4 v[4]; float s = 0.f;
#pragma unroll
    for (int j = 0; j < 4; ++j) { const u32x2 w = xr[64 * j]; v[j] = (f32x4){bflo(w.x), bfhi(w.x), bflo(w.y), bfhi(w.y)}; s += (v[j].x * v[j].x + v[j].y * v[j].y) + (v[j].z * v[j].z + v[j].w * v[j].w); }
    const float r = 1.0f / sqrtf(wave_sum(s) * (1.0f / 1024.0f) + 1e-6f);
    f32x4* o = (f32x4*)orow + lane;
#pragma unroll
    for (int j = 0; j < 4; ++j) { const f32x4 gg = gr[64 * j]; o[64 * j] = (v[j] * r) * gg; }
}
struct Ctx { LAS unsigned char* lds; unsigned char* ws; int tid, lane, wave, G, bx, gw, NGW; };

__device__ __forceinline__ void ph_prologue(const Args& a, const Ctx& C) {
    unsigned char* ws = C.ws;
    { float* rc = (float*)(ws + WS_ROPEC); float* rs = (float*)(ws + WS_ROPES);
      for (int idx = C.bx * 512 + C.tid; idx < SEQ * 32; idx += C.G * 512) {
        const int t = idx >> 5, i = idx & 31; const double ang = (double)t * a.invf[i];
        const double k = rint(ang * 0.15915494309189535); double r = fma(-k, 6.283185307179586, ang); r = fma(-k, 2.4492935982947064e-16, r);
        const double r2 = r * r; double s = 1.0, c = 1.0;
#pragma unroll
        for (int n = 15; n >= 1; --n) { s = 1.0 - r2 * (1.0 / (double)((2 * n) * (2 * n + 1))) * s; c = 1.0 - r2 * (1.0 / (double)((2 * n - 1) * (2 * n))) * c; }
        rc[idx] = (float)c; rs[idx] = (float)(r * s);
      } }
    LAS float* scr = (LAS float*)(C.lds + C.wave * 8448);
    constexpr int I_IN = 16 * 144, I_POOL = 8 * 16, I_CK = 32 * 8, I_PP = 8 * 32, I_PN = 16 * 32, I_OUT = 16 * 32, I_FF1 = 16 * 128, I_FF2 = 64 * 32, I_C2 = 4 * 2;
    constexpr int NITEMS = I_IN + I_POOL + 2 * I_CK + I_PP + I_PN + I_OUT + I_FF1 + I_FF2 + 2 * I_C2;
    for (int it = C.gw; it < DEPTH * NITEMS; it += C.NGW) {
        const int l = it / NITEMS; int r = it - l * NITEMS; unsigned char* wl = ws + WS_W + (size_t)l * WL_STRIDE;
        if (r < I_IN) { conv_tile(FWin{AIN(a, 2) + (size_t)l * DM * NIN, AIN(a, 1) + (size_t)l * 1024}, (bf16_t*)(wl + W_IN), 1024, (r % 144) * 32, (r / 144) * 64, scr, C.lane); continue; } r -= I_IN;
        if (r < I_POOL) { conv_tile(FPool{AIN(a, 3) + (size_t)l * 65536, AIN(a, 4) + (size_t)l * 512}, (bf16_t*)(wl + W_POOL), 512, (r % 16) * 32, (r / 16) * 64, scr, C.lane); continue; } r -= I_POOL;
        if (r < I_CK) { conv_tile(FPlain{AIN(a, 7) + (size_t)l * 2048 * 256, 256}, (bf16_t*)(wl + W_CK1), 2048, (r % 8) * 32, (r / 8) * 64, scr, C.lane); continue; } r -= I_CK;
        if (r < I_CK) { conv_tile(FPlain{AIN(a, 9) + (size_t)l * 2048 * 256, 256}, (bf16_t*)(wl + W_CV1), 2048, (r % 8) * 32, (r / 8) * 64, scr, C.lane); continue; } r -= I_CK;
        if (r < I_PP) { conv_tile(FPlain{AIN(a, 11) + (size_t)l * 512 * 1024, 1024}, (bf16_t*)(wl + W_PP), 512, (r % 32) * 32, (r / 32) * 64, scr, C.lane); continue; } r -= I_PP;
        if (r < I_PN) { conv_tile(FPlain{AIN(a, 12) + (size_t)l * 1024 * 1024, 1024}, (bf16_t*)(wl + W_PN), 1024, (r % 32) * 32, (r / 32) * 64, scr, C.lane); continue; } r -= I_PN;
        if (r < I_OUT) { conv_tile(FPlain{AIN(a, 13) + (size_t)l * 1024 * 1024, 1024}, (bf16_t*)(wl + W_OUT), 1024, (r % 32) * 32, (r / 32) * 64, scr, C.lane); continue; } r -= I_OUT;
        if (r < I_FF1) { conv_tile(FPlainG{AIN(a, 15) + (size_t)l * 1024 * 4096, 4096, AIN(a, 14) + (size_t)l * 1024}, (bf16_t*)(wl + W_FF1), 1024, (r % 128) * 32, (r / 128) * 64, scr, C.lane); continue; } r -= I_FF1;
        if (r < I_FF2) { conv_tile(FPlain{AIN(a, 16) + (size_t)l * 4096 * 1024, 1024}, (bf16_t*)(wl + W_FF2), 4096, (r % 32) * 32, (r / 32) * 64, scr, C.lane); continue; } r -= I_FF2;
        if (r < I_C2) { conv_tile(FPlain{AIN(a, 8) + (size_t)l * 256 * 64, 64}, (bf16_t*)(wl + W_CK2), 256, (r % 2) * 32, (r / 2) * 64, scr, C.lane); continue; } r -= I_C2;
        conv_tile(FPlain{AIN(a, 10) + (size_t)l * 256 * 64, 64}, (bf16_t*)(wl + W_CV2), 256, (r % 2) * 32, (r / 2) * 64, scr, C.lane);
    }
    { float* cb = (float*)(ws + WS_CBIAS);
      for (int it = C.gw; it < DEPTH * 512; it += C.NGW) { const int l = it >> 9, kv = (it >> 8) & 1, n = it & 255; const float* pe = AIN(a, kv ? 6 : 5) + (size_t)l * 2048; const float* w1 = AIN(a, kv ? 9 : 7) + (size_t)l * 2048 * 256;
          float s = 0.f; for (int kk = C.lane; kk < 2048; kk += 64) s += pe[kk] * w1[(size_t)kk * 256 + n];
          s = wave_sum(s); if (C.lane == 0) cb[it] = s; } }
    { const float* x = AIN(a, 0); bf16_t* XB = (bf16_t*)(ws + WS_XN); float* SS = (float*)(ws + WS_SS); const int lane = C.lane;
      for (int m = C.gw; m < MTOK; m += C.NGW) {
        const f32x4* xr = (const f32x4*)(x + (size_t)m * 1024) + lane; u32x2* o8 = (u32x2*)(XB + (size_t)m * 1024) + lane; float sq = 0.f;
#pragma unroll
        for (int j = 0; j < 4; ++j) { const f32x4 v = xr[64 * j]; sq += (v.x * v.x + v.y * v.y) + (v.z * v.z + v.w * v.w); u32x2 w; w.x = cvt_pk_bf16(v.x, v.y); w.y = cvt_pk_bf16(v.z, v.w); o8[64 * j] = w; }
        sq = wave_sum(sq); if (lane < 16) SS[(size_t)m * 16 + lane] = (lane == 0) ? sq : 0.f;
      } }
}

__device__ __forceinline__ void vt_tile(const bf16_t* src, bf16_t* dst, int lane) {
    unsigned pk[32];
#pragma unroll
    for (int pos = 0; pos < 64; pos += 2) { const int kv0 = PIperm(pos); const unsigned lo = src[kv0 * 64 + lane], hi = src[(kv0 + 1) * 64 + lane]; pk[pos >> 1] = lo | (hi << 16); }
    u32x4* d = (u32x4*)(dst + lane * 64);
#pragma unroll
    for (int j = 0; j < 8; ++j) d[j] = (u32x4){pk[4 * j], pk[4 * j + 1], pk[4 * j + 2], pk[4 * j + 3]};
}
__device__ __forceinline__ void ph_post(const Ctx& C, bool do_rope, const int pgw, const int pngw, bf16_t* Dbuf) {
    unsigned char* ws = C.ws; const int lane = C.lane;
    const float* rc = (const float*)(ws + WS_ROPEC); const float* rs = (const float*)(ws + WS_ROPES);
    if (do_rope) for (int it = pgw; it < 2 * 16 * 4096 / 8; it += pngw) {
        const int rr = it * 8 + (lane >> 3); bf16_t* base = (bf16_t*)(ws + (rr < 65536 ? WS_KS : WS_KW)); const int r = rr & 65535, t = r & 4095, d0 = (lane & 7) * 4;
        bf16_t* p = base + (size_t)r * 64 + d0; const u32x2 a = *(const u32x2*)p, b = *(const u32x2*)(p + 32);
        const f32x4 c = *(const f32x4*)(rc + t * 32 + d0), s = *(const f32x4*)(rs + t * 32 + d0);
        const float x1[4] = {bflo(a.x), bfhi(a.x), bflo(a.y), bfhi(a.y)}, x2[4] = {bflo(b.x), bfhi(b.x), bflo(b.y), bfhi(b.y)};
        float y1[4], y2[4];
#pragma unroll
        for (int i = 0; i < 4; ++i) { y1[i] = x1[i] * c[i] - x2[i] * s[i]; y2[i] = x2[i] * c[i] + x1[i] * s[i]; }
        u32x2 oa, ob; oa.x = cvt_pk_bf16(y1[0], y1[1]); oa.y = cvt_pk_bf16(y1[2], y1[3]); ob.x = cvt_pk_bf16(y2[0], y2[1]); ob.y = cvt_pk_bf16(y2[2], y2[3]);
        *(u32x2*)p = oa; *(u32x2*)(p + 32) = ob;
    }
    { const bf16_t* U = (const bf16_t*)(ws + WS_U); bf16_t* D = Dbuf;
#define UNPK8(NAME_, VEC_) const float NAME_[8] = {bflo(VEC_[0]), bfhi(VEC_[0]), bflo(VEC_[1]), bfhi(VEC_[1]), bflo(VEC_[2]), bfhi(VEC_[2]), bflo(VEC_[3]), bfhi(VEC_[3])}
      for (int it = pgw; it < MTOK / 32; it += pngw) {
        const int tt0 = it * 32, t0 = tt0 & 4095, w = 2 << (lane >> 4); const bf16_t* up = U + (size_t)tt0 * 512 + lane * 8; bf16_t* dp = D + (size_t)tt0 * 512 + lane * 8;
        float s[8] = {0.f, 0.f, 0.f, 0.f, 0.f, 0.f, 0.f, 0.f};
#pragma unroll
        for (int i = 1; i < 16; ++i) if (i < w && t0 - i >= 0) { const u32x4 v = *(const u32x4*)(up - (ptrdiff_t)i * 512); UNPK8(x, v);
#pragma unroll
            for (int j2 = 0; j2 < 8; ++j2) s[j2] += x[j2]; }
#pragma unroll 8
        for (int k = 0; k < 32; ++k) {
            const int t = t0 + k; const u32x4 v = *(const u32x4*)(up + (size_t)k * 512); UNPK8(x, v);
            const int cnt = (t + 1 < w) ? t + 1 : w; const float inv = 1.0f / (float)cnt; f32x4 d0, d1;
#pragma unroll
            for (int j2 = 0; j2 < 8; ++j2) s[j2] += x[j2];
#pragma unroll
            for (int j2 = 0; j2 < 4; ++j2) { d0[j2] = s[j2] * inv - x[j2]; d1[j2] = s[j2 + 4] * inv - x[j2 + 4]; }
            store8(dp + (size_t)k * 512, d0, d1);
            if (t - w + 1 >= 0) { const u32x4 vo = *(const u32x4*)(up + (ptrdiff_t)(k - w + 1) * 512); UNPK8(y, vo);
#pragma unroll
                for (int j2 = 0; j2 < 8; ++j2) s[j2] -= y[j2]; }
        }
      }
#undef UNPK8
    }
}

__device__ __forceinline__ constexpr int crow_c(int r) { return (r & 3) + 8 * (r >> 2); }
#define MFMA32(a, b, c) __builtin_amdgcn_mfma_f32_32x32x16_bf16((a), (b), (c), 0, 0, 0)
__device__ __forceinline__ void ph_cmp2(const Ctx& C, int l) {
    unsigned char* ws = C.ws; const int lane = C.lane, c = lane & 31, hh = lane >> 5;
    const float* rc = (const float*)(ws + WS_ROPEC); const float* rs = (const float*)(ws + WS_ROPES);
    for (int it = C.bx + C.G * C.wave; it < 256; it += C.G * 8) {
        const int kv = it >> 7, r0 = (it & 127) * 32;
        const bf16_t* hid = (const bf16_t*)(ws + (kv ? WS_HIDV : WS_HIDK)) + (size_t)(r0 + c) * 256 + hh * 8;
        const bf16_t* w2t = (const bf16_t*)(ws + WS_W + (size_t)l * WL_STRIDE + (kv ? W_CV2 : W_CK2)) + hh * 8;
        f32x16 a0 = (f32x16){}, a1 = (f32x16){};
#pragma unroll 4
        for (int ks = 0; ks < 16; ++ks) { const bf16x8 af = *(const bf16x8*)(hid + ks * 16), b0 = *(const bf16x8*)(w2t + (size_t)c * 256 + ks * 16), b1 = *(const bf16x8*)(w2t + (size_t)(c + 32) * 256 + ks * 16);
            a0 = MFMA32(af, b0, a0); a1 = MFMA32(af, b1, a1); }
#pragma unroll
        for (int r = 0; r < 16; ++r) { const int row = r0 + crow_c(r) + 4 * hh, bg = row >> 8, n = row & 255; float v0 = a0[r], v1 = a1[r];
            if (n == 255) { v0 = 0.f; v1 = 0.f; }
            if (kv == 0) { const int pos = (n == 255) ? 0 : 16 * n + 31; const float cc = rc[pos * 32 + c], sn = rs[pos * 32 + c];
                bf16_t* o = (bf16_t*)(ws + WS_CK) + (size_t)row * 64; o[c] = f2bf(v0 * cc - v1 * sn); o[c + 32] = f2bf(v1 * cc + v0 * sn); }
            else { bf16_t* o = (bf16_t*)(ws + WS_CVT) + (size_t)bg * 16384 + (n >> 6) * 4096 + PIperm(n & 63); o[c * 64] = f2bf(v0); o[(c + 32) * 64] = f2bf(v1); } }
    }
}

constexpr int AT_KB = 0, AT_VB = 18432, AT_SLAB = 36864, AT_SELM = AT_SLAB + 65536, AT_UNION = AT_SELM + 256, KPITCH = 144;
constexpr float SM_C = 0.125f * 1.4426950408889634f;
__device__ __forceinline__ void qk_tile(LAS const unsigned char* kb, const bf16x8 (&qf)[4], f32x16& p0, f32x16& p1, int lane) {
    LAS const unsigned char* ka = kb + (lane & 31) * KPITCH + (lane >> 5) * 16;
    p0 = (f32x16){}; p1 = (f32x16){};
#pragma unroll
    for (int ks = 0; ks < 4; ++ks) { const bf16x8 a0 = *(LAS const bf16x8*)(ka + ks * 32), a1 = *(LAS const bf16x8*)(ka + 32 * KPITCH + ks * 32);
        p0 = MFMA32(a0, qf[ks], p0); p1 = MFMA32(a1, qf[ks], p1); }
    __builtin_amdgcn_sched_group_barrier(0x100, 8, 0); __builtin_amdgcn_sched_group_barrier(0x008, 8, 0);
}
typedef float f32x2v __attribute__((ext_vector_type(2)));
__device__ __forceinline__ float fmax3(float a, float b, float c) { return fmaxf(fmaxf(a, b), c); }
__device__ __forceinline__ void attn_tile(LAS const unsigned char* kb, LAS const unsigned char* vb, const bf16x8 (&qf)[4], float& m, float& l, f32x16& o0, f32x16& o1, int lo, int hi_, int lane) {
    const int hh = lane >> 5; f32x16 p0, p1;
    qk_tile(kb, qf, p0, p1, lane);
    const bool lane_full = (lo <= 0) && (hi_ >= 63), lane_empty = lo > hi_;
    const bool simple = __all((lane_full || lane_empty) ? 1 : 0) != 0;
    if (!simple) { const int lo2 = lo - 4 * hh, hi2 = hi_ - 4 * hh;
#pragma unroll
        for (int r = 0; r < 16; ++r) { const int c0 = crow_c(r), c1 = c0 + 32; p0[r] = (c0 >= lo2 && c0 <= hi2) ? p0[r] : -INFINITY; p1[r] = (c1 >= lo2 && c1 <= hi2) ? p1[r] : -INFINITY; } }
    float mxa = fmax3(p0[0], p0[1], p1[0]), mxb = fmax3(p0[2], p0[3], p1[1]); mxa = fmax3(mxa, p1[2], p1[3]);
#pragma unroll
    for (int r = 4; r < 16; r += 4) { mxa = fmax3(mxa, p0[r], p0[r + 1]); mxb = fmax3(mxb, p0[r + 2], p0[r + 3]); mxa = fmax3(mxa, p1[r], p1[r + 1]); mxb = fmax3(mxb, p1[r + 2], p1[r + 3]); }
    float mx = fmaxf(mxa, mxb);
    const bool dead = simple && lane_empty;
    if (dead) mx = -INFINITY;
    mx = fmaxf(mx, __shfl_xor(mx, 32));
    const float mx2 = mx * SM_C;
    if (__any((mx2 > m + 8.0f) ? 1 : 0)) {
        const float mn = fmaxf(m, mx2), alpha = __builtin_amdgcn_exp2f(m - mn);
        l *= alpha; m = mn;
#pragma unroll
        for (int r = 0; r < 16; ++r) { o0[r] *= alpha; o1[r] *= alpha; }
    }
    const float neg = dead ? -INFINITY : -m;
    float sa = 0.f, sb = 0.f;
#pragma unroll
    for (int r = 0; r < 16; r += 2) {
        p0[r] = __builtin_amdgcn_exp2f(__builtin_fmaf(p0[r], SM_C, neg)); p0[r + 1] = __builtin_amdgcn_exp2f(__builtin_fmaf(p0[r + 1], SM_C, neg));
        p1[r] = __builtin_amdgcn_exp2f(__builtin_fmaf(p1[r], SM_C, neg)); p1[r + 1] = __builtin_amdgcn_exp2f(__builtin_fmaf(p1[r + 1], SM_C, neg));
        sa += p0[r] + p0[r + 1]; sb += p1[r] + p1[r + 1];
    }
    l += sa + sb;
    bf16x8 pf[4];
#pragma unroll
    for (int s = 0; s < 2; ++s) {
        u32x4 w0, w1;
        w0.x = cvt_pk_bf16(p0[8 * s + 0], p0[8 * s + 1]); w0.y = cvt_pk_bf16(p0[8 * s + 2], p0[8 * s + 3]); w0.z = cvt_pk_bf16(p0[8 * s + 4], p0[8 * s + 5]); w0.w = cvt_pk_bf16(p0[8 * s + 6], p0[8 * s + 7]);
        w1.x = cvt_pk_bf16(p1[8 * s + 0], p1[8 * s + 1]); w1.y = cvt_pk_bf16(p1[8 * s + 2], p1[8 * s + 3]); w1.z = cvt_pk_bf16(p1[8 * s + 4], p1[8 * s + 5]); w1.w = cvt_pk_bf16(p1[8 * s + 6], p1[8 * s + 7]);
        pf[s] = __builtin_bit_cast(bf16x8, w0); pf[2 + s] = __builtin_bit_cast(bf16x8, w1);
    }
    LAS const unsigned char* va = vb + (lane & 31) * KPITCH + hh * 16;
#pragma unroll
    for (int ts = 0; ts < 4; ++ts) {
        const bf16x8 v0 = *(LAS const bf16x8*)(va + ts * 32), v1 = *(LAS const bf16x8*)(va + 32 * KPITCH + ts * 32);
        o0 = MFMA32(v0, pf[ts], o0); o1 = MFMA32(v1, pf[ts], o1);
    }
    __builtin_amdgcn_sched_group_barrier(0x100, 8, 1); __builtin_amdgcn_sched_group_barrier(0x008, 8, 1);
}
template <int MODE>
__device__ __forceinline__ void run_branch(LAS unsigned char* lds, const unsigned char* Kg, const unsigned char* Vg, unsigned long long tiles, const bf16x8 (&qf)[4],
                                           float& m, float& l, f32x16& o0, f32x16& o1, int cur, int tq, int nvalid, unsigned long long selm, int tid, int lane) {
    const int soff = (tid >> 3) * KPITCH + (tid & 7) * 16;
    unsigned long long rem = tiles;
    int T = __ffsll(rem) - 1; rem &= rem - 1;
    u32x4 kr = *(const u32x4*)(Kg + (size_t)T * 8192 + tid * 16), vr = *(const u32x4*)(Vg + (size_t)T * 8192 + tid * 16);
    *(LAS u32x4*)(lds + AT_KB + soff) = kr; *(LAS u32x4*)(lds + AT_VB + soff) = vr;
    __syncthreads();
    int bi = 0;
    for (;;) {
        const bool more = rem != 0ull;
        const int Tn = more ? (__ffsll(rem) - 1) : T; rem &= rem - 1;
        kr = *(const u32x4*)(Kg + (size_t)Tn * 8192 + tid * 16); vr = *(const u32x4*)(Vg + (size_t)Tn * 8192 + tid * 16);
        int lo, hi_;
        if (MODE == 0) { lo = 0; hi_ = nvalid - 64 * T - 1; }
        else if (MODE == 1) { const bool sb = ((selm >> T) & 1ull) != 0; lo = sb ? 0 : 1; hi_ = sb ? (T < cur ? 63 : tq) : 0; }
        else { lo = (T == cur - 8) ? tq + 1 : 0; hi_ = (T == cur) ? tq : 63; }
        attn_tile(lds + AT_KB + bi * 9216, lds + AT_VB + bi * 9216, qf, m, l, o0, o1, lo, hi_, lane);
        *(LAS u32x4*)(lds + AT_KB + (bi ^ 1) * 9216 + soff) = kr; *(LAS u32x4*)(lds + AT_VB + (bi ^ 1) * 9216 + soff) = vr;
        __syncthreads();
        if (!more) break;
        T = Tn; bi ^= 1;
    }
}
__device__ __forceinline__ void ph_attn(const Ctx& C, size_t yoff) {
    unsigned char* ws = C.ws; LAS unsigned char* lds = C.lds; const int tid = C.tid, lane = C.lane, w = C.wave, q = lane & 31, hh = lane >> 5;
    bf16_t* Q = (bf16_t*)(ws + WS_Q); const bf16_t* GN = (const bf16_t*)(ws + WS_GNSA);
    LAS float* slab = (LAS float*)(lds + AT_SLAB); LAS unsigned long long* selmp = (LAS unsigned long long*)(lds + AT_SELM); LAS unsigned* unionp = (LAS unsigned*)(lds + AT_UNION);
    const int vcu = (C.G % 8 == 0) ? (C.bx % 8) * (C.G / 8) + C.bx / 8 : C.bx;
    for (int it = vcu; it < 2048; it += C.G) {
        int bg, qb;
        if (C.G == 256) { const int i = it >> 8, v = it & 255, s = v & 15; bg = v >> 4; qb = 32 * (i >> 1) + ((i & 1) ? 31 - s : s); }
        else { bg = it & 15; qb = it >> 4; }
        const int b = bg >> 1, g = bg & 1, h = g * 8 + w, t0 = qb * 32, cur = t0 >> 6, t = t0 + q, tq = t & 63;
        const size_t tokrow = (size_t)b * 4096 + t;
        bf16_t* qp = Q + tokrow * 1024 + h * 64;
        bf16x8 qf[4];
#pragma unroll
        for (int ks = 0; ks < 4; ++ks) qf[ks] = *(const bf16x8*)(qp + ks * 16 + hh * 8);
        { const float* rcp = (const float*)(ws + WS_ROPEC) + t * 32 + hh * 8; const float* rsp = (const float*)(ws + WS_ROPES) + t * 32 + hh * 8;
#pragma unroll
          for (int ks = 0; ks < 2; ++ks) { const f32x4 c0 = *(const f32x4*)(rcp + ks * 16), c1 = *(const f32x4*)(rcp + ks * 16 + 4), s0 = *(const f32x4*)(rsp + ks * 16), s1 = *(const f32x4*)(rsp + ks * 16 + 4);
              const u32x4 xa = __builtin_bit_cast(u32x4, qf[ks]), xb = __builtin_bit_cast(u32x4, qf[ks + 2]);
              const float x1[8] = {bflo(xa.x), bfhi(xa.x), bflo(xa.y), bfhi(xa.y), bflo(xa.z), bfhi(xa.z), bflo(xa.w), bfhi(xa.w)}, x2[8] = {bflo(xb.x), bfhi(xb.x), bflo(xb.y), bfhi(xb.y), bflo(xb.z), bfhi(xb.z), bflo(xb.w), bfhi(xb.w)};
              const float cc[8] = {c0[0], c0[1], c0[2], c0[3], c1[0], c1[1], c1[2], c1[3]}, sn[8] = {s0[0], s0[1], s0[2], s0[3], s1[0], s1[1], s1[2], s1[3]};
              float y1[8], y2[8];
#pragma unroll
              for (int i = 0; i < 8; ++i) { y1[i] = x1[i] * cc[i] - x2[i] * sn[i]; y2[i] = x2[i] * cc[i] + x1[i] * sn[i]; }
              u32x4 oa, ob; oa.x = cvt_pk_bf16(y1[0], y1[1]); oa.y = cvt_pk_bf16(y1[2], y1[3]); oa.z = cvt_pk_bf16(y1[4], y1[5]); oa.w = cvt_pk_bf16(y1[6], y1[7]);
              ob.x = cvt_pk_bf16(y2[0], y2[1]); ob.y = cvt_pk_bf16(y2[2], y2[3]); ob.z = cvt_pk_bf16(y2[4], y2[5]); ob.w = cvt_pk_bf16(y2[6], y2[7]);
              qf[ks] = __builtin_bit_cast(bf16x8, oa); qf[ks + 2] = __builtin_bit_cast(bf16x8, ob); } }
        const float gc = bf2f(GN[tokrow * 64 + h * 3 + 0]), gs = bf2f(GN[tokrow * 64 + h * 3 + 1]), gwn = bf2f(GN[tokrow * 64 + h * 3 + 2]);
        if (tid == 0) { unionp[0] = 0u; unionp[1] = 0u; }
        const int nvalid = (t >= 31) ? ((t - 15) >> 4) : 0; const int nvmax = (t0 + 16) >> 4; const int ntile = (nvmax + 63) >> 6;
        const unsigned char* CKg = ws + WS_CK + (size_t)bg * 32768; const unsigned char* CVg = ws + WS_CVT + (size_t)bg * 32768;
        float m = -1e30f, l = 0.f; f32x16 o0 = (f32x16){}, o1 = (f32x16){};
        run_branch<0>(lds, CKg, CVg, (1ull << ntile) - 1ull, qf, m, l, o0, o1, cur, tq, nvalid, 0ull, tid, lane);
        l += __shfl_xor(l, 32);
        const float invl = (l > 0.f) ? 1.0f / l : 0.f;
        f32x16 out0 = o0 * (gc * invl), out1 = o1 * (gc * invl);
        { const int soff = (tid >> 3) * KPITCH + (tid & 7) * 16; float carry = 0.f;
          u32x4 kpre = *(const u32x4*)(CKg + tid * 16);
          for (int T = 0; T < ntile; ++T) {
            *(LAS u32x4*)(lds + AT_KB + (T & 1) * 9216 + soff) = kpre;
            kpre = *(const u32x4*)(CKg + (size_t)((T + 1 < ntile) ? T + 1 : T) * 8192 + tid * 16);
            __syncthreads();
            f32x16 p0, p1; qk_tile(lds + AT_KB + (T & 1) * 9216, qf, p0, p1, lane);
            const int nrel = nvalid - 64 * T - 4 * hh;
#pragma unroll
            for (int r = 0; r < 16; ++r) { const int c0 = crow_c(r);
                p0[r] = (c0 < nrel) ? __builtin_amdgcn_exp2f(p0[r] * SM_C - m) * invl : 0.f; p1[r] = (c0 + 32 < nrel) ? __builtin_amdgcn_exp2f(p1[r] * SM_C - m) * invl : 0.f; }
            float g4[8], last[8], oth[8];
#pragma unroll
            for (int i = 0; i < 8; ++i) { const int r0 = 4 * (i & 3); if (i < 4) { g4[i] = (p0[r0] + p0[r0 + 1]) + (p0[r0 + 2] + p0[r0 + 3]); last[i] = p0[r0 + 3]; } else { g4[i] = (p1[r0] + p1[r0 + 1]) + (p1[r0 + 2] + p1[r0 + 3]); last[i] = p1[r0 + 3]; } }
#pragma unroll
            for (int i = 0; i < 8; ++i) oth[i] = __shfl_xor(last[i], 32);
#pragma unroll
            for (int i = 0; i < 8; ++i) { const float add = hh ? oth[i] : (i ? oth[i > 0 ? i - 1 : 0] : carry); slab[(w * 32 + q) * 64 + 16 * T + 2 * i + hh] = g4[i] + add; }
            carry = oth[7];
          }
          __syncthreads(); }
#pragma unroll 1
        for (int qq = 0; qq < 4; ++qq) {
            const int qi = 4 * w + qq, J = lane; float v = 0.f;
#pragma unroll
            for (int w2 = 0; w2 < 8; ++w2) v += slab[(w2 * 32 + qi) * 64 + J];
            const bool cand = (J >= 1) && (J <= cur - 2);
            if (!cand) v = -1.0f;
            bool selc = cand;
            if (cur - 2 > 13) { int cnt = 0; const int vb = __float_as_int(v);
#pragma unroll 8
                for (int j2 = 0; j2 < 64; ++j2) { const float vj = __int_as_float(__builtin_amdgcn_readlane(vb, j2)); cnt += ((vj > v) || (vj == v && j2 < J)) ? 1 : 0; }
                selc = cand && (cnt < 13); }
            const bool forced = (J <= cur) && (J == 0 || J >= cur - 1);
            const unsigned long long mk = __ballot((selc || forced) ? 1 : 0);
            if (lane == 0) { selmp[qi] = mk; atomicOr((unsigned*)&unionp[0], (unsigned)mk); atomicOr((unsigned*)&unionp[1], (unsigned)(mk >> 32)); }
        }
        __syncthreads();
        const unsigned long long selm = selmp[q];
        const unsigned ulo = __builtin_amdgcn_readfirstlane(unionp[0]), uhi = __builtin_amdgcn_readfirstlane(unionp[1]);
        const unsigned long long uni = ((unsigned long long)uhi << 32) | ulo;
        m = -1e30f; l = 0.f; o0 = (f32x16){}; o1 = (f32x16){};
        run_branch<1>(lds, ws + WS_KS + (size_t)bg * 524288, ws + WS_VST + (size_t)bg * 524288, uni, qf, m, l, o0, o1, cur, tq, 0, selm, tid, lane);
        { l += __shfl_xor(l, 32); const float f = gs / l; out0 += o0 * f; out1 += o1 * f; }
        m = -1e30f; l = 0.f; o0 = (f32x16){}; o1 = (f32x16){};
        { const int j0 = cur - 8 > 0 ? cur - 8 : 0; const unsigned long long wm = ((cur == 63) ? ~0ull : ((1ull << (cur + 1)) - 1ull)) & ~((1ull << j0) - 1ull);
          run_branch<2>(lds, ws + WS_KW + (size_t)bg * 524288, ws + WS_VWT + (size_t)bg * 524288, wm, qf, m, l, o0, o1, cur, tq, 0, 0ull, tid, lane); }
        { l += __shfl_xor(l, 32); const float f = gwn / l; out0 += o0 * f; out1 += o1 * f; }
#pragma unroll
        for (int i = 0; i < 4; ++i) {
            u32x2 a0, a1; a0.x = cvt_pk_bf16(out0[4 * i], out0[4 * i + 1]); a0.y = cvt_pk_bf16(out0[4 * i + 2], out0[4 * i + 3]); a1.x = cvt_pk_bf16(out1[4 * i], out1[4 * i + 1]); a1.y = cvt_pk_bf16(out1[4 * i + 2], out1[4 * i + 3]);
            bf16_t* yp = (bf16_t*)((unsigned char*)qp + yoff); *(u32x2*)(yp + 8 * i + 4 * hh) = a0; *(u32x2*)(yp + 32 + 8 * i + 4 * hh) = a1;
        }
    }
}

constexpr int NPHASE = 8 * DEPTH + 3;
#ifndef ONLY_MASK
#define ONLY_MASK 0xffff
#endif
#define HAS(k) ((ONLY_MASK >> (k)) & 1)
__global__ void __launch_bounds__(512, 2) mega_fwd(Args a) {
    extern __shared__ __attribute__((aligned(16))) unsigned char lds_raw[];
    Ctx C; C.lds = (LAS unsigned char*)lds_raw; C.ws = a.ws; C.tid = threadIdx.x; C.lane = C.tid & 63; C.wave = __builtin_amdgcn_readfirstlane(C.tid >> 6);
    C.G = gridDim.x; C.bx = blockIdx.x; C.gw = C.bx * 8 + C.wave; C.NGW = C.G * 8;
    cg::grid_group grid = cg::this_grid();
    { volatile LAS unsigned* st = (volatile LAS unsigned*)(C.lds + LDS_BYTES - 64); if (C.tid < 16) st[C.tid] = 0u; __syncthreads(); }
    XcdBarrier xbar = xcd_barrier_post((unsigned*)(a.ws + WS_BAR), (volatile LAS unsigned*)(C.lds + LDS_BYTES - 64));
    unsigned char* ws = a.ws; float* X = a.out;
    int ph = 0;
#define IN_PH() (ph >= a.ph_lo && ph < a.ph_hi)
#define FRESH() do { int t_ = threadIdx.x; asm volatile("" : "+v"(t_)); C.tid = t_; C.lane = t_ & 63; C.wave = __builtin_amdgcn_readfirstlane(t_ >> 6); C.gw = C.bx * 8 + C.wave; \
    unsigned wl_ = __builtin_amdgcn_readfirstlane((unsigned)(unsigned long long)a.ws), wh_ = __builtin_amdgcn_readfirstlane((unsigned)((unsigned long long)a.ws >> 32)); asm volatile("" : "+s"(wl_), "+s"(wh_)); \
    ws = (unsigned char*)(GAS1 unsigned char*)(((unsigned long long)wh_ << 32) | wl_); C.ws = ws; \
    unsigned xl_ = __builtin_amdgcn_readfirstlane((unsigned)(unsigned long long)a.out), xh_ = __builtin_amdgcn_readfirstlane((unsigned)((unsigned long long)a.out >> 32)); asm volatile("" : "+s"(xl_), "+s"(xh_)); \
    X = (float*)(GAS1 float*)(((unsigned long long)xh_ << 32) | xl_); } while (0)
#define SEAM() do { ++ph; if (ph > a.ph_lo && ph < a.ph_hi) { if (ph == 1) grid.sync(); else xcd_barrier(xbar); } FRESH(); } while (0)
    FRESH();
    if (HAS(0) && IN_PH()) ph_prologue(a, C);
    SEAM();
    if (IN_PH() && C.bx < 8 * DEPTH) {
        const int l = C.bx >> 3; unsigned char* wl = ws + WS_W + (size_t)l * WL_STRIDE;
        EpiP<OpBf16> E{OpBf16{(bf16_t*)(ws + WS_PPF) + (size_t)l * 1024 * 512, 512}, nullptr};
        run_gemm(C.lds, (const bf16_t*)(wl + W_PP), 512, (const bf16_t*)(wl + W_POOL), 1024, 512, 512, E, 8, C.bx & 7);
    }
    SEAM();
    for (int l = 0; l < DEPTH; ++l) {
        const float* xin = (l == 0) ? AIN(a, 0) : X;
        unsigned char* wl = ws + WS_W + (size_t)l * WL_STRIDE;
        if (HAS(1) && IN_PH()) {
            EpiP<OpProj, true> E{OpProj{ws}, (const float*)(ws + WS_SS)};
            run_gemm(C.lds, (const bf16_t*)(ws + WS_XN), 1024, (const bf16_t*)(wl + W_IN), MTOK, NPAD, 1024, E, C.G, C.bx);
        }
        SEAM();
        if (IN_PH()) {
            const int ncc = (C.G >= 64) ? 32 : 0;
            if (HAS(2) && (ncc == 0 || C.bx >= ncc)) ph_post(C, false, (C.bx - ncc) * 8 + C.wave, (C.G - ncc) * 8, (bf16_t*)X);
            FRESH(); wl = ws + WS_W + (size_t)l * WL_STRIDE;
            if (HAS(4) && (ncc == 0 || C.bx < 16)) { EpiP<OpCmp1> E{OpCmp1{(bf16_t*)(ws + WS_HIDK), (const float*)(ws + WS_CBIAS) + l * 512}, nullptr}; run_gemm(C.lds, (const bf16_t*)(ws + WS_KC), 1024, (const bf16_t*)(wl + W_CK1), 4096, 256, 2048, E, ncc ? 16 : C.G, C.bx); }
            FRESH(); wl = ws + WS_W + (size_t)l * WL_STRIDE;
            if (HAS(5) && (ncc == 0 || (C.bx >= 16 && C.bx < 32))) { EpiP<OpCmp1> E{OpCmp1{(bf16_t*)(ws + WS_HIDV), (const float*)(ws + WS_CBIAS) + l * 512 + 256}, nullptr}; run_gemm(C.lds, (const bf16_t*)(ws + WS_VC), 1024, (const bf16_t*)(wl + W_CV1), 4096, 256, 2048, E, ncc ? 16 : C.G, ncc ? C.bx - 16 : C.bx); }
        }
        SEAM();
        wl = ws + WS_W + (size_t)l * WL_STRIDE;
        if (IN_PH()) {
            FRESH();
            if (HAS(6)) ph_cmp2(C, l);
        }
        SEAM();
        if (HAS(7) && IN_PH()) ph_attn(C, 0);
        SEAM();
        wl = ws + WS_W + (size_t)l * WL_STRIDE;
        if (IN_PH()) {
            if (HAS(8)) { EpiP<OpMerge1> E{OpMerge1{ws + WS_GM, (bf16_t*)(ws + WS_GM + 64 * MiB)}, nullptr}; run_gemm(C.lds, (const bf16_t*)X, 512, (const bf16_t*)(ws + WS_PPF) + (size_t)l * 1024 * 512, MTOK, 1024, 512, E, C.G, C.bx); }
            FRESH(); wl = ws + WS_W + (size_t)l * WL_STRIDE;
            if (HAS(9)) { EpiP<OpMerge2> E{OpMerge2{ws + WS_GM, (bf16_t*)(ws + WS_GM + 64 * MiB)}, nullptr}; run_gemm(C.lds, (const bf16_t*)(ws + WS_Q), 1024, (const bf16_t*)(wl + W_PN), MTOK, 1024, 1024, E, C.G, C.bx); }
        }
        SEAM();
        wl = ws + WS_W + (size_t)l * WL_STRIDE;
        if (HAS(10) && IN_PH()) { EpiResid E{(bf16_t*)(ws + WS_XN), (float*)(ws + WS_SS)}; run_gemm(C.lds, (const bf16_t*)(ws + WS_GM + 64 * MiB), 1024, (const bf16_t*)(wl + W_OUT), MTOK, 1024, 1024, E, C.G, C.bx); }
        SEAM();
        wl = ws + WS_W + (size_t)l * WL_STRIDE;
        if (HAS(11) && IN_PH()) { EpiP<OpFF1, true> E{OpFF1{(bf16_t*)(ws + WS_H)}, (const float*)(ws + WS_SS)}; run_gemm(C.lds, (const bf16_t*)(ws + WS_XN), 1024, (const bf16_t*)(wl + W_FF1), MTOK, DFF, 1024, E, C.G, C.bx); }
        SEAM();
        wl = ws + WS_W + (size_t)l * WL_STRIDE;
        if (HAS(12) && IN_PH()) { EpiResid E{(bf16_t*)(ws + WS_XN), (float*)(ws + WS_SS)}; run_gemm(C.lds, (const bf16_t*)(ws + WS_H), 4096, (const bf16_t*)(wl + W_FF2), MTOK, 1024, DFF, E, C.G, C.bx); }
        SEAM();
    }
    if (IN_PH()) { for (int m = C.gw; m < MTOK; m += C.NGW) rms_row_out((const bf16_t*)(ws + WS_XN) + (size_t)m * 1024, AIN(a, 17), X + (size_t)m * 1024, C.lane); }
#undef IN_PH
#undef SEAM
}

#ifndef MK_PER_PHASE
#define MK_PER_PHASE 0
#endif
extern "C" void kernel_launch(void* const* d_in, const int* in_sizes, int n_in, void* d_out, int out_size, void* d_ws, size_t ws_size, hipStream_t stream) {
    static int grid = 0;
    if (grid == 0) {
        if (n_in != 18 || out_size != MTOK * DM || ws_size < WS_END) { fprintf(stderr, "kernel_launch: unexpected shapes (n_in %d out %d ws %zu)\n", n_in, out_size, ws_size); grid = -1; return; }
        int dev = 0, cus = 0, per_cu = 0;
        (void)hipGetDevice(&dev); (void)hipDeviceGetAttribute(&cus, hipDeviceAttributeMultiprocessorCount, dev);
        if (hipFuncSetAttribute((const void*)mega_fwd, hipFuncAttributeMaxDynamicSharedMemorySize, LDS_BYTES) != hipSuccess) { fprintf(stderr, "kernel_launch: hipFuncSetAttribute failed\n"); grid = -1; return; }
        if (hipOccupancyMaxActiveBlocksPerMultiprocessor(&per_cu, (const void*)mega_fwd, 512, LDS_BYTES) != hipSuccess || per_cu < 1) { fprintf(stderr, "kernel_launch: occupancy query %d\n", per_cu); per_cu = 1; }
        (void)hipGetLastError();
        grid = cus * (per_cu > 1 ? 1 : per_cu);
        if (grid <= 0) grid = 256;
    }
    if (grid < 0) return;
    Args a{};
    for (int i = 0; i < 18; ++i) a.in[i] = (const float*)d_in[i];
    a.out = (float*)d_out; a.ws = (unsigned char*)d_ws;
    for (int i = 0; i < 32; ++i) a.invf[i] = pow(10000.0, -(double)(2 * i) / 64.0);
#if MK_PER_PHASE
    for (int p = 0; p < NPHASE; ++p) { a.ph_lo = p; a.ph_hi = p + 1; hipLaunchKernelGGL(mega_fwd, dim3(grid), dim3(512), LDS_BYTES, stream, a); }
#else
    a.ph_lo = 0; a.ph_hi = NPHASE;
    (void)hipMemsetAsync((unsigned char*)d_ws + WS_BAR, 0, 16384, stream);
    void* args[] = {&a};
    hipError_t e = hipLaunchCooperativeKernel((const void*)mega_fwd, dim3(grid), dim3(512), args, LDS_BYTES, stream);
    if (e != hipSuccess) fprintf(stderr, "cooperative launch failed: %s (grid %d)\n", hipGetErrorString(e), grid);
#endif
}
```

```cpp
#include <hip/hip_runtime.h>
#include <hip/hip_cooperative_groups.h>
#include <cstdio>
#include <cstdint>
#include <cmath>
#include <type_traits>
namespace cg = cooperative_groups;
namespace pg8 {
#define PG8_LAS __attribute__((address_space(3)))
typedef unsigned short bf16_t;
typedef short bf16x8 __attribute__((ext_vector_type(8)));
typedef float f32x4 __attribute__((ext_vector_type(4)));
typedef unsigned u32x4 __attribute__((ext_vector_type(4)));
constexpr int BM = 256, BK = 64, HALF = 128, HTB = HALF * BK * 2  , STAGE_BYTES = 8 * HTB, NXCD = 8, WGM = 8;

__host__ __device__ __forceinline__ int lds_byte(int r, int c) { const int st = (r >> 4) * 2 + (c >> 5), rr = r & 15, cc = c & 31, ob = rr * 64 + cc * 2; return st * 1024 + (ob ^ (((ob >> 9) & 1) << 5)); }
__host__ __device__ __forceinline__ void stage_rc(int b, int& R, int& C) { const int st = b / 1024, sb = b % 1024, swz = sb ^ (((sb >> 9) & 1) << 5); R = (st >> 1) * 16 + swz / 64; C = (st & 1) * 32 + (swz % 64) / 2; }
__host__ __device__ __forceinline__ int perm32(int rho) { const int n = rho >> 4, i = rho & 15; return 8 * (i >> 2) + 4 * n + (i & 3); }

struct Unit { int pm, pn; };
struct Gemm { const bf16_t* A; const bf16_t* Bt; int M, N, K, lda; };

struct StaticOrder {
    int nM, nN, nwg, G, c;
    __host__ __device__ void init(int M, int N, int G_, int c_) { nM = M / BM; nN = N / BM; nwg = nM * nN; G = G_; c = c_; }
    __host__ __device__ bool next(int i, Unit& u) const {
        const long L = (long)i * G + c; if (L >= nwg) return false;
        int wgid = (int)L; { const int q = nwg / NXCD, r = nwg % NXCD, xcd = wgid % NXCD, off = wgid / NXCD; wgid = (xcd < r ? xcd * (q + 1) : r * (q + 1) + (xcd - r) * q) + off; }
        const int nig = WGM * nN, gid = wgid / nig, fm = gid * WGM, gsz = (nM - fm) < WGM ? (nM - fm) : WGM;
        u.pm = fm + ((wgid % nig) % gsz); u.pn = (wgid % nig) / gsz; return true;
    }
    __device__ __forceinline__ void a_ready(const Unit&) const {}
    __device__ __forceinline__ void done(const Unit&) const {}
};

__device__ __forceinline__ unsigned cvt_pk_bf16(float lo, float hi) { unsigned r; asm volatile("v_cvt_pk_bf16_f32 %0, %1, %2" : "=v"(r) : "v"(lo), "v"(hi)); return r; }
typedef float f32x2 __attribute__((ext_vector_type(2)));
template <class Epi, class Sched, bool ALIGN_EPI = false, bool SP2 = false>
__device__ __forceinline__ void gemm_phase(PG8_LAS unsigned char* lds, const Gemm g, const Sched& S, const Epi& E) {
    int tid_ = threadIdx.x; asm volatile("" : "+v"(tid_));
    const int tid = tid_, wid = __builtin_amdgcn_readfirstlane(tid >> 6), lane = tid & 63, wr = wid >> 2, wc = wid & 3, fr = lane & 15, fq = lane >> 4;
    const int K = g.K, nt = K / BK;
    unsigned voffA[2], voffB[2];
#pragma unroll
    for (int i = 0; i < 2; ++i) { int R, C; stage_rc(tid * 16 + i * 8192, R, C); const int Rb = Epi::PERM ? ((R & ~31) + perm32(R & 31)) : R;
        voffA[i] = (unsigned)(R * g.lda + C) * 2u; voffB[i] = (unsigned)(Rb * K + C) * 2u; }
    const size_t kstep = (size_t)(BK * 2);
    const size_t hstepB = (size_t)HALF * K * 2, hstepA = (size_t)HALF * g.lda * 2;
    const size_t tstepA = 2 * hstepA, tstepB = 2 * hstepB;
    const unsigned ldsw = (unsigned)wid * 1024u;
    const int aoff = lds_byte(wr * 64 + fr, fq * 8), boff = lds_byte(wc * 32 + fr, fq * 8);
#define PG8_SA(b, h) (((b) * 2 + (h)) * HTB)
#define PG8_SB(b, h) ((4 + (b) * 2 + (h)) * HTB)
#define PG8_STAGE(bufoff, gbase, voff) do { _Pragma("unroll") for (int _i = 0; _i < 2; ++_i) \
        __builtin_amdgcn_global_load_lds((const unsigned*)((const char*)(gbase) + (voff)[_i]), (PG8_LAS unsigned*)(lds + (bufoff) + ldsw + _i * 8192), 16, 0, 0); } while (0)
#define PG8_LDA(dst, b, h) do { _Pragma("unroll") for (int m = 0; m < 4; ++m) _Pragma("unroll") for (int k = 0; k < 2; ++k) dst[m][k] = *(const PG8_LAS bf16x8*)(lds + PG8_SA(b, h) + aoff + m * 2048 + k * 1024); } while (0)
#define PG8_LDB(dst, b, h) do { _Pragma("unroll") for (int n = 0; n < 2; ++n) _Pragma("unroll") for (int k = 0; k < 2; ++k) dst[n][k] = *(const PG8_LAS bf16x8*)(lds + PG8_SB(b, h) + boff + n * 2048 + k * 1024); } while (0)
#define PG8_MMA(ai, bj, At, Bt) do { __builtin_amdgcn_s_setprio(1); _Pragma("unroll") for (int m = 0; m < 4; ++m) _Pragma("unroll") for (int n = 0; n < 2; ++n) _Pragma("unroll") for (int k = 0; k < 2; ++k) \
        acc[ai][bj][m][n] = __builtin_amdgcn_mfma_f32_16x16x32_bf16(Bt[n][k], At[m][k], acc[ai][bj][m][n], 0, 0, 0); __builtin_amdgcn_s_setprio(0); } while (0)
#define PG8_WAIT_V(n) asm volatile("s_waitcnt vmcnt(" #n ")" ::: "memory")
#define PG8_WAIT_L(n) asm volatile("s_waitcnt lgkmcnt(" #n ")" ::: "memory")
#define PG8_BAR __builtin_amdgcn_s_barrier()
#define PG8_SCHED __builtin_amdgcn_sched_barrier(0)
    Unit cur, nxt; int ui = 0;
    if (!S.next(0, cur)) return;
    f32x4 acc[2][2][4][2];
#pragma unroll
    for (int a = 0; a < 2; ++a)
#pragma unroll
        for (int b = 0; b < 2; ++b)
#pragma unroll
            for (int m = 0; m < 4; ++m)
#pragma unroll
                for (int n = 0; n < 2; ++n) acc[a][b][m][n] = (f32x4){0.f, 0.f, 0.f, 0.f};
    bf16x8 At[4][2], B0[2][2], B1[2][2];
    const char* cA = (const char*)g.A + (size_t)cur.pm * tstepA; const char* cB = (const char*)g.Bt + (size_t)cur.pn * tstepB;
    S.a_ready(cur);
    if constexpr (SP2) {
        PG8_STAGE(PG8_SB(0, 0), cB, voffB); PG8_STAGE(PG8_SB(0, 1), cB + hstepB, voffB); PG8_STAGE(PG8_SA(0, 0), cA, voffA); PG8_STAGE(PG8_SA(0, 1), cA + hstepA, voffA);
        if (wr == 1) PG8_BAR;
        PG8_WAIT_V(2); PG8_BAR;
        PG8_STAGE(PG8_SB(1, 0), cB + kstep, voffB); PG8_STAGE(PG8_SA(1, 0), cA + kstep, voffA); PG8_STAGE(PG8_SB(1, 1), cB + hstepB + kstep, voffB);
        PG8_WAIT_V(6); PG8_BAR;
    } else {
        PG8_STAGE(PG8_SB(0, 0), cB, voffB); PG8_STAGE(PG8_SA(0, 0), cA, voffA); PG8_STAGE(PG8_SB(0, 1), cB + hstepB, voffB); PG8_STAGE(PG8_SA(0, 1), cA + hstepA, voffA);
        if (wr == 1) PG8_BAR;
        PG8_WAIT_V(4); PG8_BAR;
        PG8_STAGE(PG8_SB(1, 0), cB + kstep, voffB); PG8_STAGE(PG8_SA(1, 0), cA + kstep, voffA); PG8_STAGE(PG8_SB(1, 1), cB + hstepB + kstep, voffB);
        PG8_WAIT_V(6); PG8_BAR;
    }
    for (;;) {
        const bool has_next = S.next(ui + 1, nxt);
        const char* nA = has_next ? (const char*)g.A + (size_t)nxt.pm * tstepA : cA; const char* nB = has_next ? (const char*)g.Bt + (size_t)nxt.pn * tstepB : cB;
        for (int t = 0; t < nt; t += 2) {
            const bool last = (t == nt - 2);
            const char* a1 = cA + (size_t)(t + 1) * kstep;
            const char* a2 = last ? nA : cA + (size_t)(t + 2) * kstep; const char* b2 = last ? nB : cB + (size_t)(t + 2) * kstep;
            const char* a3 = a2 + kstep; const char* b3 = b2 + kstep;
            if (last && has_next) S.a_ready(nxt);
            if constexpr (SP2) {
            PG8_LDB(B0, 0, 0); PG8_LDB(B1, 0, 1); PG8_SCHED; PG8_LDA(At, 0, 0); PG8_STAGE(PG8_SA(1, 1), a1 + hstepA, voffA);
            PG8_WAIT_V(8); PG8_WAIT_L(0); PG8_BAR; PG8_MMA(0, 0, At, B0); PG8_MMA(0, 1, At, B1); PG8_BAR; PG8_SCHED;
            PG8_LDA(At, 0, 1); PG8_STAGE(PG8_SB(0, 0), b2, voffB); PG8_STAGE(PG8_SB(0, 1), b2 + hstepB, voffB); PG8_STAGE(PG8_SA(0, 0), a2, voffA);
            PG8_WAIT_V(8); PG8_WAIT_L(0); PG8_BAR; PG8_MMA(1, 0, At, B0); PG8_MMA(1, 1, At, B1); PG8_BAR; PG8_SCHED;
            PG8_LDB(B0, 1, 0); PG8_LDB(B1, 1, 1); PG8_SCHED; PG8_LDA(At, 1, 0); PG8_STAGE(PG8_SA(0, 1), a2 + hstepA, voffA);
            PG8_WAIT_V(8); PG8_WAIT_L(0); PG8_BAR; PG8_MMA(0, 0, At, B0); PG8_MMA(0, 1, At, B1); PG8_BAR; PG8_SCHED;
            PG8_LDA(At, 1, 1); PG8_STAGE(PG8_SB(1, 0), b3, voffB); PG8_STAGE(PG8_SB(1, 1), b3 + hstepB, voffB); PG8_STAGE(PG8_SA(1, 0), a3, voffA);
            PG8_WAIT_V(8); PG8_WAIT_L(0); PG8_BAR; PG8_MMA(1, 0, At, B0); PG8_MMA(1, 1, At, B1); PG8_BAR; PG8_SCHED;
            } else {
            PG8_LDB(B0, 0, 0); PG8_SCHED; PG8_LDA(At, 0, 0); PG8_STAGE(PG8_SA(1, 1), a1 + hstepA, voffA);
            PG8_WAIT_L(8); PG8_BAR; PG8_WAIT_L(0); PG8_MMA(0, 0, At, B0); PG8_BAR; PG8_SCHED;
            PG8_LDB(B1, 0, 1); PG8_STAGE(PG8_SB(0, 0), b2, voffB);
            PG8_BAR; PG8_WAIT_L(0); PG8_MMA(0, 1, At, B1); PG8_BAR;
            PG8_LDA(At, 0, 1); PG8_STAGE(PG8_SA(0, 0), a2, voffA);
            PG8_BAR; PG8_WAIT_L(0); PG8_MMA(1, 0, At, B0); PG8_BAR; PG8_SCHED;
            PG8_STAGE(PG8_SB(0, 1), b2 + hstepB, voffB);
            PG8_WAIT_V(6); PG8_BAR; PG8_MMA(1, 1, At, B1); PG8_BAR;
            PG8_LDB(B0, 1, 0); PG8_SCHED; PG8_LDA(At, 1, 0); PG8_STAGE(PG8_SA(0, 1), a2 + hstepA, voffA);
            PG8_WAIT_L(8); PG8_BAR; PG8_WAIT_L(0); PG8_MMA(0, 0, At, B0); PG8_BAR; PG8_SCHED;
            PG8_LDB(B1, 1, 1); PG8_STAGE(PG8_SB(1, 0), b3, voffB);
            PG8_BAR; PG8_WAIT_L(0); PG8_MMA(0, 1, At, B1); PG8_BAR;
            PG8_LDA(At, 1, 1); PG8_STAGE(PG8_SA(1, 0), a3, voffA);
            PG8_BAR; PG8_WAIT_L(0); PG8_MMA(1, 0, At, B0); PG8_BAR; PG8_SCHED;
            PG8_STAGE(PG8_SB(1, 1), b3 + hstepB, voffB);
            PG8_WAIT_V(6); PG8_BAR; PG8_MMA(1, 1, At, B1); PG8_BAR;
            }
        }
        if constexpr (ALIGN_EPI) { if (wr == 0) PG8_BAR; }
        if constexpr (!Epi::AFTER_DRAIN) { E(acc, cur, wr, wc, fr, fq); S.done(cur); }
        if (!has_next) break;
#pragma unroll
        for (int a = 0; a < 2; ++a)
#pragma unroll
            for (int b = 0; b < 2; ++b)
#pragma unroll
                for (int m = 0; m < 4; ++m)
#pragma unroll
                    for (int n = 0; n < 2; ++n) acc[a][b][m][n] = (f32x4){0.f, 0.f, 0.f, 0.f};
        cur = nxt; cA = nA; cB = nB; ++ui;
        if constexpr (ALIGN_EPI) { if (wr == 1) PG8_BAR; }
    }
    PG8_WAIT_V(0);
    if constexpr (!ALIGN_EPI) { if (wr == 0) PG8_BAR; }
    PG8_BAR;
    if constexpr (Epi::AFTER_DRAIN) { E.fused(acc, cur, wr, wc, fr, fq, lds, wid, lane); S.done(cur); }
#undef PG8_SA
#undef PG8_SB
#undef PG8_STAGE
#undef PG8_LDA
#undef PG8_LDB
#undef PG8_MMA
#undef PG8_WAIT_V
#undef PG8_WAIT_L
#undef PG8_BAR
#undef PG8_SCHED
}
}
#define LAS __attribute__((address_space(3)))
#define XB_TMO      128
#define XB_XCNT(j)  (256  + 64 * (j))
#define XB_XSUB(j)  (1280 + 64 * (j))
#define XB_XGEN(j)  (2304 + 64 * (j))
#define XB_TOP      3328
#define XB_TOPGEN   3392
#define XCD_BAR_WORDS 3456
#define XB_SPIN_CAP (1u << 18)

__device__ __forceinline__ unsigned xb_ld(unsigned* p)              { return __hip_atomic_load(p, __ATOMIC_RELAXED, __HIP_MEMORY_SCOPE_AGENT); }
__device__ __forceinline__ unsigned xb_add(unsigned* p, unsigned v) { return __hip_atomic_fetch_add(p, v, __ATOMIC_RELAXED, __HIP_MEMORY_SCOPE_AGENT); }
__device__ __forceinline__ unsigned xb_xcc_id() { return (unsigned)__builtin_amdgcn_s_getreg((3 << 11) | 20) & 0xFu; }
#define XB_SPIN(cond, bar) do { unsigned _sp = 0; while (cond) { __builtin_amdgcn_s_sleep(1); \
    if ((++_sp & 255u) == 0u) { if (xb_ld(&(bar)[XB_TMO])) break; if (_sp > XB_SPIN_CAP) { atomicAdd(&(bar)[XB_TMO], 1u); break; } } } } while (0)

struct XcdBarrier {
    unsigned* bar; unsigned x;
    volatile LAS unsigned* st;
};

__device__ __forceinline__ XcdBarrier xcd_barrier_post(unsigned* bar, volatile LAS unsigned* st) {
    XcdBarrier b; b.bar = bar; b.x = xb_xcc_id(); b.st = st;
    if (threadIdx.x == 0) (void)xb_add(&bar[XB_XCNT(b.x)], 1u);
    return b;
}
__device__ __forceinline__ void xcd_barrier_complete(unsigned* bar, unsigned x, unsigned& nloc, unsigned& nx) {
    const unsigned G = gridDim.x * gridDim.y * gridDim.z;
    unsigned sum, cnt, mine, sp = 0u;
    for (;;) {
        sum = 0u; cnt = 0u; mine = 0u;
#pragma unroll
        for (unsigned j = 0; j < 16; ++j) { const unsigned c = xb_ld(&bar[XB_XCNT(j)]); sum += c; cnt += (c > 0u) ? 1u : 0u; mine = (j == x) ? c : mine; }
        if (sum == G) break;
        __builtin_amdgcn_s_sleep(1);
        if ((++sp & 255u) == 0u) { if (xb_ld(&bar[XB_TMO])) break; if (sp > XB_SPIN_CAP) { atomicAdd(&bar[XB_TMO], 1u); break; } }
    }
    nloc = mine > 0u ? mine : 1u; nx = cnt > 0u ? cnt : 1u;
}

__device__ __forceinline__ void xcd_barrier(const XcdBarrier& b) {
    asm volatile("s_waitcnt vmcnt(0)" ::: "memory");
    __syncthreads();
    if (threadIdx.x == 0) {
        unsigned* bar = b.bar;
        __builtin_amdgcn_s_waitcnt(0);
        unsigned nloc = b.st[0], nx = b.st[1];
        if (nloc == 0u) { xcd_barrier_complete(bar, b.x, nloc, nx); b.st[0] = nloc; b.st[1] = nx; }
        const unsigned old = xb_add(&bar[XB_XSUB(b.x)], 1u);
        const unsigned gen = old / nloc;
        if (old + 1u == (gen + 1u) * nloc) {
            __builtin_amdgcn_fence(__ATOMIC_RELEASE, "agent");
            asm volatile("s_waitcnt vmcnt(0)" ::: "memory");
            const unsigned og = xb_add(&bar[XB_TOP], 1u);
            const unsigned tg = og / nx;
            if (og + 1u == (tg + 1u) * nx) xb_add(&bar[XB_TOPGEN], 1u);
            else XB_SPIN(xb_ld(&bar[XB_TOPGEN]) == tg, bar);
            __builtin_amdgcn_fence(__ATOMIC_ACQUIRE, "agent");
            xb_add(&bar[XB_XGEN(b.x)], 1u);
            asm volatile("s_waitcnt vmcnt(0)" ::: "memory");
        } else {
            XB_SPIN(xb_ld(&bar[XB_XGEN(b.x)]) == gen, bar);
            __builtin_amdgcn_fence(__ATOMIC_ACQUIRE, "agent");
            asm volatile("s_waitcnt vmcnt(0)" ::: "memory");
        }
    }
    __syncthreads();
}
#undef LAS
using namespace pg8;
#define LAS __attribute__((address_space(3)))
typedef float f32x16 __attribute__((ext_vector_type(16)));
typedef unsigned u32x2 __attribute__((ext_vector_type(2)));
#define LDS_WAIT() asm volatile("s_waitcnt lgkmcnt(0)" ::: "memory")

constexpr int DM = 1024, NBATCH = 8, SEQ = 4096, MTOK = NBATCH * SEQ, DEPTH = 4, NIN = 4400, NPAD = 4608, DFF = 4096;
constexpr size_t MiB = 1u << 20;
constexpr size_t WS_ROPEC = 0, WS_ROPES = 512 * 1024, WS_CBIAS = 1 * MiB, WS_BAR = 1 * MiB + 64 * 1024;
constexpr size_t WS_W = 2 * MiB, WL_STRIDE = 33 * MiB;
constexpr size_t W_IN = 0, W_POOL = 9 * MiB, W_CK1 = W_POOL + MiB / 2, W_CV1 = W_CK1 + MiB, W_PP = W_CV1 + MiB, W_PN = W_PP + MiB,
                 W_OUT = W_PN + 2 * MiB, W_FF1 = W_OUT + 2 * MiB, W_FF2 = W_FF1 + 8 * MiB, W_CK2 = W_FF2 + 8 * MiB, W_CV2 = W_CK2 + 32 * 1024;
constexpr size_t WS_SS = 134 * MiB;
constexpr size_t WS_XN = 136 * MiB;
constexpr size_t WS_CK = 200 * MiB, WS_CVT = WS_CK + MiB / 2, WS_HIDK = 201 * MiB, WS_HIDV = 203 * MiB;
constexpr size_t WS_U = 206 * MiB, WS_Q = 238 * MiB, WS_KC = 302 * MiB, WS_VC = 310 * MiB, WS_KS = 318 * MiB, WS_VS = 326 * MiB, WS_KW = 334 * MiB,
                 WS_VW = 342 * MiB, WS_VST = 350 * MiB, WS_VWT = 358 * MiB, WS_GNSA = 366 * MiB, WS_GM = 370 * MiB;
constexpr size_t WS_H = 206 * MiB;
constexpr size_t WS_PPF = 500 * MiB;
constexpr size_t WS_END = 504 * MiB;
constexpr int LDS_BYTES = 135168;

__device__ __forceinline__ int launder_s(int i) { i = __builtin_amdgcn_readfirstlane(i); asm volatile("" : "+s"(i)); return i; }
#define GAS1 __attribute__((address_space(1)))
#define AIN(a, i) ((const float*)(const GAS1 float*)((a).in[launder_s(i)]))
struct Args { const float* in[18]; float* out; unsigned char* ws; double invf[32]; int ph_lo, ph_hi; };

__device__ __forceinline__ float bf2f(unsigned short u) { return __uint_as_float((unsigned)u << 16); }
__device__ __forceinline__ float bflo(unsigned w) { return __uint_as_float(w << 16); }
__device__ __forceinline__ float bfhi(unsigned w) { return __uint_as_float(w & 0xffff0000u); }
__device__ __forceinline__ unsigned short f2bf(float f) { return (unsigned short)(cvt_pk_bf16(f, f) & 0xffffu); }
__device__ __forceinline__ float wave_sum(float v) {
#pragma unroll
    for (int o = 1; o < 64; o <<= 1) v += __shfl_xor(v, o);
    return v;
}
__device__ __forceinline__ float sigmoidf_(float x) { return __builtin_amdgcn_rcpf(1.0f + __builtin_amdgcn_exp2f(-1.4426950408889634f * x)); }
__device__ __forceinline__ f32x4 sigmoid4(f32x4 v) { return (f32x4){sigmoidf_(v[0]), sigmoidf_(v[1]), sigmoidf_(v[2]), sigmoidf_(v[3])}; }
__device__ __forceinline__ float gelu_tanh(float x) {
    const float y = 0.7978845608028654f * (x + 0.044715f * x * x * x);
    const float e = __builtin_amdgcn_exp2f(2.0f * 1.4426950408889634f * y);
    const float th = 1.0f - 2.0f * __builtin_amdgcn_rcpf(1.0f + e);
    return 0.5f * x * (1.0f + th);
}
__device__ __forceinline__ void store8(bf16_t* dst, f32x4 v0, f32x4 v1) {
    u32x4 w; w.x = cvt_pk_bf16(v0[0], v0[1]); w.y = cvt_pk_bf16(v0[2], v0[3]); w.z = cvt_pk_bf16(v1[0], v1[1]); w.w = cvt_pk_bf16(v1[2], v1[3]);
    *(u32x4*)dst = w;
}

template <class T, class = void> struct has_pair : std::false_type {};
template <class T> struct has_pair<T, std::void_t<decltype(T::HAS_PAIR)>> : std::true_type {};
template <class Op, bool RS = false> struct EpiP {
    static constexpr bool PERM = true, AFTER_DRAIN = false; Op op; const float* ss;
    __device__ __forceinline__ void operator()(const f32x4 (&acc)[2][2][4][2], const Unit& u, int wr, int wc, int fr, int fq) const {
#pragma unroll
        for (int ai = 0; ai < 2; ++ai) {
            const int row0 = u.pm * 256 + ai * 128 + wr * 64 + fr; float r[4] = {1.0f, 1.0f, 1.0f, 1.0f};
            if (RS) { f32x4 t[4][4];
#pragma unroll
                for (int m = 0; m < 4; ++m) { const f32x4* sp = (const f32x4*)(ss + (size_t)(row0 + m * 16) * 16);
#pragma unroll
                    for (int k = 0; k < 4; ++k) t[m][k] = sp[k]; }
#pragma unroll
                for (int m = 0; m < 4; ++m) { const f32x4 q = (t[m][0] + t[m][1]) + (t[m][2] + t[m][3]); r[m] = 1.0f / sqrtf(((q.x + q.y) + (q.z + q.w)) * (1.0f / 1024.0f) + 1e-6f); } }
            if constexpr (has_pair<Op>::value) { if (op.is_pair(u.pn)) {
#pragma unroll
                for (int m = 0; m < 4; ++m) op.apply_pair(row0 + m * 16, wc, fq, acc[ai][0][m][0] * r[m], acc[ai][0][m][1] * r[m], acc[ai][1][m][0] * r[m], acc[ai][1][m][1] * r[m]);
                continue; } }
            typename Op::Pre pre[4][2];
#pragma unroll
            for (int m = 0; m < 4; ++m)
#pragma unroll
                for (int bj = 0; bj < 2; ++bj) pre[m][bj] = op.load(u.pn, row0 + m * 16, bj * 128 + wc * 32 + 8 * fq);
#pragma unroll
            for (int m = 0; m < 4; ++m)
#pragma unroll
                for (int bj = 0; bj < 2; ++bj) op.apply(u.pn, row0 + m * 16, bj * 128 + wc * 32 + 8 * fq, acc[ai][bj][m][0] * r[m], acc[ai][bj][m][1] * r[m], pre[m][bj]);
        }
    }
};
struct EpiResid {
    static constexpr bool PERM = true, AFTER_DRAIN = false; bf16_t* xb; float* ss;
    __device__ __forceinline__ void operator()(const f32x4 (&acc)[2][2][4][2], const Unit& u, int wr, int wc, int fr, int fq) const {
#pragma unroll
        for (int ai = 0; ai < 2; ++ai) {
            const int row0 = u.pm * 256 + ai * 128 + wr * 64 + fr; const int col0 = u.pn * 256 + wc * 32 + 8 * fq;
            u32x4 xv[4][2];
#pragma unroll
            for (int m = 0; m < 4; ++m)
#pragma unroll
                for (int bj = 0; bj < 2; ++bj) xv[m][bj] = *(const u32x4*)(xb + (size_t)(row0 + m * 16) * 1024 + col0 + bj * 128);
#pragma unroll
            for (int m = 0; m < 4; ++m) { const int row = row0 + m * 16; float sq = 0.f;
#pragma unroll
                for (int bj = 0; bj < 2; ++bj) { const size_t o = (size_t)row * 1024 + col0 + bj * 128; const u32x4 x = xv[m][bj];
                    const f32x4 v0 = (f32x4){bflo(x.x), bfhi(x.x), bflo(x.y), bfhi(x.y)} + acc[ai][bj][m][0], v1 = (f32x4){bflo(x.z), bfhi(x.z), bflo(x.w), bfhi(x.w)} + acc[ai][bj][m][1];
                    store8(xb + o, v0, v1);
                    sq += ((v0.x * v0.x + v0.y * v0.y) + (v0.z * v0.z + v0.w * v0.w)) + ((v1.x * v1.x + v1.y * v1.y) + (v1.z * v1.z + v1.w * v1.w)); }
                sq += __shfl_xor(sq, 16); sq += __shfl_xor(sq, 32);
                if (fq == 0) ss[(size_t)row * 16 + u.pn * 4 + wc] = sq; }
        }
    }
};
__device__ __forceinline__ constexpr int PIperm(int p) { return (p & ~12) | ((p & 8) >> 1) | ((p & 4) << 1); }
struct NoPre {};
struct OpProj { unsigned char* ws; typedef NoPre Pre; static constexpr bool HAS_PAIR = true;
    __device__ __forceinline__ bool is_pair(int pn) const { return pn == 7; }
    __device__ __forceinline__ void apply_pair(int row, int wc, int fq, f32x4 a0, f32x4 a1, f32x4 b0, f32x4 b1) const {
        const unsigned g = wc & 1, d0 = 8 * fq, b = (unsigned)row >> 12, t = row & 4095;
        const unsigned ro = (t * 32 + d0) * 4;
        const unsigned ko = (unsigned)((wc >> 1) ? WS_KW : WS_KS) + (((b * 2 + g) * 4096 + t) * 64 + d0) * 2;
        { const f32x4 c0 = *(const f32x4*)(ws + WS_ROPEC + ro), s0 = *(const f32x4*)(ws + WS_ROPES + ro);
          const f32x4 y1 = a0 * c0 - b0 * s0, y2 = b0 * c0 + a0 * s0; u32x2 w1, w2; w1.x = cvt_pk_bf16(y1[0], y1[1]); w1.y = cvt_pk_bf16(y1[2], y1[3]); w2.x = cvt_pk_bf16(y2[0], y2[1]); w2.y = cvt_pk_bf16(y2[2], y2[3]);
          *(u32x2*)(ws + ko) = w1; *(u32x2*)(ws + ko + 64) = w2; }
        { const f32x4 c1 = *(const f32x4*)(ws + WS_ROPEC + ro + 16), s1 = *(const f32x4*)(ws + WS_ROPES + ro + 16);
          const f32x4 y1 = a1 * c1 - b1 * s1, y2 = b1 * c1 + a1 * s1; u32x2 w1, w2; w1.x = cvt_pk_bf16(y1[0], y1[1]); w1.y = cvt_pk_bf16(y1[2], y1[3]); w2.x = cvt_pk_bf16(y2[0], y2[1]); w2.y = cvt_pk_bf16(y2[2], y2[3]);
          *(u32x2*)(ws + ko + 8) = w1; *(u32x2*)(ws + ko + 72) = w2; }
    }
    __device__ __forceinline__ Pre load(int, int, int) const { return Pre{}; }
    __device__ __forceinline__ void apply(int pn, int row, int lc, f32x4 v0, f32x4 v1, const Pre&) const {
        size_t off; bool sig = false;
        if (pn < 2) off = WS_U + ((size_t)row * 512 + pn * 256 + lc) * 2;
        else if (pn < 6) off = WS_Q + ((size_t)row * 1024 + (pn - 2) * 256 + lc) * 2;
        else if (pn == 6) { const int c = lc & 127, g = c >> 6, dh = c & 63, b = row >> 12, t = row & 4095;
            off = WS_KC + (size_t)(lc >> 7) * (8 * MiB) + (((size_t)((b * 2 + g) * 4096 + t)) * 64 + dh) * 2; }
        else if (pn == 8) {
            const int c = lc & 127, g = c >> 6, dh = c & 63, b = row >> 12, t = row & 4095;
            bf16_t* vt = (bf16_t*)(ws + ((lc >> 7) ? WS_VWT : WS_VST)) + ((size_t)(b * 2 + g) * 64 + (t >> 6)) * 4096 + dh * 64 + PIperm(t & 63);
#pragma unroll
            for (int j = 0; j < 4; ++j) { vt[j * 64] = f2bf(v0[j]); vt[(4 + j) * 64] = f2bf(v1[j]); }
            return; }
        else if (pn == 7) return;
        else if (pn == 9) { if (lc >= 64) return; off = WS_GNSA + ((size_t)row * 64 + lc) * 2; sig = true; }
        else {
            v0 = sigmoid4(v0); v1 = sigmoid4(v1); u32x2 w;
            w.x = (unsigned)(v0[0] * 255.0f + 0.5f) | ((unsigned)(v0[1] * 255.0f + 0.5f) << 8) | ((unsigned)(v0[2] * 255.0f + 0.5f) << 16) | ((unsigned)(v0[3] * 255.0f + 0.5f) << 24);
            w.y = (unsigned)(v1[0] * 255.0f + 0.5f) | ((unsigned)(v1[1] * 255.0f + 0.5f) << 8) | ((unsigned)(v1[2] * 255.0f + 0.5f) << 16) | ((unsigned)(v1[3] * 255.0f + 0.5f) << 24);
            *(u32x2*)(ws + WS_GM + (size_t)row * 2048 + (pn - 10) * 256 + lc) = w; return; }
        if (sig) { v0 = sigmoid4(v0); v1 = sigmoid4(v1); }
        store8((bf16_t*)(ws + off), v0, v1);
    } };
struct OpBf16 { bf16_t* O; int ld; typedef NoPre Pre;
    __device__ __forceinline__ Pre load(int, int, int) const { return Pre{}; }
    __device__ __forceinline__ void apply(int pn, int row, int lc, f32x4 v0, f32x4 v1, const Pre&) const { store8(O + (size_t)row * ld + pn * 256 + lc, v0, v1); } };
struct OpCmp1 { bf16_t* H; const float* bias; struct Pre { f32x4 b0, b1; };
    __device__ __forceinline__ Pre load(int, int, int lc) const { return Pre{*(const f32x4*)(bias + lc), *(const f32x4*)(bias + lc + 4)}; }
    __device__ __forceinline__ void apply(int pn, int row, int lc, f32x4 v0, f32x4 v1, const Pre& p) const {
        v0 += p.b0; v1 += p.b1;
#pragma unroll
        for (int i = 0; i < 4; ++i) { v0[i] = gelu_tanh(v0[i]); v1[i] = gelu_tanh(v1[i]); }
        store8(H + (size_t)row * 256 + lc, v0, v1);
    } };
__device__ __forceinline__ void ungate8(u32x2 g, float (&f)[8]) { constexpr float k = 1.0f / 255.0f;
    f[0] = (float)(g.x & 255u) * k; f[1] = (float)((g.x >> 8) & 255u) * k; f[2] = (float)((g.x >> 16) & 255u) * k; f[3] = (float)(g.x >> 24) * k;
    f[4] = (float)(g.y & 255u) * k; f[5] = (float)((g.y >> 8) & 255u) * k; f[6] = (float)((g.y >> 16) & 255u) * k; f[7] = (float)(g.y >> 24) * k; }
struct OpMerge1 { const unsigned char* G8; bf16_t* MG; struct Pre { u32x2 g; };
    __device__ __forceinline__ Pre load(int pn, int row, int lc) const { return Pre{*(const u32x2*)(G8 + (size_t)row * 2048 + pn * 256 + lc)}; }
    __device__ __forceinline__ void apply(int pn, int row, int lc, f32x4 v0, f32x4 v1, const Pre& p) const {
        float g[8]; ungate8(p.g, g);
#pragma unroll
        for (int i = 0; i < 4; ++i) { v0[i] *= g[i]; v1[i] *= g[4 + i]; }
        store8(MG + (size_t)row * 1024 + pn * 256 + lc, v0, v1);
    } };
struct OpMerge2 { const unsigned char* G8; bf16_t* MG; struct Pre { u32x4 t; u32x2 g; };
    __device__ __forceinline__ Pre load(int pn, int row, int lc) const { return Pre{*(const u32x4*)(MG + (size_t)row * 1024 + pn * 256 + lc), *(const u32x2*)(G8 + (size_t)row * 2048 + 1024 + pn * 256 + lc)}; }
    __device__ __forceinline__ void apply(int pn, int row, int lc, f32x4 v0, f32x4 v1, const Pre& p) const {
        const u32x4 t = p.t; float g[8]; ungate8(p.g, g);
        v0[0] = v0[0] * g[0] + bflo(t.x); v0[1] = v0[1] * g[1] + bfhi(t.x); v0[2] = v0[2] * g[2] + bflo(t.y); v0[3] = v0[3] * g[3] + bfhi(t.y);
        v1[0] = v1[0] * g[4] + bflo(t.z); v1[1] = v1[1] * g[5] + bfhi(t.z); v1[2] = v1[2] * g[6] + bflo(t.w); v1[3] = v1[3] * g[7] + bfhi(t.w);
        store8(MG + (size_t)row * 1024 + pn * 256 + lc, v0, v1);
    } };
struct OpFF1 { bf16_t* H; typedef NoPre Pre;
    __device__ __forceinline__ Pre load(int, int, int) const { return Pre{}; }
    __device__ __forceinline__ void apply(int pn, int row, int lc, f32x4 v0, f32x4 v1, const Pre&) const {
#pragma unroll
        for (int i = 0; i < 4; ++i) { const float a = fmaxf(v0[i], 0.f), b = fmaxf(v1[i], 0.f); v0[i] = a * a; v1[i] = b * b; }
        store8(H + (size_t)row * 4096 + pn * 256 + lc, v0, v1);
    } };
struct EpiNull { static constexpr bool PERM = true, AFTER_DRAIN = false;
    __device__ __forceinline__ void operator()(const f32x4 (&acc)[2][2][4][2], const Unit& u, int wr, int wc, int fr, int fq) const {
#pragma unroll
        for (int ai = 0; ai < 2; ++ai)
#pragma unroll
            for (int bj = 0; bj < 2; ++bj)
#pragma unroll
                for (int m = 0; m < 4; ++m)
#pragma unroll
                    for (int n = 0; n < 2; ++n) asm volatile("" :: "v"(acc[ai][bj][m][n]));
    } };
template <class Epi> __device__ __forceinline__ void run_gemm(LAS unsigned char* lds, const bf16_t* A, int lda, const bf16_t* Bt, int M, int N, int K, const Epi& E, int G, int c) {
    Gemm g{A, Bt, M, N, K, lda}; StaticOrder S; S.init(M, N, G, c);
    gemm_phase<Epi, StaticOrder, true, true>(lds, g, S, E);
}

template <class F> __device__ __forceinline__ void conv_tile(F f, bf16_t* WT, int K, int n0, int k0, LAS float* scr, int lane) {
    float tv[32];
#pragma unroll
    for (int i = 0; i < 32; ++i) tv[i] = f(k0 + 2 * i + (lane >> 5), n0 + (lane & 31));
#pragma unroll
    for (int i = 0; i < 32; ++i) scr[(2 * i + (lane >> 5)) * 33 + (lane & 31)] = tv[i];
    LDS_WAIT(); asm volatile("" ::: "memory");
    const int c = lane & 7;
#pragma unroll
    for (int j = 0; j < 4; ++j) { const int n = (lane >> 3) + 8 * j; const LAS float* s = scr + (8 * c) * 33 + n;
        u32x4 o; o.x = cvt_pk_bf16(s[0 * 33], s[1 * 33]); o.y = cvt_pk_bf16(s[2 * 33], s[3 * 33]); o.z = cvt_pk_bf16(s[4 * 33], s[5 * 33]); o.w = cvt_pk_bf16(s[6 * 33], s[7 * 33]);
        *(u32x4*)(WT + (size_t)(n0 + n) * K + k0 + 8 * c) = o; }
    LDS_WAIT(); asm volatile("" ::: "memory");
}
struct FPlain { const float* W; int N; __device__ __forceinline__ float operator()(int k, int n) const { return W[(size_t)k * N + n]; } };
struct FWin { const float* W; const float* gk; __device__ __forceinline__ float operator()(int k, int p) const {
    int src;
    if (p < 1792) src = p;
    else if (p < 2048) { const int lc = p - 1792, bj = lc >> 7, wc = (lc >> 5) & 3, r = lc & 31;
        src = ((wc >> 1) ? 2048 : 1792) + (wc & 1) * 64 + bj * 32 + r; }
    else if (p < 2304) { const int lc = p - 2048; src = (lc < 128) ? 1920 + lc : 2176 + (lc - 128); }
    else if (p < 2352) src = p; else if (p < 2560) src = -1; else src = p - 208; return src < 0 ? 0.f : W[(size_t)k * NIN + src] * gk[k]; } };
struct FPlainG { const float* W; int N; const float* gk; __device__ __forceinline__ float operator()(int k, int n) const { return W[(size_t)k * N + n] * gk[k]; } };
struct FPool { const float* W; const float* sc; __device__ __forceinline__ float operator()(int j, int k) const {
    return ((k >> 7) == (j >> 7)) ? W[(k >> 7) * 16384 + (k & 127) * 128 + (j & 127)] * sc[j] : 0.f; } };

__device__ __forceinline__ void rms_row_out(const bf16_t* xrow, const float* g, float* orow, int lane) {
    const u32x2* xr = (const u32x2*)xrow + lane; const f32x4* gr = (const f32x4*)g + lane;
    f32x4 v[4]; float s = 0.f;
#pragma unroll
    for (int j = 0; j < 4; ++j) { const u32x2 w = xr[64 * j]; v[j] = (f32x4){bflo(w.x), bfhi(w.x), bflo(w.y), bfhi(w.y)}; s += (v[j].x * v[j].x + v[j].y * v[j].y) + (v[j].z * v[j].z + v[j].w * v[j].w); }
    const float r = 1.0f / sqrtf(wave_sum(s) * (1.0f / 1024.0f) + 1e-6f);
    f32x4* o = (f32x4*)orow + lane;
#pragma unroll
    for (int j = 0; j < 4; ++j) { const f32x4 gg = gr[64 * j]; o[64 * j] = (v[j] * r) * gg; }
}
struct Ctx { LAS unsigned char* lds; unsigned char* ws; int tid, lane, wave, G, bx, gw, NGW; };

__device__ __forceinline__ void ph_prologue(const Args& a, const Ctx& C) {
    unsigned char* ws = C.ws;
    { float* rc = (float*)(ws + WS_ROPEC); float* rs = (float*)(ws + WS_ROPES);
      for (int idx = C.bx * 512 + C.tid; idx < SEQ * 32; idx += C.G * 512) {
        const int t = idx >> 5, i = idx & 31; const double ang = (double)t * a.invf[i];
        const double k = rint(ang * 0.15915494309189535); double r = fma(-k, 6.283185307179586, ang); r = fma(-k, 2.4492935982947064e-16, r);
        const double r2 = r * r; double s = 1.0, c = 1.0;
#pragma unroll
        for (int n = 15; n >= 1; --n) { s = 1.0 - r2 * (1.0 / (double)((2 * n) * (2 * n + 1))) * s; c = 1.0 - r2 * (1.0 / (double)((2 * n - 1) * (2 * n))) * c; }
        rc[idx] = (float)c; rs[idx] = (float)(r * s);
      } }
    LAS float* scr = (LAS float*)(C.lds + C.wave * 8448);
    constexpr int I_IN = 16 * 144, I_POOL = 8 * 16, I_CK = 32 * 8, I_PP = 8 * 32, I_PN = 16 * 32, I_OUT = 16 * 32, I_FF1 = 16 * 128, I_FF2 = 64 * 32, I_C2 = 4 * 2;
    constexpr int NITEMS = I_IN + I_POOL + 2 * I_CK + I_PP + I_PN + I_OUT + I_FF1 + I_FF2 + 2 * I_C2;
    for (int it = C.gw; it < DEPTH * NITEMS; it += C.NGW) {
        const int l = it / NITEMS; int r = it - l * NITEMS; unsigned char* wl = ws + WS_W + (size_t)l * WL_STRIDE;
        if (r < I_IN) { conv_tile(FWin{AIN(a, 2) + (size_t)l * DM * NIN, AIN(a, 1) + (size_t)l * 1024}, (bf16_t*)(wl + W_IN), 1024, (r % 144) * 32, (r / 144) * 64, scr, C.lane); continue; } r -= I_IN;
        if (r < I_POOL) { conv_tile(FPool{AIN(a, 3) + (size_t)l * 65536, AIN(a, 4) + (size_t)l * 512}, (bf16_t*)(wl + W_POOL), 512, (r % 16) * 32, (r / 16) * 64, scr, C.lane); continue; } r -= I_POOL;
        if (r < I_CK) { conv_tile(FPlain{AIN(a, 7) + (size_t)l * 2048 * 256, 256}, (bf16_t*)(wl + W_CK1), 2048, (r % 8) * 32, (r / 8) * 64, scr, C.lane); continue; } r -= I_CK;
        if (r < I_CK) { conv_tile(FPlain{AIN(a, 9) + (size_t)l * 2048 * 256, 256}, (bf16_t*)(wl + W_CV1), 2048, (r % 8) * 32, (r / 8) * 64, scr, C.lane); continue; } r -= I_CK;
        if (r < I_PP) { conv_tile(FPlain{AIN(a, 11) + (size_t)l * 512 * 1024, 1024}, (bf16_t*)(wl + W_PP), 512, (r % 32) * 32, (r / 32) * 64, scr, C.lane); continue; } r -= I_PP;
        if (r < I_PN) { conv_tile(FPlain{AIN(a, 12) + (size_t)l * 1024 * 1024, 1024}, (bf16_t*)(wl + W_PN), 1024, (r % 32) * 32, (r / 32) * 64, scr, C.lane); continue; } r -= I_PN;
        if (r < I_OUT) { conv_tile(FPlain{AIN(a, 13) + (size_t)l * 1024 * 1024, 1024}, (bf16_t*)(wl + W_OUT), 1024, (r % 32) * 32, (r / 32) * 64, scr, C.lane); continue; } r -= I_OUT;
        if (r < I_FF1) { conv_tile(FPlainG{AIN(a, 15) + (size_t)l * 1024 * 4096, 4096, AIN(a, 14) + (size_t)l * 1024}, (bf16_t*)(wl + W_FF1), 1024, (r % 128) * 32, (r / 128) * 64, scr, C.lane); continue; } r -= I_FF1;
        if (r < I_FF2) { conv_tile(FPlain{AIN(a, 16) + (size_t)l * 4096 * 1024, 1024}, (bf16_t*)(wl + W_FF2), 4096, (r % 32) * 32, (r / 32) * 64, scr, C.lane); continue; } r -= I_FF2;
        if (r < I_C2) { conv_tile(FPlain{AIN(a, 8) + (size_t)l * 256 * 64, 64}, (bf16_t*)(wl + W_CK2), 256, (r % 2) * 32, (r / 2) * 64, scr, C.lane); continue; } r -= I_C2;
        conv_tile(FPlain{AIN(a, 10) + (size_t)l * 256 * 64, 64}, (bf16_t*)(wl + W_CV2), 256, (r % 2) * 32, (r / 2) * 64, scr, C.lane);
    }
    { float* cb = (float*)(ws + WS_CBIAS);
      for (int it = C.gw; it < DEPTH * 512; it += C.NGW) { const int l = it >> 9, kv = (it >> 8) & 1, n = it & 255; const float* pe = AIN(a, kv ? 6 : 5) + (size_t)l * 2048; const float* w1 = AIN(a, kv ? 9 : 7) + (size_t)l * 2048 * 256;
          float s = 0.f; for (int kk = C.lane; kk < 2048; kk += 64) s += pe[kk] * w1[(size_t)kk * 256 + n];
          s = wave_sum(s); if (C.lane == 0) cb[it] = s; } }
    { const float* x = AIN(a, 0); bf16_t* XB = (bf16_t*)(ws + WS_XN); float* SS = (float*)(ws + WS_SS); const int lane = C.lane;
      for (int m = C.gw; m < MTOK; m += C.NGW) {
        const f32x4* xr = (const f32x4*)(x + (size_t)m * 1024) + lane; u32x2* o8 = (u32x2*)(XB + (size_t)m * 1024) + lane; float sq = 0.f;
#pragma unroll
        for (int j = 0; j < 4; ++j) { const f32x4 v = xr[64 * j]; sq += (v.x * v.x + v.y * v.y) + (v.z * v.z + v.w * v.w); u32x2 w; w.x = cvt_pk_bf16(v.x, v.y); w.y = cvt_pk_bf16(v.z, v.w); o8[64 * j] = w; }
        sq = wave_sum(sq); if (lane < 16) SS[(size_t)m * 16 + lane] = (lane == 0) ? sq : 0.f;
      } }
}

__device__ __forceinline__ void vt_tile(const bf16_t* src, bf16_t* dst, int lane) {
    unsigned pk[32];
#pragma unroll
    for (int pos = 0; pos < 64; pos += 2) { const int kv0 = PIperm(pos); const unsigned lo = src[kv0 * 64 + lane], hi = src[(kv0 + 1) * 64 + lane]; pk[pos >> 1] = lo | (hi << 16); }
    u32x4* d = (u32x4*)(dst + lane * 64);
#pragma unroll
    for (int j = 0; j < 8; ++j) d[j] = (u32x4){pk[4 * j], pk[4 * j + 1], pk[4 * j + 2], pk[4 * j + 3]};
}
__device__ __forceinline__ void ph_post(const Ctx& C, bool do_rope, const int pgw, const int pngw, bf16_t* Dbuf) {
    unsigned char* ws = C.ws; const int lane = C.lane;
    const float* rc = (const float*)(ws + WS_ROPEC); const float* rs = (const float*)(ws + WS_ROPES);
    if (do_rope) for (int it = pgw; it < 2 * 16 * 4096 / 8; it += pngw) {
        const int rr = it * 8 + (lane >> 3); bf16_t* base = (bf16_t*)(ws + (rr < 65536 ? WS_KS : WS_KW)); const int r = rr & 65535, t = r & 4095, d0 = (lane & 7) * 4;
        bf16_t* p = base + (size_t)r * 64 + d0; const u32x2 a = *(const u32x2*)p, b = *(const u32x2*)(p + 32);
        const f32x4 c = *(const f32x4*)(rc + t * 32 + d0), s = *(const f32x4*)(rs + t * 32 + d0);
        const float x1[4] = {bflo(a.x), bfhi(a.x), bflo(a.y), bfhi(a.y)}, x2[4] = {bflo(b.x), bfhi(b.x), bflo(b.y), bfhi(b.y)};
        float y1[4], y2[4];
#pragma unroll
        for (int i = 0; i < 4; ++i) { y1[i] = x1[i] * c[i] - x2[i] * s[i]; y2[i] = x2[i] * c[i] + x1[i] * s[i]; }
        u32x2 oa, ob; oa.x = cvt_pk_bf16(y1[0], y1[1]); oa.y = cvt_pk_bf16(y1[2], y1[3]); ob.x = cvt_pk_bf16(y2[0], y2[1]); ob.y = cvt_pk_bf16(y2[2], y2[3]);
        *(u32x2*)p = oa; *(u32x2*)(p + 32) = ob;
    }
    { const bf16_t* U = (const bf16_t*)(ws + WS_U); bf16_t* D = Dbuf;
#define UNPK8(NAME_, VEC_) const float NAME_[8] = {bflo(VEC_[0]), bfhi(VEC_[0]), bflo(VEC_[1]), bfhi(VEC_[1]), bflo(VEC_[2]), bfhi(VEC_[2]), bflo(VEC_[3]), bfhi(VEC_[3])}
      for (int it = pgw; it < MTOK / 32; it += pngw) {
        const int tt0 = it * 32, t0 = tt0 & 4095, w = 2 << (lane >> 4); const bf16_t* up = U + (size_t)tt0 * 512 + lane * 8; bf16_t* dp = D + (size_t)tt0 * 512 + lane * 8;
        float s[8] = {0.f, 0.f, 0.f, 0.f, 0.f, 0.f, 0.f, 0.f};
#pragma unroll
        for (int i = 1; i < 16; ++i) if (i < w && t0 - i >= 0) { const u32x4 v = *(const u32x4*)(up - (ptrdiff_t)i * 512); UNPK8(x, v);
#pragma unroll
            for (int j2 = 0; j2 < 8; ++j2) s[j2] += x[j2]; }
#pragma unroll 8
        for (int k = 0; k < 32; ++k) {
            const int t = t0 + k; const u32x4 v = *(const u32x4*)(up + (size_t)k * 512); UNPK8(x, v);
            const int cnt = (t + 1 < w) ? t + 1 : w; const float inv = 1.0f / (float)cnt; f32x4 d0, d1;
#pragma unroll
            for (int j2 = 0; j2 < 8; ++j2) s[j2] += x[j2];
#pragma unroll
            for (int j2 = 0; j2 < 4; ++j2) { d0[j2] = s[j2] * inv - x[j2]; d1[j2] = s[j2 + 4] * inv - x[j2 + 4]; }
            store8(dp + (size_t)k * 512, d0, d1);
            if (t - w + 1 >= 0) { const u32x4 vo = *(const u32x4*)(up + (ptrdiff_t)(k - w + 1) * 512); UNPK8(y, vo);
#pragma unroll
                for (int j2 = 0; j2 < 8; ++j2) s[j2] -= y[j2]; }
        }
      }
#undef UNPK8
    }
}

__device__ __forceinline__ constexpr int crow_c(int r) { return (r & 3) + 8 * (r >> 2); }
#define MFMA32(a, b, c) __builtin_amdgcn_mfma_f32_32x32x16_bf16((a), (b), (c), 0, 0, 0)
__device__ __forceinline__ void ph_cmp2(const Ctx& C, int l) {
    unsigned char* ws = C.ws; const int lane = C.lane, c = lane & 31, hh = lane >> 5;
    const float* rc = (const float*)(ws + WS_ROPEC); const float* rs = (const float*)(ws + WS_ROPES);
    for (int it = C.bx + C.G * C.wave; it < 256; it += C.G * 8) {
        const int kv = it >> 7, r0 = (it & 127) * 32;
        const bf16_t* hid = (const bf16_t*)(ws + (kv ? WS_HIDV : WS_HIDK)) + (size_t)(r0 + c) * 256 + hh * 8;
        const bf16_t* w2t = (const bf16_t*)(ws + WS_W + (size_t)l * WL_STRIDE + (kv ? W_CV2 : W_CK2)) + hh * 8;
        f32x16 a0 = (f32x16){}, a1 = (f32x16){};
#pragma unroll 4
        for (int ks = 0; ks < 16; ++ks) { const bf16x8 af = *(const bf16x8*)(hid + ks * 16), b0 = *(const bf16x8*)(w2t + (size_t)c * 256 + ks * 16), b1 = *(const bf16x8*)(w2t + (size_t)(c + 32) * 256 + ks * 16);
            a0 = MFMA32(af, b0, a0); a1 = MFMA32(af, b1, a1); }
#pragma unroll
        for (int r = 0; r < 16; ++r) { const int row = r0 + crow_c(r) + 4 * hh, bg = row >> 8, n = row & 255; float v0 = a0[r], v1 = a1[r];
            if (n == 255) { v0 = 0.f; v1 = 0.f; }
            if (kv == 0) { const int pos = (n == 255) ? 0 : 16 * n + 31; const float cc = rc[pos * 32 + c], sn = rs[pos * 32 + c];
                bf16_t* o = (bf16_t*)(ws + WS_CK) + (size_t)row * 64; o[c] = f2bf(v0 * cc - v1 * sn); o[c + 32] = f2bf(v1 * cc + v0 * sn); }
            else { bf16_t* o = (bf16_t*)(ws + WS_CVT) + (size_t)bg * 16384 + (n >> 6) * 4096 + PIperm(n & 63); o[c * 64] = f2bf(v0); o[(c + 32) * 64] = f2bf(v1); } }
    }
}

constexpr int AT_KB = 0, AT_VB = 18432, AT_SLAB = 36864, AT_SELM = AT_SLAB + 65536, AT_UNION = AT_SELM + 256, KPITCH = 144;
constexpr float SM_C = 0.125f * 1.4426950408889634f;
__device__ __forceinline__ void qk_tile(LAS const unsigned char* kb, const bf16x8 (&qf)[4], f32x16& p0, f32x16& p1, int lane) {
    LAS const unsigned char* ka = kb + (lane & 31) * KPITCH + (lane >> 5) * 16;
    p0 = (f32x16){}; p1 = (f32x16){};
#pragma unroll
    for (int ks = 0; ks < 4; ++ks) { const bf16x8 a0 = *(LAS const bf16x8*)(ka + ks * 32), a1 = *(LAS const bf16x8*)(ka + 32 * KPITCH + ks * 32);
        p0 = MFMA32(a0, qf[ks], p0); p1 = MFMA32(a1, qf[ks], p1); }
    __builtin_amdgcn_sched_group_barrier(0x100, 8, 0); __builtin_amdgcn_sched_group_barrier(0x008, 8, 0);
}
typedef float f32x2v __attribute__((ext_vector_type(2)));
__device__ __forceinline__ float fmax3(float a, float b, float c) { return fmaxf(fmaxf(a, b), c); }
__device__ __forceinline__ void attn_tile(LAS const unsigned char* kb, LAS const unsigned char* vb, const bf16x8 (&qf)[4], float& m, float& l, f32x16& o0, f32x16& o1, int lo, int hi_, int lane) {
    const int hh = lane >> 5; f32x16 p0, p1;
    qk_tile(kb, qf, p0, p1, lane);
    const bool lane_full = (lo <= 0) && (hi_ >= 63), lane_empty = lo > hi_;
    const bool simple = __all((lane_full || lane_empty) ? 1 : 0) != 0;
    if (!simple) { const int lo2 = lo - 4 * hh, hi2 = hi_ - 4 * hh;
#pragma unroll
        for (int r = 0; r < 16; ++r) { const int c0 = crow_c(r), c1 = c0 + 32; p0[r] = (c0 >= lo2 && c0 <= hi2) ? p0[r] : -INFINITY; p1[r] = (c1 >= lo2 && c1 <= hi2) ? p1[r] : -INFINITY; } }
    float mxa = fmax3(p0[0], p0[1], p1[0]), mxb = fmax3(p0[2], p0[3], p1[1]); mxa = fmax3(mxa, p1[2], p1[3]);
#pragma unroll
    for (int r = 4; r < 16; r += 4) { mxa = fmax3(mxa, p0[r], p0[r + 1]); mxb = fmax3(mxb, p0[r + 2], p0[r + 3]); mxa = fmax3(mxa, p1[r], p1[r + 1]); mxb = fmax3(mxb, p1[r + 2], p1[r + 3]); }
    float mx = fmaxf(mxa, mxb);
    const bool dead = simple && lane_empty;
    if (dead) mx = -INFINITY;
    mx = fmaxf(mx, __shfl_xor(mx, 32));
    const float mx2 = mx * SM_C;
    if (__any((mx2 > m + 8.0f) ? 1 : 0)) {
        const float mn = fmaxf(m, mx2), alpha = __builtin_amdgcn_exp2f(m - mn);
        l *= alpha; m = mn;
#pragma unroll
        for (int r = 0; r < 16; ++r) { o0[r] *= alpha; o1[r] *= alpha; }
    }
    const float neg = dead ? -INFINITY : -m;
    float sa = 0.f, sb = 0.f;
#pragma unroll
    for (int r = 0; r < 16; r += 2) {
        p0[r] = __builtin_amdgcn_exp2f(__builtin_fmaf(p0[r], SM_C, neg)); p0[r + 1] = __builtin_amdgcn_exp2f(__builtin_fmaf(p0[r + 1], SM_C, neg));
        p1[r] = __builtin_amdgcn_exp2f(__builtin_fmaf(p1[r], SM_C, neg)); p1[r + 1] = __builtin_amdgcn_exp2f(__builtin_fmaf(p1[r + 1], SM_C, neg));
        sa += p0[r] + p0[r + 1]; sb += p1[r] + p1[r + 1];
    }
    l += sa + sb;
    bf16x8 pf[4];
#pragma unroll
    for (int s = 0; s < 2; ++s) {
        u32x4 w0, w1;
        w0.x = cvt_pk_bf16(p0[8 * s + 0], p0[8 * s + 1]); w0.y = cvt_pk_bf16(p0[8 * s + 2], p0[8 * s + 3]); w0.z = cvt_pk_bf16(p0[8 * s + 4], p0[8 * s + 5]); w0.w = cvt_pk_bf16(p0[8 * s + 6], p0[8 * s + 7]);
        w1.x = cvt_pk_bf16(p1[8 * s + 0], p1[8 * s + 1]); w1.y = cvt_pk_bf16(p1[8 * s + 2], p1[8 * s + 3]); w1.z = cvt_pk_bf16(p1[8 * s + 4], p1[8 * s + 5]); w1.w = cvt_pk_bf16(p1[8 * s + 6], p1[8 * s + 7]);
        pf[s] = __builtin_bit_cast(bf16x8, w0); pf[2 + s] = __builtin_bit_cast(bf16x8, w1);
    }
    LAS const unsigned char* va = vb + (lane & 31) * KPITCH + hh * 16;
#pragma unroll
    for (int ts = 0; ts < 4; ++ts) {
        const bf16x8 v0 = *(LAS const bf16x8*)(va + ts * 32), v1 = *(LAS const bf16x8*)(va + 32 * KPITCH + ts * 32);
        o0 = MFMA32(v0, pf[ts], o0); o1 = MFMA32(v1, pf[ts], o1);
    }
    __builtin_amdgcn_sched_group_barrier(0x100, 8, 1); __builtin_amdgcn_sched_group_barrier(0x008, 8, 1);
}
template <int MODE>
__device__ __forceinline__ void run_branch(LAS unsigned char* lds, const unsigned char* Kg, const unsigned char* Vg, unsigned long long tiles, const bf16x8 (&qf)[4],
                                           float& m, float& l, f32x16& o0, f32x16& o1, int cur, int tq, int nvalid, unsigned long long selm, int tid, int lane) {
    const int soff = (tid >> 3) * KPITCH + (tid & 7) * 16;
    unsigned long long rem = tiles;
    int T = __ffsll(rem) - 1; rem &= rem - 1;
    u32x4 kr = *(const u32x4*)(Kg + (size_t)T * 8192 + tid * 16), vr = *(const u32x4*)(Vg + (size_t)T * 8192 + tid * 16);
    *(LAS u32x4*)(lds + AT_KB + soff) = kr; *(LAS u32x4*)(lds + AT_VB + soff) = vr;
    __syncthreads();
    int bi = 0;
    for (;;) {
        const bool more = rem != 0ull;
        const int Tn = more ? (__ffsll(rem) - 1) : T; rem &= rem - 1;
        kr = *(const u32x4*)(Kg + (size_t)Tn * 8192 + tid * 16); vr = *(const u32x4*)(Vg + (size_t)Tn * 8192 + tid * 16);
        int lo, hi_;
        if (MODE == 0) { lo = 0; hi_ = nvalid - 64 * T - 1; }
        else if (MODE == 1) { const bool sb = ((selm >> T) & 1ull) != 0; lo = sb ? 0 : 1; hi_ = sb ? (T < cur ? 63 : tq) : 0; }
        else { lo = (T == cur - 8) ? tq + 1 : 0; hi_ = (T == cur) ? tq : 63; }
        attn_tile(lds + AT_KB + bi * 9216, lds + AT_VB + bi * 9216, qf, m, l, o0, o1, lo, hi_, lane);
        *(LAS u32x4*)(lds + AT_KB + (bi ^ 1) * 9216 + soff) = kr; *(LAS u32x4*)(lds + AT_VB + (bi ^ 1) * 9216 + soff) = vr;
        __syncthreads();
        if (!more) break;
        T = Tn; bi ^= 1;
    }
}
__device__ __forceinline__ void ph_attn(const Ctx& C, size_t yoff) {
    unsigned char* ws = C.ws; LAS unsigned char* lds = C.lds; const int tid = C.tid, lane = C.lane, w = C.wave, q = lane & 31, hh = lane >> 5;
    bf16_t* Q = (bf16_t*)(ws + WS_Q); const bf16_t* GN = (const bf16_t*)(ws + WS_GNSA);
    LAS float* slab = (LAS float*)(lds + AT_SLAB); LAS unsigned long long* selmp = (LAS unsigned long long*)(lds + AT_SELM); LAS unsigned* unionp = (LAS unsigned*)(lds + AT_UNION);
    const int vcu = (C.G % 8 == 0) ? (C.bx % 8) * (C.G / 8) + C.bx / 8 : C.bx;
    for (int it = vcu; it < 2048; it += C.G) {
        int bg, qb;
        if (C.G == 256) { const int i = it >> 8, v = it & 255, s = v & 15; bg = v >> 4; qb = 32 * (i >> 1) + ((i & 1) ? 31 - s : s); }
        else { bg = it & 15; qb = it >> 4; }
        const int b = bg >> 1, g = bg & 1, h = g * 8 + w, t0 = qb * 32, cur = t0 >> 6, t = t0 + q, tq = t & 63;
        const size_t tokrow = (size_t)b * 4096 + t;
        bf16_t* qp = Q + tokrow * 1024 + h * 64;
        bf16x8 qf[4];
#pragma unroll
        for (int ks = 0; ks < 4; ++ks) qf[ks] = *(const bf16x8*)(qp + ks * 16 + hh * 8);
        { const float* rcp = (const float*)(ws + WS_ROPEC) + t * 32 + hh * 8; const float* rsp = (const float*)(ws + WS_ROPES) + t * 32 + hh * 8;
#pragma unroll
          for (int ks = 0; ks < 2; ++ks) { const f32x4 c0 = *(const f32x4*)(rcp + ks * 16), c1 = *(const f32x4*)(rcp + ks * 16 + 4), s0 = *(const f32x4*)(rsp + ks * 16), s1 = *(const f32x4*)(rsp + ks * 16 + 4);
              const u32x4 xa = __builtin_bit_cast(u32x4, qf[ks]), xb = __builtin_bit_cast(u32x4, qf[ks + 2]);
              const float x1[8] = {bflo(xa.x), bfhi(xa.x), bflo(xa.y), bfhi(xa.y), bflo(xa.z), bfhi(xa.z), bflo(xa.w), bfhi(xa.w)}, x2[8] = {bflo(xb.x), bfhi(xb.x), bflo(xb.y), bfhi(xb.y), bflo(xb.z), bfhi(xb.z), bflo(xb.w), bfhi(xb.w)};
              const float cc[8] = {c0[0], c0[1], c0[2], c0[3], c1[0], c1[1], c1[2], c1[3]}, sn[8] = {s0[0], s0[1], s0[2], s0[3], s1[0], s1[1], s1[2], s1[3]};
              float y1[8], y2[8];
#pragma unroll
              for (int i = 0; i < 8; ++i) { y1[i] = x1[i] * cc[i] - x2[i] * sn[i]; y2[i] = x2[i] * cc[i] + x1[i] * sn[i]; }
              u32x4 oa, ob; oa.x = cvt_pk_bf16(y1[0], y1[1]); oa.y = cvt_pk_bf16(y1[2], y1[3]); oa.z = cvt_pk_bf16(y1[4], y1[5]); oa.w = cvt_pk_bf16(y1[6], y1[7]);
              ob.x = cvt_pk_bf16(y2[0], y2[1]); ob.y = cvt_pk_bf16(y2[2], y2[3]); ob.z = cvt_pk_bf16(y2[4], y2[5]); ob.w = cvt_pk_bf16(y2[6], y2[7]);
              qf[ks] = __builtin_bit_cast(bf16x8, oa); qf[ks + 2] = __builtin_bit_cast(bf16x8, ob); } }
        const float gc = bf2f(GN[tokrow * 64 + h * 3 + 0]), gs = bf2f(GN[tokrow * 64 + h * 3 + 1]), gwn = bf2f(GN[tokrow * 64 + h * 3 + 2]);
        if (tid == 0) { unionp[0] = 0u; unionp[1] = 0u; }
        const int nvalid = (t >= 31) ? ((t - 15) >> 4) : 0; const int nvmax = (t0 + 16) >> 4; const int ntile = (nvmax + 63) >> 6;
        const unsigned char* CKg = ws + WS_CK + (size_t)bg * 32768; const unsigned char* CVg = ws + WS_CVT + (size_t)bg * 32768;
        float m = -1e30f, l = 0.f; f32x16 o0 = (f32x16){}, o1 = (f32x16){};
        run_branch<0>(lds, CKg, CVg, (1ull << ntile) - 1ull, qf, m, l, o0, o1, cur, tq, nvalid, 0ull, tid, lane);
        l += __shfl_xor(l, 32);
        const float invl = (l > 0.f) ? 1.0f / l : 0.f;
        f32x16 out0 = o0 * (gc * invl), out1 = o1 * (gc * invl);
        { const int soff = (tid >> 3) * KPITCH + (tid & 7) * 16; float carry = 0.f;
          u32x4 kpre = *(const u32x4*)(CKg + tid * 16);
          for (int T = 0; T < ntile; ++T) {
            *(LAS u32x4*)(lds + AT_KB + (T & 1) * 9216 + soff) = kpre;
            kpre = *(const u32x4*)(CKg + (size_t)((T + 1 < ntile) ? T + 1 : T) * 8192 + tid * 16);
            __syncthreads();
            f32x16 p0, p1; qk_tile(lds + AT_KB + (T & 1) * 9216, qf, p0, p1, lane);
            const int nrel = nvalid - 64 * T - 4 * hh;
#pragma unroll
            for (int r = 0; r < 16; ++r) { const int c0 = crow_c(r);
                p0[r] = (c0 < nrel) ? __builtin_amdgcn_exp2f(p0[r] * SM_C - m) * invl : 0.f; p1[r] = (c0 + 32 < nrel) ? __builtin_amdgcn_exp2f(p1[r] * SM_C - m) * invl : 0.f; }
            float g4[8], last[8], oth[8];
#pragma unroll
            for (int i = 0; i < 8; ++i) { const int r0 = 4 * (i & 3); if (i < 4) { g4[i] = (p0[r0] + p0[r0 + 1]) + (p0[r0 + 2] + p0[r0 + 3]); last[i] = p0[r0 + 3]; } else { g4[i] = (p1[r0] + p1[r0 + 1]) + (p1[r0 + 2] + p1[r0 + 3]); last[i] = p1[r0 + 3]; } }
#pragma unroll
            for (int i = 0; i < 8; ++i) oth[i] = __shfl_xor(last[i], 32);
#pragma unroll
            for (int i = 0; i < 8; ++i) { const float add = hh ? oth[i] : (i ? oth[i > 0 ? i - 1 : 0] : carry); slab[(w * 32 + q) * 64 + 16 * T + 2 * i + hh] = g4[i] + add; }
            carry = oth[7];
          }
          __syncthreads(); }
        {
            const int J = lane; const bool cand = (J >= 1) && (J <= cur - 2); const bool forced = (J <= cur) && (J == 0 || J >= cur - 1);
            const unsigned long long candm = __ballot(cand ? 1 : 0), forcedm = __ballot(forced ? 1 : 0);
            unsigned vb[4]; unsigned long long selq[4];
#pragma unroll
            for (int qq = 0; qq < 4; ++qq) { const int qi = 4 * w + qq; float v = 0.f;
#pragma unroll
                for (int w2 = 0; w2 < 8; ++w2) v += slab[(w2 * 32 + qi) * 64 + J];
                vb[qq] = cand ? __float_as_uint(v) : 0u; selq[qq] = candm; }
            if (cur - 2 > 13) {
                unsigned th[4] = {0u, 0u, 0u, 0u};
#pragma unroll 1
                for (int bit = 30; bit >= 0; --bit) {
#pragma unroll
                    for (int qq = 0; qq < 4; ++qq) { const unsigned trial = th[qq] | (1u << bit); const unsigned long long mm = __ballot((vb[qq] >= trial) ? 1 : 0) & candm; th[qq] = (__popcll(mm) >= 13) ? trial : th[qq]; }
                }
                const unsigned long long below = (lane == 0) ? 0ull : (~0ull >> (64 - lane));
#pragma unroll
                for (int qq = 0; qq < 4; ++qq) { const unsigned long long mgt = __ballot((vb[qq] > th[qq]) ? 1 : 0) & candm, meq = __ballot((vb[qq] == th[qq]) ? 1 : 0) & candm;
                    const int need = 13 - __popcll(mgt), rank = __popcll(meq & below);
                    selq[qq] = __ballot((cand && (vb[qq] > th[qq] || (vb[qq] == th[qq] && rank < need))) ? 1 : 0); }
            }
#pragma unroll
            for (int qq = 0; qq < 4; ++qq) { const unsigned long long mk = selq[qq] | forcedm;
                if (lane == 0) { selmp[4 * w + qq] = mk; atomicOr((unsigned*)&unionp[0], (unsigned)mk); atomicOr((unsigned*)&unionp[1], (unsigned)(mk >> 32)); } }
        }
        __syncthreads();
        const unsigned long long selm = selmp[q];
        const unsigned ulo = __builtin_amdgcn_readfirstlane(unionp[0]), uhi = __builtin_amdgcn_readfirstlane(unionp[1]);
        const unsigned long long uni = ((unsigned long long)uhi << 32) | ulo;
        m = -1e30f; l = 0.f; o0 = (f32x16){}; o1 = (f32x16){};
        run_branch<1>(lds, ws + WS_KS + (size_t)bg * 524288, ws + WS_VST + (size_t)bg * 524288, uni, qf, m, l, o0, o1, cur, tq, 0, selm, tid, lane);
        { l += __shfl_xor(l, 32); const float f = gs / l; out0 += o0 * f; out1 += o1 * f; }
        m = -1e30f; l = 0.f; o0 = (f32x16){}; o1 = (f32x16){};
        { const int j0 = cur - 8 > 0 ? cur - 8 : 0; const unsigned long long wm = ((cur == 63) ? ~0ull : ((1ull << (cur + 1)) - 1ull)) & ~((1ull << j0) - 1ull);
          run_branch<2>(lds, ws + WS_KW + (size_t)bg * 524288, ws + WS_VWT + (size_t)bg * 524288, wm, qf, m, l, o0, o1, cur, tq, 0, 0ull, tid, lane); }
        { l += __shfl_xor(l, 32); const float f = gwn / l; out0 += o0 * f; out1 += o1 * f; }
#pragma unroll
        for (int i = 0; i < 4; ++i) {
            u32x2 a0, a1; a0.x = cvt_pk_bf16(out0[4 * i], out0[4 * i + 1]); a0.y = cvt_pk_bf16(out0[4 * i + 2], out0[4 * i + 3]); a1.x = cvt_pk_bf16(out1[4 * i], out1[4 * i + 1]); a1.y = cvt_pk_bf16(out1[4 * i + 2], out1[4 * i + 3]);
            bf16_t* yp = (bf16_t*)((unsigned char*)qp + yoff); *(u32x2*)(yp + 8 * i + 4 * hh) = a0; *(u32x2*)(yp + 32 + 8 * i + 4 * hh) = a1;
        }
    }
}

constexpr int NPHASE = 8 * DEPTH + 3;
#ifndef ONLY_MASK
#define ONLY_MASK 0xffff
#endif
#define HAS(k) ((ONLY_MASK >> (k)) & 1)
__global__ void __launch_bounds__(512, 2) mega_fwd(Args a) {
    extern __shared__ __attribute__((aligned(16))) unsigned char lds_raw[];
    Ctx C; C.lds = (LAS unsigned char*)lds_raw; C.ws = a.ws; C.tid = threadIdx.x; C.lane = C.tid & 63; C.wave = __builtin_amdgcn_readfirstlane(C.tid >> 6);
    C.G = gridDim.x; C.bx = blockIdx.x; C.gw = C.bx * 8 + C.wave; C.NGW = C.G * 8;
    cg::grid_group grid = cg::this_grid();
    { volatile LAS unsigned* st = (volatile LAS unsigned*)(C.lds + LDS_BYTES - 64); if (C.tid < 16) st[C.tid] = 0u; __syncthreads(); }
    XcdBarrier xbar = xcd_barrier_post((unsigned*)(a.ws + WS_BAR), (volatile LAS unsigned*)(C.lds + LDS_BYTES - 64));
    unsigned char* ws = a.ws; float* X = a.out;
    int ph = 0;
#define IN_PH() (ph >= a.ph_lo && ph < a.ph_hi)
#define FRESH() do { int t_ = threadIdx.x; asm volatile("" : "+v"(t_)); C.tid = t_; C.lane = t_ & 63; C.wave = __builtin_amdgcn_readfirstlane(t_ >> 6); C.gw = C.bx * 8 + C.wave; \
    unsigned wl_ = __builtin_amdgcn_readfirstlane((unsigned)(unsigned long long)a.ws), wh_ = __builtin_amdgcn_readfirstlane((unsigned)((unsigned long long)a.ws >> 32)); asm volatile("" : "+s"(wl_), "+s"(wh_)); \
    ws = (unsigned char*)(GAS1 unsigned char*)(((unsigned long long)wh_ << 32) | wl_); C.ws = ws; \
    unsigned xl_ = __builtin_amdgcn_readfirstlane((unsigned)(unsigned long long)a.out), xh_ = __builtin_amdgcn_readfirstlane((unsigned)((unsigned long long)a.out >> 32)); asm volatile("" : "+s"(xl_), "+s"(xh_)); \
    X = (float*)(GAS1 float*)(((unsigned long long)xh_ << 32) | xl_); } while (0)
#define SEAM() do { ++ph; if (ph > a.ph_lo && ph < a.ph_hi) { if (ph == 1) grid.sync(); else xcd_barrier(xbar); } FRESH(); } while (0)
    FRESH();
    if (HAS(0) && IN_PH()) ph_prologue(a, C);
    SEAM();
    if (IN_PH() && C.bx < 8 * DEPTH) {
        const int l = C.bx >> 3; unsigned char* wl = ws + WS_W + (size_t)l * WL_STRIDE;
        EpiP<OpBf16> E{OpBf16{(bf16_t*)(ws + WS_PPF) + (size_t)l * 1024 * 512, 512}, nullptr};
        run_gemm(C.lds, (const bf16_t*)(wl + W_PP), 512, (const bf16_t*)(wl + W_POOL), 1024, 512, 512, E, 8, C.bx & 7);
    }
    SEAM();
    for (int l = 0; l < DEPTH; ++l) {
        const float* xin = (l == 0) ? AIN(a, 0) : X;
        unsigned char* wl = ws + WS_W + (size_t)l * WL_STRIDE;
        if (HAS(1) && IN_PH()) {
            EpiP<OpProj, true> E{OpProj{ws}, (const float*)(ws + WS_SS)};
            run_gemm(C.lds, (const bf16_t*)(ws + WS_XN), 1024, (const bf16_t*)(wl + W_IN), MTOK, NPAD, 1024, E, C.G, C.bx);
        }
        SEAM();
        if (IN_PH()) {
            const int ncc = (C.G >= 64) ? 32 : 0;
            if (HAS(2) && (ncc == 0 || C.bx >= ncc)) ph_post(C, false, (C.bx - ncc) * 8 + C.wave, (C.G - ncc) * 8, (bf16_t*)X);
            FRESH(); wl = ws + WS_W + (size_t)l * WL_STRIDE;
            if (HAS(4) && (ncc == 0 || C.bx < 16)) { EpiP<OpCmp1> E{OpCmp1{(bf16_t*)(ws + WS_HIDK), (const float*)(ws + WS_CBIAS) + l * 512}, nullptr}; run_gemm(C.lds, (const bf16_t*)(ws + WS_KC), 1024, (const bf16_t*)(wl + W_CK1), 4096, 256, 2048, E, ncc ? 16 : C.G, C.bx); }
            FRESH(); wl = ws + WS_W + (size_t)l * WL_STRIDE;
            if (HAS(5) && (ncc == 0 || (C.bx >= 16 && C.bx < 32))) { EpiP<OpCmp1> E{OpCmp1{(bf16_t*)(ws + WS_HIDV), (const float*)(ws + WS_CBIAS) + l * 512 + 256}, nullptr}; run_gemm(C.lds, (const bf16_t*)(ws + WS_VC), 1024, (const bf16_t*)(wl + W_CV1), 4096, 256, 2048, E, ncc ? 16 : C.G, ncc ? C.bx - 16 : C.bx); }
        }
        SEAM();
        wl = ws + WS_W + (size_t)l * WL_STRIDE;
        if (IN_PH()) {
            FRESH();
            if (HAS(6)) ph_cmp2(C, l);
        }
        SEAM();
        if (HAS(7) && IN_PH()) ph_attn(C, 0);
        SEAM();
        wl = ws + WS_W + (size_t)l * WL_STRIDE;
        if (IN_PH()) {
            if (HAS(8)) { EpiP<OpMerge1> E{OpMerge1{ws + WS_GM, (bf16_t*)(ws + WS_GM + 64 * MiB)}, nullptr}; run_gemm(C.lds, (const bf16_t*)X, 512, (const bf16_t*)(ws + WS_PPF) + (size_t)l * 1024 * 512, MTOK, 1024, 512, E, C.G, C.bx); }
            FRESH(); wl = ws + WS_W + (size_t)l * WL_STRIDE;
            if (HAS(9)) { EpiP<OpMerge2> E{OpMerge2{ws + WS_GM, (bf16_t*)(ws + WS_GM + 64 * MiB)}, nullptr}; run_gemm(C.lds, (const bf16_t*)(ws + WS_Q), 1024, (const bf16_t*)(wl + W_PN), MTOK, 1024, 1024, E, C.G, C.bx); }
        }
        SEAM();
        wl = ws + WS_W + (size_t)l * WL_STRIDE;
        if (HAS(10) && IN_PH()) { EpiResid E{(bf16_t*)(ws + WS_XN), (float*)(ws + WS_SS)}; run_gemm(C.lds, (const bf16_t*)(ws + WS_GM + 64 * MiB), 1024, (const bf16_t*)(wl + W_OUT), MTOK, 1024, 1024, E, C.G, C.bx); }
        SEAM();
        wl = ws + WS_W + (size_t)l * WL_STRIDE;
        if (HAS(11) && IN_PH()) { EpiP<OpFF1, true> E{OpFF1{(bf16_t*)(ws + WS_H)}, (const float*)(ws + WS_SS)}; run_gemm(C.lds, (const bf16_t*)(ws + WS_XN), 1024, (const bf16_t*)(wl + W_FF1), MTOK, DFF, 1024, E, C.G, C.bx); }
        SEAM();
        wl = ws + WS_W + (size_t)l * WL_STRIDE;
        if (HAS(12) && IN_PH()) { EpiResid E{(bf16_t*)(ws + WS_XN), (float*)(ws + WS_SS)}; run_gemm(C.lds, (const bf16_t*)(ws + WS_H), 4096, (const bf16_t*)(wl + W_FF2), MTOK, 1024, DFF, E, C.G, C.bx); }
        SEAM();
    }
    if (IN_PH()) { for (int m = C.gw; m < MTOK; m += C.NGW) rms_row_out((const bf16_t*)(ws + WS_XN) + (size_t)m * 1024, AIN(a, 17), X + (size_t)m * 1024, C.lane); }
#undef IN_PH
#undef SEAM
}

#ifndef MK_PER_PHASE
#define MK_PER_PHASE 0
#endif
extern "C" void kernel_launch(void* const* d_in, const int* in_sizes, int n_in, void* d_out, int out_size, void* d_ws, size_t ws_size, hipStream_t stream) {
    static int grid = 0;
    if (grid == 0) {
        if (n_in != 18 || out_size != MTOK * DM || ws_size < WS_END) { fprintf(stderr, "kernel_launch: unexpected shapes (n_in %d out %d ws %zu)\n", n_in, out_size, ws_size); grid = -1; return; }
        int dev = 0, cus = 0, per_cu = 0;
        (void)hipGetDevice(&dev); (void)hipDeviceGetAttribute(&cus, hipDeviceAttributeMultiprocessorCount, dev);
        if (hipFuncSetAttribute((const void*)mega_fwd, hipFuncAttributeMaxDynamicSharedMemorySize, LDS_BYTES) != hipSuccess) { fprintf(stderr, "kernel_launch: hipFuncSetAttribute failed\n"); grid = -1; return; }
        if (hipOccupancyMaxActiveBlocksPerMultiprocessor(&per_cu, (const void*)mega_fwd, 512, LDS_BYTES) != hipSuccess || per_cu < 1) { fprintf(stderr, "kernel_launch: occupancy query %d\n", per_cu); per_cu = 1; }
        (void)hipGetLastError();
        grid = cus * (per_cu > 1 ? 1 : per_cu);
        if (grid <= 0) grid = 256;
    }
    if (grid < 0) return;
    Args a{};
    for (int i = 0; i < 18; ++i) a.in[i] = (const float*)d_in[i];
    a.out = (float*)d_out; a.ws = (unsigned char*)d_ws;
    for (int i = 0; i < 32; ++i) a.invf[i] = pow(10000.0, -(double)(2 * i) / 64.0);
#if MK_PER_PHASE
    for (int p = 0; p < NPHASE; ++p) { a.ph_lo = p; a.ph_hi = p + 1; hipLaunchKernelGGL(mega_fwd, dim3(grid), dim3(512), LDS_BYTES, stream, a); }
#else
    a.ph_lo = 0; a.ph_hi = NPHASE;
    (void)hipMemsetAsync((unsigned char*)d_ws + WS_BAR, 0, 16384, stream);
    void* args[] = {&a};
    hipError_t e = hipLaunchCooperativeKernel((const void*)mega_fwd, dim3(grid), dim3(512), args, LDS_BYTES, stream);
    if (e != hipSuccess) fprintf(stderr, "cooperative launch failed: %s (grid %d)\n", hipGetErrorString(e), grid);
#endif
}
```

```cpp
#include <hip/hip_runtime.h>
#include <hip/hip_cooperative_groups.h>
#include <cstdio>
#include <cstdint>
#include <cmath>
#include <type_traits>
namespace cg = cooperative_groups;
namespace pg8 {
#define PG8_LAS __attribute__((address_space(3)))
typedef unsigned short bf16_t;
typedef short bf16x8 __attribute__((ext_vector_type(8)));
typedef float f32x4 __attribute__((ext_vector_type(4)));
typedef unsigned u32x4 __attribute__((ext_vector_type(4)));
constexpr int BM = 256, BK = 64, HALF = 128, HTB = HALF * BK * 2  , STAGE_BYTES = 8 * HTB, NXCD = 8, WGM = 8;

__host__ __device__ __forceinline__ int lds_byte(int r, int c) { const int st = (r >> 4) * 2 + (c >> 5), rr = r & 15, cc = c & 31, ob = rr * 64 + cc * 2; return st * 1024 + (ob ^ (((ob >> 9) & 1) << 5)); }
__host__ __device__ __forceinline__ void stage_rc(int b, int& R, int& C) { const int st = b / 1024, sb = b % 1024, swz = sb ^ (((sb >> 9) & 1) << 5); R = (st >> 1) * 16 + swz / 64; C = (st & 1) * 32 + (swz % 64) / 2; }
__host__ __device__ __forceinline__ int perm32(int rho) { const int n = rho >> 4, i = rho & 15; return 8 * (i >> 2) + 4 * n + (i & 3); }

struct Unit { int pm, pn; };
struct Gemm { const bf16_t* A; const bf16_t* Bt; int M, N, K, lda; };

struct StaticOrder {
    int nM, nN, nwg, G, c;
    __host__ __device__ void init(int M, int N, int G_, int c_) { nM = M / BM; nN = N / BM; nwg = nM * nN; G = G_; c = c_; }
    __host__ __device__ bool next(int i, Unit& u) const {
        const long L = (long)i * G + c; if (L >= nwg) return false;
        int wgid = (int)L; { const int q = nwg / NXCD, r = nwg % NXCD, xcd = wgid % NXCD, off = wgid / NXCD; wgid = (xcd < r ? xcd * (q + 1) : r * (q + 1) + (xcd - r) * q) + off; }
        const int nig = WGM * nN, gid = wgid / nig, fm = gid * WGM, gsz = (nM - fm) < WGM ? (nM - fm) : WGM;
        u.pm = fm + ((wgid % nig) % gsz); u.pn = (wgid % nig) / gsz; return true;
    }
    __device__ __forceinline__ void a_ready(const Unit&) const {}
    __device__ __forceinline__ void done(const Unit&) const {}
};

__device__ __forceinline__ unsigned cvt_pk_bf16(float lo, float hi) { unsigned r; asm volatile("v_cvt_pk_bf16_f32 %0, %1, %2" : "=v"(r) : "v"(lo), "v"(hi)); return r; }
typedef float f32x2 __attribute__((ext_vector_type(2)));
template <class Epi, class Sched, bool ALIGN_EPI = false, bool SP2 = false>
__device__ __forceinline__ void gemm_phase(PG8_LAS unsigned char* lds, const Gemm g, const Sched& S, const Epi& E) {
    int tid_ = threadIdx.x; asm volatile("" : "+v"(tid_));
    const int tid = tid_, wid = __builtin_amdgcn_readfirstlane(tid >> 6), lane = tid & 63, wr = wid >> 2, wc = wid & 3, fr = lane & 15, fq = lane >> 4;
    const int K = g.K, nt = K / BK;
    unsigned voffA[2], voffB[2];
#pragma unroll
    for (int i = 0; i < 2; ++i) { int R, C; stage_rc(tid * 16 + i * 8192, R, C); const int Rb = Epi::PERM ? ((R & ~31) + perm32(R & 31)) : R;
        voffA[i] = (unsigned)(R * g.lda + C) * 2u; voffB[i] = (unsigned)(Rb * K + C) * 2u; }
    const size_t kstep = (size_t)(BK * 2);
    const size_t hstepB = (size_t)HALF * K * 2, hstepA = (size_t)HALF * g.lda * 2;
    const size_t tstepA = 2 * hstepA, tstepB = 2 * hstepB;
    const unsigned ldsw = (unsigned)wid * 1024u;
    const int aoff = lds_byte(wr * 64 + fr, fq * 8), boff = lds_byte(wc * 32 + fr, fq * 8);
#define PG8_SA(b, h) (((b) * 2 + (h)) * HTB)
#define PG8_SB(b, h) ((4 + (b) * 2 + (h)) * HTB)
#define PG8_STAGE(bufoff, gbase, voff) do { _Pragma("unroll") for (int _i = 0; _i < 2; ++_i) \
        __builtin_amdgcn_global_load_lds((const unsigned*)((const char*)(gbase) + (voff)[_i]), (PG8_LAS unsigned*)(lds + (bufoff) + ldsw + _i * 8192), 16, 0, 0); } while (0)
#define PG8_LDA(dst, b, h) do { _Pragma("unroll") for (int m = 0; m < 4; ++m) _Pragma("unroll") for (int k = 0; k < 2; ++k) dst[m][k] = *(const PG8_LAS bf16x8*)(lds + PG8_SA(b, h) + aoff + m * 2048 + k * 1024); } while (0)
#define PG8_LDB(dst, b, h) do { _Pragma("unroll") for (int n = 0; n < 2; ++n) _Pragma("unroll") for (int k = 0; k < 2; ++k) dst[n][k] = *(const PG8_LAS bf16x8*)(lds + PG8_SB(b, h) + boff + n * 2048 + k * 1024); } while (0)
#define PG8_MMA(ai, bj, At, Bt) do { __builtin_amdgcn_s_setprio(1); _Pragma("unroll") for (int m = 0; m < 4; ++m) _Pragma("unroll") for (int n = 0; n < 2; ++n) _Pragma("unroll") for (int k = 0; k < 2; ++k) \
        acc[ai][bj][m][n] = __builtin_amdgcn_mfma_f32_16x16x32_bf16(Bt[n][k], At[m][k], acc[ai][bj][m][n], 0, 0, 0); __builtin_amdgcn_s_setprio(0); } while (0)
#define PG8_WAIT_V(n) asm volatile("s_waitcnt vmcnt(" #n ")" ::: "memory")
#define PG8_WAIT_L(n) asm volatile("s_waitcnt lgkmcnt(" #n ")" ::: "memory")
#define PG8_BAR __builtin_amdgcn_s_barrier()
#define PG8_SCHED __builtin_amdgcn_sched_barrier(0)
    Unit cur, nxt; int ui = 0;
    if (!S.next(0, cur)) return;
    f32x4 acc[2][2][4][2];
#pragma unroll
    for (int a = 0; a < 2; ++a)
#pragma unroll
        for (int b = 0; b < 2; ++b)
#pragma unroll
            for (int m = 0; m < 4; ++m)
#pragma unroll
                for (int n = 0; n < 2; ++n) acc[a][b][m][n] = (f32x4){0.f, 0.f, 0.f, 0.f};
    bf16x8 At[4][2], B0[2][2], B1[2][2];
    const char* cA = (const char*)g.A + (size_t)cur.pm * tstepA; const char* cB = (const char*)g.Bt + (size_t)cur.pn * tstepB;
    S.a_ready(cur);
    if constexpr (SP2) {
        PG8_STAGE(PG8_SB(0, 0), cB, voffB); PG8_STAGE(PG8_SB(0, 1), cB + hstepB, voffB); PG8_STAGE(PG8_SA(0, 0), cA, voffA); PG8_STAGE(PG8_SA(0, 1), cA + hstepA, voffA);
        if (wr == 1) PG8_BAR;
        PG8_WAIT_V(2); PG8_BAR;
        PG8_STAGE(PG8_SB(1, 0), cB + kstep, voffB); PG8_STAGE(PG8_SA(1, 0), cA + kstep, voffA); PG8_STAGE(PG8_SB(1, 1), cB + hstepB + kstep, voffB);
        PG8_WAIT_V(6); PG8_BAR;
    } else {
        PG8_STAGE(PG8_SB(0, 0), cB, voffB); PG8_STAGE(PG8_SA(0, 0), cA, voffA); PG8_STAGE(PG8_SB(0, 1), cB + hstepB, voffB); PG8_STAGE(PG8_SA(0, 1), cA + hstepA, voffA);
        if (wr == 1) PG8_BAR;
        PG8_WAIT_V(4); PG8_BAR;
        PG8_STAGE(PG8_SB(1, 0), cB + kstep, voffB); PG8_STAGE(PG8_SA(1, 0), cA + kstep, voffA); PG8_STAGE(PG8_SB(1, 1), cB + hstepB + kstep, voffB);
        PG8_WAIT_V(6); PG8_BAR;
    }
    for (;;) {
        const bool has_next = S.next(ui + 1, nxt);
        const char* nA = has_next ? (const char*)g.A + (size_t)nxt.pm * tstepA : cA; const char* nB = has_next ? (const char*)g.Bt + (size_t)nxt.pn * tstepB : cB;
        for (int t = 0; t < nt; t += 2) {
            const bool last = (t == nt - 2);
            const char* a1 = cA + (size_t)(t + 1) * kstep;
            const char* a2 = last ? nA : cA + (size_t)(t + 2) * kstep; const char* b2 = last ? nB : cB + (size_t)(t + 2) * kstep;
            const char* a3 = a2 + kstep; const char* b3 = b2 + kstep;
            if (last && has_next) S.a_ready(nxt);
            if constexpr (SP2) {
            PG8_LDB(B0, 0, 0); PG8_LDB(B1, 0, 1); PG8_SCHED; PG8_LDA(At, 0, 0); PG8_STAGE(PG8_SA(1, 1), a1 + hstepA, voffA);
            PG8_WAIT_V(8); PG8_WAIT_L(0); PG8_BAR; PG8_MMA(0, 0, At, B0); PG8_MMA(0, 1, At, B1); PG8_BAR; PG8_SCHED;
            PG8_LDA(At, 0, 1); PG8_STAGE(PG8_SB(0, 0), b2, voffB); PG8_STAGE(PG8_SB(0, 1), b2 + hstepB, voffB); PG8_STAGE(PG8_SA(0, 0), a2, voffA);
            PG8_WAIT_V(8); PG8_WAIT_L(0); PG8_BAR; PG8_MMA(1, 0, At, B0); PG8_MMA(1, 1, At, B1); PG8_BAR; PG8_SCHED;
            PG8_LDB(B0, 1, 0); PG8_LDB(B1, 1, 1); PG8_SCHED; PG8_LDA(At, 1, 0); PG8_STAGE(PG8_SA(0, 1), a2 + hstepA, voffA);
            PG8_WAIT_V(8); PG8_WAIT_L(0); PG8_BAR; PG8_MMA(0, 0, At, B0); PG8_MMA(0, 1, At, B1); PG8_BAR; PG8_SCHED;
            PG8_LDA(At, 1, 1); PG8_STAGE(PG8_SB(1, 0), b3, voffB); PG8_STAGE(PG8_SB(1, 1), b3 + hstepB, voffB); PG8_STAGE(PG8_SA(1, 0), a3, voffA);
            PG8_WAIT_V(8); PG8_WAIT_L(0); PG8_BAR; PG8_MMA(1, 0, At, B0); PG8_MMA(1, 1, At, B1); PG8_BAR; PG8_SCHED;
            } else {
            PG8_LDB(B0, 0, 0); PG8_SCHED; PG8_LDA(At, 0, 0); PG8_STAGE(PG8_SA(1, 1), a1 + hstepA, voffA);
            PG8_WAIT_L(8); PG8_BAR; PG8_WAIT_L(0); PG8_MMA(0, 0, At, B0); PG8_BAR; PG8_SCHED;
            PG8_LDB(B1, 0, 1); PG8_STAGE(PG8_SB(0, 0), b2, voffB);
            PG8_BAR; PG8_WAIT_L(0); PG8_MMA(0, 1, At, B1); PG8_BAR;
            PG8_LDA(At, 0, 1); PG8_STAGE(PG8_SA(0, 0), a2, voffA);
            PG8_BAR; PG8_WAIT_L(0); PG8_MMA(1, 0, At, B0); PG8_BAR; PG8_SCHED;
            PG8_STAGE(PG8_SB(0, 1), b2 + hstepB, voffB);
            PG8_WAIT_V(6); PG8_BAR; PG8_MMA(1, 1, At, B1); PG8_BAR;
            PG8_LDB(B0, 1, 0); PG8_SCHED; PG8_LDA(At, 1, 0); PG8_STAGE(PG8_SA(0, 1), a2 + hstepA, voffA);
            PG8_WAIT_L(8); PG8_BAR; PG8_WAIT_L(0); PG8_MMA(0, 0, At, B0); PG8_BAR; PG8_SCHED;
            PG8_LDB(B1, 1, 1); PG8_STAGE(PG8_SB(1, 0), b3, voffB);
            PG8_BAR; PG8_WAIT_L(0); PG8_MMA(0, 1, At, B1); PG8_BAR;
            PG8_LDA(At, 1, 1); PG8_STAGE(PG8_SA(1, 0), a3, voffA);
            PG8_BAR; PG8_WAIT_L(0); PG8_MMA(1, 0, At, B0); PG8_BAR; PG8_SCHED;
            PG8_STAGE(PG8_SB(1, 1), b3 + hstepB, voffB);
            PG8_WAIT_V(6); PG8_BAR; PG8_MMA(1, 1, At, B1); PG8_BAR;
            }
        }
        if constexpr (ALIGN_EPI) { if (wr == 0) PG8_BAR; }
        if constexpr (!Epi::AFTER_DRAIN) { E(acc, cur, wr, wc, fr, fq); S.done(cur); }
        if (!has_next) break;
#pragma unroll
        for (int a = 0; a < 2; ++a)
#pragma unroll
            for (int b = 0; b < 2; ++b)
#pragma unroll
                for (int m = 0; m < 4; ++m)
#pragma unroll
                    for (int n = 0; n < 2; ++n) acc[a][b][m][n] = (f32x4){0.f, 0.f, 0.f, 0.f};
        cur = nxt; cA = nA; cB = nB; ++ui;
        if constexpr (ALIGN_EPI) { if (wr == 1) PG8_BAR; }
    }
    PG8_WAIT_V(0);
    if constexpr (!ALIGN_EPI) { if (wr == 0) PG8_BAR; }
    PG8_BAR;
    if constexpr (Epi::AFTER_DRAIN) { E.fused(acc, cur, wr, wc, fr, fq, lds, wid, lane); S.done(cur); }
#undef PG8_SA
#undef PG8_SB
#undef PG8_STAGE
#undef PG8_LDA
#undef PG8_LDB
#undef PG8_MMA
#undef PG8_WAIT_V
#undef PG8_WAIT_L
#undef PG8_BAR
#undef PG8_SCHED
}
}
#define LAS __attribute__((address_space(3)))
#define XB_TMO      128
#define XB_XCNT(j)  (256  + 64 * (j))
#define XB_XSUB(j)  (1280 + 64 * (j))
#define XB_XGEN(j)  (2304 + 64 * (j))
#define XB_TOP      3328
#define XB_TOPGEN   3392
#define XCD_BAR_WORDS 3456
#define XB_SPIN_CAP (1u << 18)

__device__ __forceinline__ unsigned xb_ld(unsigned* p)              { return __hip_atomic_load(p, __ATOMIC_RELAXED, __HIP_MEMORY_SCOPE_AGENT); }
__device__ __forceinline__ unsigned xb_add(unsigned* p, unsigned v) { return __hip_atomic_fetch_add(p, v, __ATOMIC_RELAXED, __HIP_MEMORY_SCOPE_AGENT); }
__device__ __forceinline__ unsigned xb_xcc_id() { return (unsigned)__builtin_amdgcn_s_getreg((3 << 11) | 20) & 0xFu; }
#define XB_SPIN(cond, bar) do { unsigned _sp = 0; while (cond) { __builtin_amdgcn_s_sleep(1); \
    if ((++_sp & 255u) == 0u) { if (xb_ld(&(bar)[XB_TMO])) break; if (_sp > XB_SPIN_CAP) { atomicAdd(&(bar)[XB_TMO], 1u); break; } } } } while (0)

struct XcdBarrier {
    unsigned* bar; unsigned x;
    volatile LAS unsigned* st;
};

__device__ __forceinline__ XcdBarrier xcd_barrier_post(unsigned* bar, volatile LAS unsigned* st) {
    XcdBarrier b; b.bar = bar; b.x = xb_xcc_id(); b.st = st;
    if (threadIdx.x == 0) (void)xb_add(&bar[XB_XCNT(b.x)], 1u);
    return b;
}
__device__ __forceinline__ void xcd_barrier_complete(unsigned* bar, unsigned x, unsigned& nloc, unsigned& nx) {
    const unsigned G = gridDim.x * gridDim.y * gridDim.z;
    unsigned sum, cnt, mine, sp = 0u;
    for (;;) {
        sum = 0u; cnt = 0u; mine = 0u;
#pragma unroll
        for (unsigned j = 0; j < 16; ++j) { const unsigned c = xb_ld(&bar[XB_XCNT(j)]); sum += c; cnt += (c > 0u) ? 1u : 0u; mine = (j == x) ? c : mine; }
        if (sum == G) break;
        __builtin_amdgcn_s_sleep(1);
        if ((++sp & 255u) == 0u) { if (xb_ld(&bar[XB_TMO])) break; if (sp > XB_SPIN_CAP) { atomicAdd(&bar[XB_TMO], 1u); break; } }
    }
    nloc = mine > 0u ? mine : 1u; nx = cnt > 0u ? cnt : 1u;
}

__device__ __forceinline__ void xcd_barrier(const XcdBarrier& b) {
    asm volatile("s_waitcnt vmcnt(0)" ::: "memory");
    __syncthreads();
    if (threadIdx.x == 0) {
        unsigned* bar = b.bar;
        __builtin_amdgcn_s_waitcnt(0);
        unsigned nloc = b.st[0], nx = b.st[1];
        if (nloc == 0u) { xcd_barrier_complete(bar, b.x, nloc, nx); b.st[0] = nloc; b.st[1] = nx; }
        const unsigned old = xb_add(&bar[XB_XSUB(b.x)], 1u);
        const unsigned gen = old / nloc;
        if (old + 1u == (gen + 1u) * nloc) {
            __builtin_amdgcn_fence(__ATOMIC_RELEASE, "agent");
            asm volatile("s_waitcnt vmcnt(0)" ::: "memory");
            const unsigned og = xb_add(&bar[XB_TOP], 1u);
            const unsigned tg = og / nx;
            if (og + 1u == (tg + 1u) * nx) xb_add(&bar[XB_TOPGEN], 1u);
            else XB_SPIN(xb_ld(&bar[XB_TOPGEN]) == tg, bar);
            __builtin_amdgcn_fence(__ATOMIC_ACQUIRE, "agent");
            xb_add(&bar[XB_XGEN(b.x)], 1u);
            asm volatile("s_waitcnt vmcnt(0)" ::: "memory");
        } else {
            XB_SPIN(xb_ld(&bar[XB_XGEN(b.x)]) == gen, bar);
            __builtin_amdgcn_fence(__ATOMIC_ACQUIRE, "agent");
            asm volatile("s_waitcnt vmcnt(0)" ::: "memory");
        }
    }
    __syncthreads();
}
#undef LAS
using namespace pg8;
#define LAS __attribute__((address_space(3)))
typedef float f32x16 __attribute__((ext_vector_type(16)));
typedef unsigned u32x2 __attribute__((ext_vector_type(2)));
#define LDS_WAIT() asm volatile("s_waitcnt lgkmcnt(0)" ::: "memory")

constexpr int DM = 1024, NBATCH = 8, SEQ = 4096, MTOK = NBATCH * SEQ, DEPTH = 4, NIN = 4400, NPAD = 4608, DFF = 4096;
constexpr size_t MiB = 1u << 20;
constexpr size_t WS_ROPEC = 0, WS_ROPES = 512 * 1024, WS_CBIAS = 1 * MiB, WS_BAR = 1 * MiB + 64 * 1024;
constexpr size_t WS_W = 2 * MiB, WL_STRIDE = 33 * MiB;
constexpr size_t W_IN = 0, W_POOL = 9 * MiB, W_CK1 = W_POOL + MiB / 2, W_CV1 = W_CK1 + MiB, W_PP = W_CV1 + MiB, W_PN = W_PP + MiB,
                 W_OUT = W_PN + 2 * MiB, W_FF1 = W_OUT + 2 * MiB, W_FF2 = W_FF1 + 8 * MiB, W_CK2 = W_FF2 + 8 * MiB, W_CV2 = W_CK2 + 32 * 1024;
constexpr size_t WS_SS = 134 * MiB;
constexpr size_t WS_XN = 136 * MiB;
constexpr size_t WS_CK = 200 * MiB, WS_CVT = WS_CK + MiB / 2, WS_HIDK = 201 * MiB, WS_HIDV = 203 * MiB;
constexpr size_t WS_U = 206 * MiB, WS_Q = 238 * MiB, WS_KC = 302 * MiB, WS_VC = 310 * MiB, WS_KS = 318 * MiB, WS_VS = 326 * MiB, WS_KW = 334 * MiB,
                 WS_VW = 342 * MiB, WS_VST = 350 * MiB, WS_VWT = 358 * MiB, WS_GNSA = 366 * MiB, WS_GM = 370 * MiB;
constexpr size_t WS_H = 206 * MiB;
constexpr size_t WS_PPF = 500 * MiB;
constexpr size_t WS_END = 504 * MiB;
constexpr int LDS_BYTES = 135168;

__device__ __forceinline__ int launder_s(int i) { i = __builtin_amdgcn_readfirstlane(i); asm volatile("" : "+s"(i)); return i; }
#define GAS1 __attribute__((address_space(1)))
#define AIN(a, i) ((const float*)(const GAS1 float*)((a).in[launder_s(i)]))
struct Args { const float* in[18]; float* out; unsigned char* ws; double invf[32]; int ph_lo, ph_hi; };

__device__ __forceinline__ float bf2f(unsigned short u) { return __uint_as_float((unsigned)u << 16); }
__device__ __forceinline__ float bflo(unsigned w) { return __uint_as_float(w << 16); }
__device__ __forceinline__ float bfhi(unsigned w) { return __uint_as_float(w & 0xffff0000u); }
__device__ __forceinline__ unsigned short f2bf(float f) { return (unsigned short)(cvt_pk_bf16(f, f) & 0xffffu); }
__device__ __forceinline__ float wave_sum(float v) {
#pragma unroll
    for (int o = 1; o < 64; o <<= 1) v += __shfl_xor(v, o);
    return v;
}
__device__ __forceinline__ float sigmoidf_(float x) { return __builtin_amdgcn_rcpf(1.0f + __builtin_amdgcn_exp2f(-1.4426950408889634f * x)); }
__device__ __forceinline__ f32x4 sigmoid4(f32x4 v) { return (f32x4){sigmoidf_(v[0]), sigmoidf_(v[1]), sigmoidf_(v[2]), sigmoidf_(v[3])}; }
__device__ __forceinline__ float gelu_tanh(float x) {
    const float y = 0.7978845608028654f * (x + 0.044715f * x * x * x);
    const float e = __builtin_amdgcn_exp2f(2.0f * 1.4426950408889634f * y);
    const float th = 1.0f - 2.0f * __builtin_amdgcn_rcpf(1.0f + e);
    return 0.5f * x * (1.0f + th);
}
__device__ __forceinline__ void store8(bf16_t* dst, f32x4 v0, f32x4 v1) {
    u32x4 w; w.x = cvt_pk_bf16(v0[0], v0[1]); w.y = cvt_pk_bf16(v0[2], v0[3]); w.z = cvt_pk_bf16(v1[0], v1[1]); w.w = cvt_pk_bf16(v1[2], v1[3]);
    *(u32x4*)dst = w;
}

template <class T, class = void> struct has_pair : std::false_type {};
template <class T> struct has_pair<T, std::void_t<decltype(T::HAS_PAIR)>> : std::true_type {};
template <class Op, bool RS = false> struct EpiP {
    static constexpr bool PERM = true, AFTER_DRAIN = false; Op op; const float* ss;
    __device__ __forceinline__ void operator()(const f32x4 (&acc)[2][2][4][2], const Unit& u, int wr, int wc, int fr, int fq) const {
#pragma unroll
        for (int ai = 0; ai < 2; ++ai) {
            const int row0 = u.pm * 256 + ai * 128 + wr * 64 + fr; float r[4] = {1.0f, 1.0f, 1.0f, 1.0f};
            if (RS) { f32x4 t[4][4];
#pragma unroll
                for (int m = 0; m < 4; ++m) { const f32x4* sp = (const f32x4*)(ss + (size_t)(row0 + m * 16) * 16);
#pragma unroll
                    for (int k = 0; k < 4; ++k) t[m][k] = sp[k]; }
#pragma unroll
                for (int m = 0; m < 4; ++m) { const f32x4 q = (t[m][0] + t[m][1]) + (t[m][2] + t[m][3]); r[m] = 1.0f / sqrtf(((q.x + q.y) + (q.z + q.w)) * (1.0f / 1024.0f) + 1e-6f); } }
            if constexpr (has_pair<Op>::value) { if (op.is_pair(u.pn)) {
#pragma unroll
                for (int m = 0; m < 4; ++m) op.apply_pair(u.pn, row0 + m * 16, wc, fq, acc[ai][0][m][0] * r[m], acc[ai][0][m][1] * r[m], acc[ai][1][m][0] * r[m], acc[ai][1][m][1] * r[m]);
                continue; } }
            typename Op::Pre pre[4][2];
#pragma unroll
            for (int m = 0; m < 4; ++m)
#pragma unroll
                for (int bj = 0; bj < 2; ++bj) pre[m][bj] = op.load(u.pn, row0 + m * 16, bj * 128 + wc * 32 + 8 * fq);
#pragma unroll
            for (int m = 0; m < 4; ++m)
#pragma unroll
                for (int bj = 0; bj < 2; ++bj) op.apply(u.pn, row0 + m * 16, bj * 128 + wc * 32 + 8 * fq, acc[ai][bj][m][0] * r[m], acc[ai][bj][m][1] * r[m], pre[m][bj]);
        }
    }
};
struct EpiResid {
    static constexpr bool PERM = true, AFTER_DRAIN = false; bf16_t* xb; float* ss;
    __device__ __forceinline__ void operator()(const f32x4 (&acc)[2][2][4][2], const Unit& u, int wr, int wc, int fr, int fq) const {
#pragma unroll
        for (int ai = 0; ai < 2; ++ai) {
            const int row0 = u.pm * 256 + ai * 128 + wr * 64 + fr; const int col0 = u.pn * 256 + wc * 32 + 8 * fq;
            u32x4 xv[4][2];
#pragma unroll
            for (int m = 0; m < 4; ++m)
#pragma unroll
                for (int bj = 0; bj < 2; ++bj) xv[m][bj] = *(const u32x4*)(xb + (size_t)(row0 + m * 16) * 1024 + col0 + bj * 128);
#pragma unroll
            for (int m = 0; m < 4; ++m) { const int row = row0 + m * 16; float sq = 0.f;
#pragma unroll
                for (int bj = 0; bj < 2; ++bj) { const size_t o = (size_t)row * 1024 + col0 + bj * 128; const u32x4 x = xv[m][bj];
                    const f32x4 v0 = (f32x4){bflo(x.x), bfhi(x.x), bflo(x.y), bfhi(x.y)} + acc[ai][bj][m][0], v1 = (f32x4){bflo(x.z), bfhi(x.z), bflo(x.w), bfhi(x.w)} + acc[ai][bj][m][1];
                    store8(xb + o, v0, v1);
                    sq += ((v0.x * v0.x + v0.y * v0.y) + (v0.z * v0.z + v0.w * v0.w)) + ((v1.x * v1.x + v1.y * v1.y) + (v1.z * v1.z + v1.w * v1.w)); }
                sq += __shfl_xor(sq, 16); sq += __shfl_xor(sq, 32);
                if (fq == 0) ss[(size_t)row * 16 + u.pn * 4 + wc] = sq; }
        }
    }
};
__device__ __forceinline__ constexpr int PIperm(int p) { return (p & ~12) | ((p & 8) >> 1) | ((p & 4) << 1); }
struct NoPre {};
struct OpProj { unsigned char* ws; typedef NoPre Pre; static constexpr bool HAS_PAIR = true;
    __device__ __forceinline__ bool is_pair(int pn) const { return pn == 7 || (pn >= 2 && pn < 6); }
    __device__ __forceinline__ void apply_pair(int pn, int row, int wc, int fq, f32x4 a0, f32x4 a1, f32x4 b0, f32x4 b1) const {
        const unsigned g = wc & 1, d0 = 8 * fq, b = (unsigned)row >> 12, t = row & 4095;
        const unsigned ro = (t * 32 + d0) * 4;
        const unsigned ko = (pn == 7) ? (unsigned)((wc >> 1) ? WS_KW : WS_KS) + (((b * 2 + g) * 4096 + t) * 64 + d0) * 2
                                      : (unsigned)WS_Q + ((unsigned)row * 1024u + (unsigned)((pn - 2) * 4 + wc) * 64u + d0) * 2;
        { const f32x4 c0 = *(const f32x4*)(ws + WS_ROPEC + ro), s0 = *(const f32x4*)(ws + WS_ROPES + ro);
          const f32x4 y1 = a0 * c0 - b0 * s0, y2 = b0 * c0 + a0 * s0; u32x2 w1, w2; w1.x = cvt_pk_bf16(y1[0], y1[1]); w1.y = cvt_pk_bf16(y1[2], y1[3]); w2.x = cvt_pk_bf16(y2[0], y2[1]); w2.y = cvt_pk_bf16(y2[2], y2[3]);
          *(u32x2*)(ws + ko) = w1; *(u32x2*)(ws + ko + 64) = w2; }
        { const f32x4 c1 = *(const f32x4*)(ws + WS_ROPEC + ro + 16), s1 = *(const f32x4*)(ws + WS_ROPES + ro + 16);
          const f32x4 y1 = a1 * c1 - b1 * s1, y2 = b1 * c1 + a1 * s1; u32x2 w1, w2; w1.x = cvt_pk_bf16(y1[0], y1[1]); w1.y = cvt_pk_bf16(y1[2], y1[3]); w2.x = cvt_pk_bf16(y2[0], y2[1]); w2.y = cvt_pk_bf16(y2[2], y2[3]);
          *(u32x2*)(ws + ko + 8) = w1; *(u32x2*)(ws + ko + 72) = w2; }
    }
    __device__ __forceinline__ Pre load(int, int, int) const { return Pre{}; }
    __device__ __forceinline__ void apply(int pn, int row, int lc, f32x4 v0, f32x4 v1, const Pre&) const {
        size_t off; bool sig = false;
        if (pn < 2) off = WS_U + ((size_t)row * 512 + pn * 256 + lc) * 2;
        else if (pn < 6) off = WS_Q + ((size_t)row * 1024 + (pn - 2) * 256 + lc) * 2;
        else if (pn == 6) { const int c = lc & 127, g = c >> 6, dh = c & 63, b = row >> 12, t = row & 4095;
            off = WS_KC + (size_t)(lc >> 7) * (8 * MiB) + (((size_t)((b * 2 + g) * 4096 + t)) * 64 + dh) * 2; }
        else if (pn == 8) {
            const int c = lc & 127, g = c >> 6, dh = c & 63, b = row >> 12, t = row & 4095;
            bf16_t* vt = (bf16_t*)(ws + ((lc >> 7) ? WS_VWT : WS_VST)) + ((size_t)(b * 2 + g) * 64 + (t >> 6)) * 4096 + dh * 64 + PIperm(t & 63);
#pragma unroll
            for (int j = 0; j < 4; ++j) { vt[j * 64] = f2bf(v0[j]); vt[(4 + j) * 64] = f2bf(v1[j]); }
            return; }
        else if (pn == 7) return;
        else if (pn == 9) { if (lc >= 64) return; off = WS_GNSA + ((size_t)row * 64 + lc) * 2; sig = true; }
        else {
            v0 = sigmoid4(v0); v1 = sigmoid4(v1); u32x2 w;
            w.x = (unsigned)(v0[0] * 255.0f + 0.5f) | ((unsigned)(v0[1] * 255.0f + 0.5f) << 8) | ((unsigned)(v0[2] * 255.0f + 0.5f) << 16) | ((unsigned)(v0[3] * 255.0f + 0.5f) << 24);
            w.y = (unsigned)(v1[0] * 255.0f + 0.5f) | ((unsigned)(v1[1] * 255.0f + 0.5f) << 8) | ((unsigned)(v1[2] * 255.0f + 0.5f) << 16) | ((unsigned)(v1[3] * 255.0f + 0.5f) << 24);
            *(u32x2*)(ws + WS_GM + (size_t)row * 2048 + (pn - 10) * 256 + lc) = w; return; }
        if (sig) { v0 = sigmoid4(v0); v1 = sigmoid4(v1); }
        store8((bf16_t*)(ws + off), v0, v1);
    } };
struct OpBf16 { bf16_t* O; int ld; typedef NoPre Pre;
    __device__ __forceinline__ Pre load(int, int, int) const { return Pre{}; }
    __device__ __forceinline__ void apply(int pn, int row, int lc, f32x4 v0, f32x4 v1, const Pre&) const { store8(O + (size_t)row * ld + pn * 256 + lc, v0, v1); } };
struct OpCmp1 { bf16_t* H; const float* bias; struct Pre { f32x4 b0, b1; };
    __device__ __forceinline__ Pre load(int, int, int lc) const { return Pre{*(const f32x4*)(bias + lc), *(const f32x4*)(bias + lc + 4)}; }
    __device__ __forceinline__ void apply(int pn, int row, int lc, f32x4 v0, f32x4 v1, const Pre& p) const {
        v0 += p.b0; v1 += p.b1;
#pragma unroll
        for (int i = 0; i < 4; ++i) { v0[i] = gelu_tanh(v0[i]); v1[i] = gelu_tanh(v1[i]); }
        store8(H + (size_t)row * 256 + lc, v0, v1);
    } };
__device__ __forceinline__ void ungate8(u32x2 g, float (&f)[8]) { constexpr float k = 1.0f / 255.0f;
    f[0] = (float)(g.x & 255u) * k; f[1] = (float)((g.x >> 8) & 255u) * k; f[2] = (float)((g.x >> 16) & 255u) * k; f[3] = (float)(g.x >> 24) * k;
    f[4] = (float)(g.y & 255u) * k; f[5] = (float)((g.y >> 8) & 255u) * k; f[6] = (float)((g.y >> 16) & 255u) * k; f[7] = (float)(g.y >> 24) * k; }
struct OpMerge1 { const unsigned char* G8; bf16_t* MG; struct Pre { u32x2 g; };
    __device__ __forceinline__ Pre load(int pn, int row, int lc) const { return Pre{*(const u32x2*)(G8 + (size_t)row * 2048 + pn * 256 + lc)}; }
    __device__ __forceinline__ void apply(int pn, int row, int lc, f32x4 v0, f32x4 v1, const Pre& p) const {
        float g[8]; ungate8(p.g, g);
#pragma unroll
        for (int i = 0; i < 4; ++i) { v0[i] *= g[i]; v1[i] *= g[4 + i]; }
        store8(MG + (size_t)row * 1024 + pn * 256 + lc, v0, v1);
    } };
struct OpMerge2 { const unsigned char* G8; bf16_t* MG; struct Pre { u32x4 t; u32x2 g; };
    __device__ __forceinline__ Pre load(int pn, int row, int lc) const { return Pre{*(const u32x4*)(MG + (size_t)row * 1024 + pn * 256 + lc), *(const u32x2*)(G8 + (size_t)row * 2048 + 1024 + pn * 256 + lc)}; }
    __device__ __forceinline__ void apply(int pn, int row, int lc, f32x4 v0, f32x4 v1, const Pre& p) const {
        const u32x4 t = p.t; float g[8]; ungate8(p.g, g);
        v0[0] = v0[0] * g[0] + bflo(t.x); v0[1] = v0[1] * g[1] + bfhi(t.x); v0[2] = v0[2] * g[2] + bflo(t.y); v0[3] = v0[3] * g[3] + bfhi(t.y);
        v1[0] = v1[0] * g[4] + bflo(t.z); v1[1] = v1[1] * g[5] + bfhi(t.z); v1[2] = v1[2] * g[6] + bflo(t.w); v1[3] = v1[3] * g[7] + bfhi(t.w);
        store8(MG + (size_t)row * 1024 + pn * 256 + lc, v0, v1);
    } };
struct OpFF1 { bf16_t* H; typedef NoPre Pre;
    __device__ __forceinline__ Pre load(int, int, int) const { return Pre{}; }
    __device__ __forceinline__ void apply(int pn, int row, int lc, f32x4 v0, f32x4 v1, const Pre&) const {
#pragma unroll
        for (int i = 0; i < 4; ++i) { const float a = fmaxf(v0[i], 0.f), b = fmaxf(v1[i], 0.f); v0[i] = a * a; v1[i] = b * b; }
        store8(H + (size_t)row * 4096 + pn * 256 + lc, v0, v1);
    } };
struct EpiNull { static constexpr bool PERM = true, AFTER_DRAIN = false;
    __device__ __forceinline__ void operator()(const f32x4 (&acc)[2][2][4][2], const Unit& u, int wr, int wc, int fr, int fq) const {
#pragma unroll
        for (int ai = 0; ai < 2; ++ai)
#pragma unroll
            for (int bj = 0; bj < 2; ++bj)
#pragma unroll
                for (int m = 0; m < 4; ++m)
#pragma unroll
                    for (int n = 0; n < 2; ++n) asm volatile("" :: "v"(acc[ai][bj][m][n]));
    } };
template <class Epi> __device__ __forceinline__ void run_gemm(LAS unsigned char* lds, const bf16_t* A, int lda, const bf16_t* Bt, int M, int N, int K, const Epi& E, int G, int c) {
    Gemm g{A, Bt, M, N, K, lda}; StaticOrder S; S.init(M, N, G, c);
    gemm_phase<Epi, StaticOrder, true, true>(lds, g, S, E);
}

template <class F> __device__ __forceinline__ void conv_tile(F f, bf16_t* WT, int K, int n0, int k0, LAS float* scr, int lane) {
    float tv[32];
#pragma unroll
    for (int i = 0; i < 32; ++i) tv[i] = f(k0 + 2 * i + (lane >> 5), n0 + (lane & 31));
#pragma unroll
    for (int i = 0; i < 32; ++i) scr[(2 * i + (lane >> 5)) * 33 + (lane & 31)] = tv[i];
    LDS_WAIT(); asm volatile("" ::: "memory");
    const int c = lane & 7;
#pragma unroll
    for (int j = 0; j < 4; ++j) { const int n = (lane >> 3) + 8 * j; const LAS float* s = scr + (8 * c) * 33 + n;
        u32x4 o; o.x = cvt_pk_bf16(s[0 * 33], s[1 * 33]); o.y = cvt_pk_bf16(s[2 * 33], s[3 * 33]); o.z = cvt_pk_bf16(s[4 * 33], s[5 * 33]); o.w = cvt_pk_bf16(s[6 * 33], s[7 * 33]);
        *(u32x4*)(WT + (size_t)(n0 + n) * K + k0 + 8 * c) = o; }
    LDS_WAIT(); asm volatile("" ::: "memory");
}
struct FPlain { const float* W; int N; __device__ __forceinline__ float operator()(int k, int n) const { return W[(size_t)k * N + n]; } };
struct FWin { const float* W; const float* gk; __device__ __forceinline__ float operator()(int k, int p) const {
    int src;
    if (p < 512 || (p >= 1536 && p < 1792)) src = p;
    else if (p < 1536) { const int lc = (p - 512) & 255, tl = (p - 512) >> 8, bj = lc >> 7, wc = (lc >> 5) & 3, r = lc & 31;
        src = 512 + (tl * 4 + wc) * 64 + bj * 32 + r; }
    else if (p < 2048) { const int lc = p - 1792, bj = lc >> 7, wc = (lc >> 5) & 3, r = lc & 31;
        src = ((wc >> 1) ? 2048 : 1792) + (wc & 1) * 64 + bj * 32 + r; }
    else if (p < 2304) { const int lc = p - 2048; src = (lc < 128) ? 1920 + lc : 2176 + (lc - 128); }
    else if (p < 2352) src = p; else if (p < 2560) src = -1; else src = p - 208; return src < 0 ? 0.f : W[(size_t)k * NIN + src] * gk[k]; } };
struct FPlainG { const float* W; int N; const float* gk; __device__ __forceinline__ float operator()(int k, int n) const { return W[(size_t)k * N + n] * gk[k]; } };
struct FPool { const float* W; const float* sc; __device__ __forceinline__ float operator()(int j, int k) const {
    return ((k >> 7) == (j >> 7)) ? W[(k >> 7) * 16384 + (k & 127) * 128 + (j & 127)] * sc[j] : 0.f; } };

__device__ __forceinline__ void rms_row_out(const bf16_t* xrow, const float* g, float* orow, int lane) {
    const u32x2* xr = (const u32x2*)xrow + lane; const f32x4* gr = (const f32x4*)g + lane;
    f32x4 v[4]; float s = 0.f;
#pragma unroll
    for (int j = 0; j < 4; ++j) { const u32x2 w = xr[64 * j]; v[j] = (f32x4){bflo(w.x), bfhi(w.x), bflo(w.y), bfhi(w.y)}; s += (v[j].x * v[j].x + v[j].y * v[j].y) + (v[j].z * v[j].z + v[j].w * v[j].w); }
    const float r = 1.0f / sqrtf(wave_sum(s) * (1.0f / 1024.0f) + 1e-6f);
    f32x4* o = (f32x4*)orow + lane;
#pragma unroll
    for (int j = 0; j < 4; ++j) { const f32x4 gg = gr[64 * j]; o[64 * j] = (v[j] * r) * gg; }
}
struct Ctx { LAS unsigned char* lds; unsigned char* ws; int tid, lane, wave, G, bx, gw, NGW; };

__device__ __forceinline__ void ph_prologue(const Args& a, const Ctx& C) {
    unsigned char* ws = C.ws;
    { float* rc = (float*)(ws + WS_ROPEC); float* rs = (float*)(ws + WS_ROPES);
      for (int idx = C.bx * 512 + C.tid; idx < SEQ * 32; idx += C.G * 512) {
        const int t = idx >> 5, i = idx & 31; const double ang = (double)t * a.invf[i];
        const double k = rint(ang * 0.15915494309189535); double r = fma(-k, 6.283185307179586, ang); r = fma(-k, 2.4492935982947064e-16, r);
        const double r2 = r * r; double s = 1.0, c = 1.0;
#pragma unroll
        for (int n = 15; n >= 1; --n) { s = 1.0 - r2 * (1.0 / (double)((2 * n) * (2 * n + 1))) * s; c = 1.0 - r2 * (1.0 / (double)((2 * n - 1) * (2 * n))) * c; }
        rc[idx] = (float)c; rs[idx] = (float)(r * s);
      } }
    LAS float* scr = (LAS float*)(C.lds + C.wave * 8448);
    constexpr int I_IN = 16 * 144, I_POOL = 8 * 16, I_CK = 32 * 8, I_PP = 8 * 32, I_PN = 16 * 32, I_OUT = 16 * 32, I_FF1 = 16 * 128, I_FF2 = 64 * 32, I_C2 = 4 * 2;
    constexpr int NITEMS = I_IN + I_POOL + 2 * I_CK + I_PP + I_PN + I_OUT + I_FF1 + I_FF2 + 2 * I_C2;
    for (int it = C.gw; it < DEPTH * NITEMS; it += C.NGW) {
        const int l = it / NITEMS; int r = it - l * NITEMS; unsigned char* wl = ws + WS_W + (size_t)l * WL_STRIDE;
        if (r < I_IN) { conv_tile(FWin{AIN(a, 2) + (size_t)l * DM * NIN, AIN(a, 1) + (size_t)l * 1024}, (bf16_t*)(wl + W_IN), 1024, (r % 144) * 32, (r / 144) * 64, scr, C.lane); continue; } r -= I_IN;
        if (r < I_POOL) { conv_tile(FPool{AIN(a, 3) + (size_t)l * 65536, AIN(a, 4) + (size_t)l * 512}, (bf16_t*)(wl + W_POOL), 512, (r % 16) * 32, (r / 16) * 64, scr, C.lane); continue; } r -= I_POOL;
        if (r < I_CK) { conv_tile(FPlain{AIN(a, 7) + (size_t)l * 2048 * 256, 256}, (bf16_t*)(wl + W_CK1), 2048, (r % 8) * 32, (r / 8) * 64, scr, C.lane); continue; } r -= I_CK;
        if (r < I_CK) { conv_tile(FPlain{AIN(a, 9) + (size_t)l * 2048 * 256, 256}, (bf16_t*)(wl + W_CV1), 2048, (r % 8) * 32, (r / 8) * 64, scr, C.lane); continue; } r -= I_CK;
        if (r < I_PP) { conv_tile(FPlain{AIN(a, 11) + (size_t)l * 512 * 1024, 1024}, (bf16_t*)(wl + W_PP), 512, (r % 32) * 32, (r / 32) * 64, scr, C.lane); continue; } r -= I_PP;
        if (r < I_PN) { conv_tile(FPlain{AIN(a, 12) + (size_t)l * 1024 * 1024, 1024}, (bf16_t*)(wl + W_PN), 1024, (r % 32) * 32, (r / 32) * 64, scr, C.lane); continue; } r -= I_PN;
        if (r < I_OUT) { conv_tile(FPlain{AIN(a, 13) + (size_t)l * 1024 * 1024, 1024}, (bf16_t*)(wl + W_OUT), 1024, (r % 32) * 32, (r / 32) * 64, scr, C.lane); continue; } r -= I_OUT;
        if (r < I_FF1) { conv_tile(FPlainG{AIN(a, 15) + (size_t)l * 1024 * 4096, 4096, AIN(a, 14) + (size_t)l * 1024}, (bf16_t*)(wl + W_FF1), 1024, (r % 128) * 32, (r / 128) * 64, scr, C.lane); continue; } r -= I_FF1;
        if (r < I_FF2) { conv_tile(FPlain{AIN(a, 16) + (size_t)l * 4096 * 1024, 1024}, (bf16_t*)(wl + W_FF2), 4096, (r % 32) * 32, (r / 32) * 64, scr, C.lane); continue; } r -= I_FF2;
        if (r < I_C2) { conv_tile(FPlain{AIN(a, 8) + (size_t)l * 256 * 64, 64}, (bf16_t*)(wl + W_CK2), 256, (r % 2) * 32, (r / 2) * 64, scr, C.lane); continue; } r -= I_C2;
        conv_tile(FPlain{AIN(a, 10) + (size_t)l * 256 * 64, 64}, (bf16_t*)(wl + W_CV2), 256, (r % 2) * 32, (r / 2) * 64, scr, C.lane);
    }
    { float* cb = (float*)(ws + WS_CBIAS);
      for (int it = C.gw; it < DEPTH * 512; it += C.NGW) { const int l = it >> 9, kv = (it >> 8) & 1, n = it & 255; const float* pe = AIN(a, kv ? 6 : 5) + (size_t)l * 2048; const float* w1 = AIN(a, kv ? 9 : 7) + (size_t)l * 2048 * 256;
          float s = 0.f; for (int kk = C.lane; kk < 2048; kk += 64) s += pe[kk] * w1[(size_t)kk * 256 + n];
          s = wave_sum(s); if (C.lane == 0) cb[it] = s; } }
    { const float* x = AIN(a, 0); bf16_t* XB = (bf16_t*)(ws + WS_XN); float* SS = (float*)(ws + WS_SS); const int lane = C.lane;
      for (int m = C.gw; m < MTOK; m += C.NGW) {
        const f32x4* xr = (const f32x4*)(x + (size_t)m * 1024) + lane; u32x2* o8 = (u32x2*)(XB + (size_t)m * 1024) + lane; float sq = 0.f;
#pragma unroll
        for (int j = 0; j < 4; ++j) { const f32x4 v = xr[64 * j]; sq += (v.x * v.x + v.y * v.y) + (v.z * v.z + v.w * v.w); u32x2 w; w.x = cvt_pk_bf16(v.x, v.y); w.y = cvt_pk_bf16(v.z, v.w); o8[64 * j] = w; }
        sq = wave_sum(sq); if (lane < 16) SS[(size_t)m * 16 + lane] = (lane == 0) ? sq : 0.f;
      } }
}

__device__ __forceinline__ void vt_tile(const bf16_t* src, bf16_t* dst, int lane) {
    unsigned pk[32];
#pragma unroll
    for (int pos = 0; pos < 64; pos += 2) { const int kv0 = PIperm(pos); const unsigned lo = src[kv0 * 64 + lane], hi = src[(kv0 + 1) * 64 + lane]; pk[pos >> 1] = lo | (hi << 16); }
    u32x4* d = (u32x4*)(dst + lane * 64);
#pragma unroll
    for (int j = 0; j < 8; ++j) d[j] = (u32x4){pk[4 * j], pk[4 * j + 1], pk[4 * j + 2], pk[4 * j + 3]};
}
__device__ __forceinline__ void ph_post(const Ctx& C, bool do_rope, const int pgw, const int pngw, bf16_t* Dbuf) {
    unsigned char* ws = C.ws; const int lane = C.lane;
    const float* rc = (const float*)(ws + WS_ROPEC); const float* rs = (const float*)(ws + WS_ROPES);
    if (do_rope) for (int it = pgw; it < 2 * 16 * 4096 / 8; it += pngw) {
        const int rr = it * 8 + (lane >> 3); bf16_t* base = (bf16_t*)(ws + (rr < 65536 ? WS_KS : WS_KW)); const int r = rr & 65535, t = r & 4095, d0 = (lane & 7) * 4;
        bf16_t* p = base + (size_t)r * 64 + d0; const u32x2 a = *(const u32x2*)p, b = *(const u32x2*)(p + 32);
        const f32x4 c = *(const f32x4*)(rc + t * 32 + d0), s = *(const f32x4*)(rs + t * 32 + d0);
        const float x1[4] = {bflo(a.x), bfhi(a.x), bflo(a.y), bfhi(a.y)}, x2[4] = {bflo(b.x), bfhi(b.x), bflo(b.y), bfhi(b.y)};
        float y1[4], y2[4];
#pragma unroll
        for (int i = 0; i < 4; ++i) { y1[i] = x1[i] * c[i] - x2[i] * s[i]; y2[i] = x2[i] * c[i] + x1[i] * s[i]; }
        u32x2 oa, ob; oa.x = cvt_pk_bf16(y1[0], y1[1]); oa.y = cvt_pk_bf16(y1[2], y1[3]); ob.x = cvt_pk_bf16(y2[0], y2[1]); ob.y = cvt_pk_bf16(y2[2], y2[3]);
        *(u32x2*)p = oa; *(u32x2*)(p + 32) = ob;
    }
    { const bf16_t* U = (const bf16_t*)(ws + WS_U); bf16_t* D = Dbuf;
#define UNPK8(NAME_, VEC_) const float NAME_[8] = {bflo(VEC_[0]), bfhi(VEC_[0]), bflo(VEC_[1]), bfhi(VEC_[1]), bflo(VEC_[2]), bfhi(VEC_[2]), bflo(VEC_[3]), bfhi(VEC_[3])}
      for (int it = pgw; it < MTOK / 32; it += pngw) {
        const int tt0 = it * 32, t0 = tt0 & 4095, w = 2 << (lane >> 4); const bf16_t* up = U + (size_t)tt0 * 512 + lane * 8; bf16_t* dp = D + (size_t)tt0 * 512 + lane * 8;
        float s[8] = {0.f, 0.f, 0.f, 0.f, 0.f, 0.f, 0.f, 0.f};
#pragma unroll
        for (int i = 1; i < 16; ++i) if (i < w && t0 - i >= 0) { const u32x4 v = *(const u32x4*)(up - (ptrdiff_t)i * 512); UNPK8(x, v);
#pragma unroll
            for (int j2 = 0; j2 < 8; ++j2) s[j2] += x[j2]; }
#pragma unroll 8
        for (int k = 0; k < 32; ++k) {
            const int t = t0 + k; const u32x4 v = *(const u32x4*)(up + (size_t)k * 512); UNPK8(x, v);
            const int cnt = (t + 1 < w) ? t + 1 : w; const float inv = 1.0f / (float)cnt; f32x4 d0, d1;
#pragma unroll
            for (int j2 = 0; j2 < 8; ++j2) s[j2] += x[j2];
#pragma unroll
            for (int j2 = 0; j2 < 4; ++j2) { d0[j2] = s[j2] * inv - x[j2]; d1[j2] = s[j2 + 4] * inv - x[j2 + 4]; }
            store8(dp + (size_t)k * 512, d0, d1);
            if (t - w + 1 >= 0) { const u32x4 vo = *(const u32x4*)(up + (ptrdiff_t)(k - w + 1) * 512); UNPK8(y, vo);
#pragma unroll
                for (int j2 = 0; j2 < 8; ++j2) s[j2] -= y[j2]; }
        }
      }
#undef UNPK8
    }
}

__device__ __forceinline__ constexpr int crow_c(int r) { return (r & 3) + 8 * (r >> 2); }
#define MFMA32(a, b, c) __builtin_amdgcn_mfma_f32_32x32x16_bf16((a), (b), (c), 0, 0, 0)
__device__ __forceinline__ void ph_cmp2(const Ctx& C, int l) {
    unsigned char* ws = C.ws; const int lane = C.lane, c = lane & 31, hh = lane >> 5;
    const float* rc = (const float*)(ws + WS_ROPEC); const float* rs = (const float*)(ws + WS_ROPES);
    for (int it = C.bx + C.G * C.wave; it < 256; it += C.G * 8) {
        const int kv = it >> 7, r0 = (it & 127) * 32;
        const bf16_t* hid = (const bf16_t*)(ws + (kv ? WS_HIDV : WS_HIDK)) + (size_t)(r0 + c) * 256 + hh * 8;
        const bf16_t* w2t = (const bf16_t*)(ws + WS_W + (size_t)l * WL_STRIDE + (kv ? W_CV2 : W_CK2)) + hh * 8;
        f32x16 a0 = (f32x16){}, a1 = (f32x16){};
#pragma unroll 4
        for (int ks = 0; ks < 16; ++ks) { const bf16x8 af = *(const bf16x8*)(hid + ks * 16), b0 = *(const bf16x8*)(w2t + (size_t)c * 256 + ks * 16), b1 = *(const bf16x8*)(w2t + (size_t)(c + 32) * 256 + ks * 16);
            a0 = MFMA32(af, b0, a0); a1 = MFMA32(af, b1, a1); }
#pragma unroll
        for (int r = 0; r < 16; ++r) { const int row = r0 + crow_c(r) + 4 * hh, bg = row >> 8, n = row & 255; float v0 = a0[r], v1 = a1[r];
            if (n == 255) { v0 = 0.f; v1 = 0.f; }
            if (kv == 0) { const int pos = (n == 255) ? 0 : 16 * n + 31; const float cc = rc[pos * 32 + c], sn = rs[pos * 32 + c];
                bf16_t* o = (bf16_t*)(ws + WS_CK) + (size_t)row * 64; o[c] = f2bf(v0 * cc - v1 * sn); o[c + 32] = f2bf(v1 * cc + v0 * sn); }
            else { bf16_t* o = (bf16_t*)(ws + WS_CVT) + (size_t)bg * 16384 + (n >> 6) * 4096 + PIperm(n & 63); o[c * 64] = f2bf(v0); o[(c + 32) * 64] = f2bf(v1); } }
    }
}

constexpr int AT_KB = 0, AT_VB = 18432, AT_SLAB = 36864, AT_SELM = AT_SLAB + 65536, AT_UNION = AT_SELM + 256, KPITCH = 144;
constexpr float SM_C = 0.125f * 1.4426950408889634f;
__device__ __forceinline__ void qk_tile(LAS const unsigned char* kb, const bf16x8 (&qf)[4], f32x16& p0, f32x16& p1, int lane) {
    LAS const unsigned char* ka = kb + (lane & 31) * KPITCH + (lane >> 5) * 16;
    p0 = (f32x16){}; p1 = (f32x16){};
#pragma unroll
    for (int ks = 0; ks < 4; ++ks) { const bf16x8 a0 = *(LAS const bf16x8*)(ka + ks * 32), a1 = *(LAS const bf16x8*)(ka + 32 * KPITCH + ks * 32);
        p0 = MFMA32(a0, qf[ks], p0); p1 = MFMA32(a1, qf[ks], p1); }
    __builtin_amdgcn_sched_group_barrier(0x100, 8, 0); __builtin_amdgcn_sched_group_barrier(0x008, 8, 0);
}
typedef float f32x2v __attribute__((ext_vector_type(2)));
__device__ __forceinline__ float fmax3(float a, float b, float c) { return fmaxf(fmaxf(a, b), c); }
__device__ __forceinline__ void attn_tile(LAS const unsigned char* kb, LAS const unsigned char* vb, const bf16x8 (&qf)[4], float& m, float& l, f32x16& o0, f32x16& o1, int lo, int hi_, int lane) {
    const int hh = lane >> 5; f32x16 p0, p1;
    qk_tile(kb, qf, p0, p1, lane);
    const bool lane_full = (lo <= 0) && (hi_ >= 63), lane_empty = lo > hi_;
    const bool simple = __all((lane_full || lane_empty) ? 1 : 0) != 0;
    if (!simple) { const int lo2 = lo - 4 * hh, hi2 = hi_ - 4 * hh;
#pragma unroll
        for (int r = 0; r < 16; ++r) { const int c0 = crow_c(r), c1 = c0 + 32; p0[r] = (c0 >= lo2 && c0 <= hi2) ? p0[r] : -INFINITY; p1[r] = (c1 >= lo2 && c1 <= hi2) ? p1[r] : -INFINITY; } }
    float mxa = fmax3(p0[0], p0[1], p1[0]), mxb = fmax3(p0[2], p0[3], p1[1]); mxa = fmax3(mxa, p1[2], p1[3]);
#pragma unroll
    for (int r = 4; r < 16; r += 4) { mxa = fmax3(mxa, p0[r], p0[r + 1]); mxb = fmax3(mxb, p0[r + 2], p0[r + 3]); mxa = fmax3(mxa, p1[r], p1[r + 1]); mxb = fmax3(mxb, p1[r + 2], p1[r + 3]); }
    float mx = fmaxf(mxa, mxb);
    const bool dead = simple && lane_empty;
    if (dead) mx = -INFINITY;
    mx = fmaxf(mx, __shfl_xor(mx, 32));
    const float mx2 = mx * SM_C;
    if (__any((mx2 > m + 8.0f) ? 1 : 0)) {
        const float mn = fmaxf(m, mx2), alpha = __builtin_amdgcn_exp2f(m - mn);
        l *= alpha; m = mn;
#pragma unroll
        for (int r = 0; r < 16; ++r) { o0[r] *= alpha; o1[r] *= alpha; }
    }
    const float neg = dead ? -INFINITY : -m;
    float sa = 0.f, sb = 0.f;
#pragma unroll
    for (int r = 0; r < 16; r += 2) {
        p0[r] = __builtin_amdgcn_exp2f(__builtin_fmaf(p0[r], SM_C, neg)); p0[r + 1] = __builtin_amdgcn_exp2f(__builtin_fmaf(p0[r + 1], SM_C, neg));
        p1[r] = __builtin_amdgcn_exp2f(__builtin_fmaf(p1[r], SM_C, neg)); p1[r + 1] = __builtin_amdgcn_exp2f(__builtin_fmaf(p1[r + 1], SM_C, neg));
        sa += p0[r] + p0[r + 1]; sb += p1[r] + p1[r + 1];
    }
    l += sa + sb;
    bf16x8 pf[4];
#pragma unroll
    for (int s = 0; s < 2; ++s) {
        u32x4 w0, w1;
        w0.x = cvt_pk_bf16(p0[8 * s + 0], p0[8 * s + 1]); w0.y = cvt_pk_bf16(p0[8 * s + 2], p0[8 * s + 3]); w0.z = cvt_pk_bf16(p0[8 * s + 4], p0[8 * s + 5]); w0.w = cvt_pk_bf16(p0[8 * s + 6], p0[8 * s + 7]);
        w1.x = cvt_pk_bf16(p1[8 * s + 0], p1[8 * s + 1]); w1.y = cvt_pk_bf16(p1[8 * s + 2], p1[8 * s + 3]); w1.z = cvt_pk_bf16(p1[8 * s + 4], p1[8 * s + 5]); w1.w = cvt_pk_bf16(p1[8 * s + 6], p1[8 * s + 7]);
        pf[s] = __builtin_bit_cast(bf16x8, w0); pf[2 + s] = __builtin_bit_cast(bf16x8, w1);
    }
    LAS const unsigned char* va = vb + (lane & 31) * KPITCH + hh * 16;
#pragma unroll
    for (int ts = 0; ts < 4; ++ts) {
        const bf16x8 v0 = *(LAS const bf16x8*)(va + ts * 32), v1 = *(LAS const bf16x8*)(va + 32 * KPITCH + ts * 32);
        o0 = MFMA32(v0, pf[ts], o0); o1 = MFMA32(v1, pf[ts], o1);
    }
    __builtin_amdgcn_sched_group_barrier(0x100, 8, 1); __builtin_amdgcn_sched_group_barrier(0x008, 8, 1);
}
template <int MODE>
__device__ __forceinline__ void run_branch(LAS unsigned char* lds, const unsigned char* Kg, const unsigned char* Vg, unsigned long long tiles, const bf16x8 (&qf)[4],
                                           float& m, float& l, f32x16& o0, f32x16& o1, int cur, int tq, int nvalid, unsigned long long selm, int tid, int lane) {
    const int soff = (tid >> 3) * KPITCH + (tid & 7) * 16;
    unsigned long long rem = tiles;
    int T = __ffsll(rem) - 1; rem &= rem - 1;
    u32x4 kr = *(const u32x4*)(Kg + (size_t)T * 8192 + tid * 16), vr = *(const u32x4*)(Vg + (size_t)T * 8192 + tid * 16);
    *(LAS u32x4*)(lds + AT_KB + soff) = kr; *(LAS u32x4*)(lds + AT_VB + soff) = vr;
    __syncthreads();
    int bi = 0;
    for (;;) {
        const bool more = rem != 0ull;
        const int Tn = more ? (__ffsll(rem) - 1) : T; rem &= rem - 1;
        kr = *(const u32x4*)(Kg + (size_t)Tn * 8192 + tid * 16); vr = *(const u32x4*)(Vg + (size_t)Tn * 8192 + tid * 16);
        int lo, hi_;
        if (MODE == 0) { lo = 0; hi_ = nvalid - 64 * T - 1; }
        else if (MODE == 1) { const bool sb = ((selm >> T) & 1ull) != 0; lo = sb ? 0 : 1; hi_ = sb ? (T < cur ? 63 : tq) : 0; }
        else { lo = (T == cur - 8) ? tq + 1 : 0; hi_ = (T == cur) ? tq : 63; }
        attn_tile(lds + AT_KB + bi * 9216, lds + AT_VB + bi * 9216, qf, m, l, o0, o1, lo, hi_, lane);
        *(LAS u32x4*)(lds + AT_KB + (bi ^ 1) * 9216 + soff) = kr; *(LAS u32x4*)(lds + AT_VB + (bi ^ 1) * 9216 + soff) = vr;
        __syncthreads();
        if (!more) break;
        T = Tn; bi ^= 1;
    }
}
__device__ __forceinline__ void ph_attn(const Ctx& C, size_t yoff) {
    unsigned char* ws = C.ws; LAS unsigned char* lds = C.lds; const int tid = C.tid, lane = C.lane, w = C.wave, q = lane & 31, hh = lane >> 5;
    bf16_t* Q = (bf16_t*)(ws + WS_Q); const bf16_t* GN = (const bf16_t*)(ws + WS_GNSA);
    LAS float* slab = (LAS float*)(lds + AT_SLAB); LAS unsigned long long* selmp = (LAS unsigned long long*)(lds + AT_SELM); LAS unsigned* unionp = (LAS unsigned*)(lds + AT_UNION);
    const int vcu = (C.G % 8 == 0) ? (C.bx % 8) * (C.G / 8) + C.bx / 8 : C.bx;
    for (int it = vcu; it < 2048; it += C.G) {
        int bg, qb;
        if (C.G == 256) { const int i = it >> 8, v = it & 255, s = v & 15; bg = v >> 4; qb = 32 * (i >> 1) + ((i & 1) ? 31 - s : s); }
        else { bg = it & 15; qb = it >> 4; }
        const int b = bg >> 1, g = bg & 1, h = g * 8 + w, t0 = qb * 32, cur = t0 >> 6, t = t0 + q, tq = t & 63;
        const size_t tokrow = (size_t)b * 4096 + t;
        bf16_t* qp = Q + tokrow * 1024 + h * 64;
        bf16x8 qf[4];
#pragma unroll
        for (int ks = 0; ks < 4; ++ks) qf[ks] = *(const bf16x8*)(qp + ks * 16 + hh * 8);
        const float gc = bf2f(GN[tokrow * 64 + h * 3 + 0]), gs = bf2f(GN[tokrow * 64 + h * 3 + 1]), gwn = bf2f(GN[tokrow * 64 + h * 3 + 2]);
        if (tid == 0) { unionp[0] = 0u; unionp[1] = 0u; }
        const int nvalid = (t >= 31) ? ((t - 15) >> 4) : 0; const int nvmax = (t0 + 16) >> 4; const int ntile = (nvmax + 63) >> 6;
        const unsigned char* CKg = ws + WS_CK + (size_t)bg * 32768; const unsigned char* CVg = ws + WS_CVT + (size_t)bg * 32768;
        float m = -1e30f, l = 0.f; f32x16 o0 = (f32x16){}, o1 = (f32x16){};
        run_branch<0>(lds, CKg, CVg, (1ull << ntile) - 1ull, qf, m, l, o0, o1, cur, tq, nvalid, 0ull, tid, lane);
        l += __shfl_xor(l, 32);
        const float invl = (l > 0.f) ? 1.0f / l : 0.f;
        f32x16 out0 = o0 * (gc * invl), out1 = o1 * (gc * invl);
        if (cur - 2 > 13) { const int soff = (tid >> 3) * KPITCH + (tid & 7) * 16; float carry = 0.f;
          u32x4 kpre = *(const u32x4*)(CKg + tid * 16);
          for (int T = 0; T < ntile; ++T) {
            *(LAS u32x4*)(lds + AT_KB + (T & 1) * 9216 + soff) = kpre;
            kpre = *(const u32x4*)(CKg + (size_t)((T + 1 < ntile) ? T + 1 : T) * 8192 + tid * 16);
            __syncthreads();
            f32x16 p0, p1; qk_tile(lds + AT_KB + (T & 1) * 9216, qf, p0, p1, lane);
            const int nrel = nvalid - 64 * T - 4 * hh;
#pragma unroll
            for (int r = 0; r < 16; ++r) { const int c0 = crow_c(r);
                p0[r] = (c0 < nrel) ? __builtin_amdgcn_exp2f(p0[r] * SM_C - m) * invl : 0.f; p1[r] = (c0 + 32 < nrel) ? __builtin_amdgcn_exp2f(p1[r] * SM_C - m) * invl : 0.f; }
            float g4[8], last[8], oth[8];
#pragma unroll
            for (int i = 0; i < 8; ++i) { const int r0 = 4 * (i & 3); if (i < 4) { g4[i] = (p0[r0] + p0[r0 + 1]) + (p0[r0 + 2] + p0[r0 + 3]); last[i] = p0[r0 + 3]; } else { g4[i] = (p1[r0] + p1[r0 + 1]) + (p1[r0 + 2] + p1[r0 + 3]); last[i] = p1[r0 + 3]; } }
#pragma unroll
            for (int i = 0; i < 8; ++i) oth[i] = __shfl_xor(last[i], 32);
#pragma unroll
            for (int i = 0; i < 8; ++i) { const float add = hh ? oth[i] : (i ? oth[i > 0 ? i - 1 : 0] : carry); slab[(w * 32 + q) * 64 + 16 * T + 2 * i + hh] = g4[i] + add; }
            carry = oth[7];
          }
          __syncthreads(); }
        {
            const int J = lane; const bool cand = (J >= 1) && (J <= cur - 2); const bool forced = (J <= cur) && (J == 0 || J >= cur - 1);
            const unsigned long long candm = __ballot(cand ? 1 : 0), forcedm = __ballot(forced ? 1 : 0);
            unsigned vb[4]; unsigned long long selq[4];
#pragma unroll
            for (int qq = 0; qq < 4; ++qq) { const int qi = 4 * w + qq; float v = 0.f;
#pragma unroll
                for (int w2 = 0; w2 < 8; ++w2) v += slab[(w2 * 32 + qi) * 64 + J];
                vb[qq] = cand ? __float_as_uint(v) : 0u; selq[qq] = candm; }
            if (cur - 2 > 13) {
                unsigned th[4] = {0u, 0u, 0u, 0u};
#pragma unroll 1
                for (int bit = 30; bit >= 0; --bit) {
#pragma unroll
                    for (int qq = 0; qq < 4; ++qq) { const unsigned trial = th[qq] | (1u << bit); const unsigned long long mm = __ballot((vb[qq] >= trial) ? 1 : 0) & candm; th[qq] = (__popcll(mm) >= 13) ? trial : th[qq]; }
                }
                const unsigned long long below = (lane == 0) ? 0ull : (~0ull >> (64 - lane));
#pragma unroll
                for (int qq = 0; qq < 4; ++qq) { const unsigned long long mgt = __ballot((vb[qq] > th[qq]) ? 1 : 0) & candm, meq = __ballot((vb[qq] == th[qq]) ? 1 : 0) & candm;
                    const int need = 13 - __popcll(mgt), rank = __popcll(meq & below);
                    selq[qq] = __ballot((cand && (vb[qq] > th[qq] || (vb[qq] == th[qq] && rank < need))) ? 1 : 0); }
            }
#pragma unroll
            for (int qq = 0; qq < 4; ++qq) { const unsigned long long mk = selq[qq] | forcedm;
                if (lane == 0) { selmp[4 * w + qq] = mk; atomicOr((unsigned*)&unionp[0], (unsigned)mk); atomicOr((unsigned*)&unionp[1], (unsigned)(mk >> 32)); } }
        }
        __syncthreads();
        const unsigned long long selm = selmp[q];
        const unsigned ulo = __builtin_amdgcn_readfirstlane(unionp[0]), uhi = __builtin_amdgcn_readfirstlane(unionp[1]);
        const unsigned long long uni = ((unsigned long long)uhi << 32) | ulo;
        m = -1e30f; l = 0.f; o0 = (f32x16){}; o1 = (f32x16){};
        run_branch<1>(lds, ws + WS_KS + (size_t)bg * 524288, ws + WS_VST + (size_t)bg * 524288, uni, qf, m, l, o0, o1, cur, tq, 0, selm, tid, lane);
        { l += __shfl_xor(l, 32); const float f = gs / l; out0 += o0 * f; out1 += o1 * f; }
        m = -1e30f; l = 0.f; o0 = (f32x16){}; o1 = (f32x16){};
        { const int j0 = cur - 8 > 0 ? cur - 8 : 0; const unsigned long long wm = ((cur == 63) ? ~0ull : ((1ull << (cur + 1)) - 1ull)) & ~((1ull << j0) - 1ull);
          run_branch<2>(lds, ws + WS_KW + (size_t)bg * 524288, ws + WS_VWT + (size_t)bg * 524288, wm, qf, m, l, o0, o1, cur, tq, 0, 0ull, tid, lane); }
        { l += __shfl_xor(l, 32); const float f = gwn / l; out0 += o0 * f; out1 += o1 * f; }
#pragma unroll
        for (int i = 0; i < 4; ++i) {
            u32x2 a0, a1; a0.x = cvt_pk_bf16(out0[4 * i], out0[4 * i + 1]); a0.y = cvt_pk_bf16(out0[4 * i + 2], out0[4 * i + 3]); a1.x = cvt_pk_bf16(out1[4 * i], out1[4 * i + 1]); a1.y = cvt_pk_bf16(out1[4 * i + 2], out1[4 * i + 3]);
            bf16_t* yp = (bf16_t*)((unsigned char*)qp + yoff); *(u32x2*)(yp + 8 * i + 4 * hh) = a0; *(u32x2*)(yp + 32 + 8 * i + 4 * hh) = a1;
        }
    }
}

constexpr int NPHASE = 8 * DEPTH + 3;
#ifndef ONLY_MASK
#define ONLY_MASK 0xffff
#endif
#define HAS(k) ((ONLY_MASK >> (k)) & 1)
__global__ void __launch_bounds__(512, 2) mega_fwd(Args a) {
    extern __shared__ __attribute__((aligned(16))) unsigned char lds_raw[];
    Ctx C; C.lds = (LAS unsigned char*)lds_raw; C.ws = a.ws; C.tid = threadIdx.x; C.lane = C.tid & 63; C.wave = __builtin_amdgcn_readfirstlane(C.tid >> 6);
    C.G = gridDim.x; C.bx = blockIdx.x; C.gw = C.bx * 8 + C.wave; C.NGW = C.G * 8;
    cg::grid_group grid = cg::this_grid();
    { volatile LAS unsigned* st = (volatile LAS unsigned*)(C.lds + LDS_BYTES - 64); if (C.tid < 16) st[C.tid] = 0u; __syncthreads(); }
    XcdBarrier xbar = xcd_barrier_post((unsigned*)(a.ws + WS_BAR), (volatile LAS unsigned*)(C.lds + LDS_BYTES - 64));
    unsigned char* ws = a.ws; float* X = a.out;
    int ph = 0;
#define IN_PH() (ph >= a.ph_lo && ph < a.ph_hi)
#define FRESH() do { int t_ = threadIdx.x; asm volatile("" : "+v"(t_)); C.tid = t_; C.lane = t_ & 63; C.wave = __builtin_amdgcn_readfirstlane(t_ >> 6); C.gw = C.bx * 8 + C.wave; \
    unsigned wl_ = __builtin_amdgcn_readfirstlane((unsigned)(unsigned long long)a.ws), wh_ = __builtin_amdgcn_readfirstlane((unsigned)((unsigned long long)a.ws >> 32)); asm volatile("" : "+s"(wl_), "+s"(wh_)); \
    ws = (unsigned char*)(GAS1 unsigned char*)(((unsigned long long)wh_ << 32) | wl_); C.ws = ws; \
    unsigned xl_ = __builtin_amdgcn_readfirstlane((unsigned)(unsigned long long)a.out), xh_ = __builtin_amdgcn_readfirstlane((unsigned)((unsigned long long)a.out >> 32)); asm volatile("" : "+s"(xl_), "+s"(xh_)); \
    X = (float*)(GAS1 float*)(((unsigned long long)xh_ << 32) | xl_); } while (0)
#define SEAM() do { ++ph; if (ph > a.ph_lo && ph < a.ph_hi) { if (ph == 1) grid.sync(); else xcd_barrier(xbar); } FRESH(); } while (0)
    FRESH();
    if (HAS(0) && IN_PH()) ph_prologue(a, C);
    SEAM();
    if (IN_PH() && C.bx < 8 * DEPTH) {
        const int l = C.bx >> 3; unsigned char* wl = ws + WS_W + (size_t)l * WL_STRIDE;
        EpiP<OpBf16> E{OpBf16{(bf16_t*)(ws + WS_PPF) + (size_t)l * 1024 * 512, 512}, nullptr};
        run_gemm(C.lds, (const bf16_t*)(wl + W_PP), 512, (const bf16_t*)(wl + W_POOL), 1024, 512, 512, E, 8, C.bx & 7);
    }
    SEAM();
    for (int l = 0; l < DEPTH; ++l) {
        const float* xin = (l == 0) ? AIN(a, 0) : X;
        unsigned char* wl = ws + WS_W + (size_t)l * WL_STRIDE;
        if (HAS(1) && IN_PH()) {
            EpiP<OpProj, true> E{OpProj{ws}, (const float*)(ws + WS_SS)};
            run_gemm(C.lds, (const bf16_t*)(ws + WS_XN), 1024, (const bf16_t*)(wl + W_IN), MTOK, NPAD, 1024, E, C.G, C.bx);
        }
        SEAM();
        if (IN_PH()) {
            const int ncc = (C.G >= 64) ? 32 : 0;
            if (HAS(2) && (ncc == 0 || C.bx >= ncc)) ph_post(C, false, (C.bx - ncc) * 8 + C.wave, (C.G - ncc) * 8, (bf16_t*)X);
            FRESH(); wl = ws + WS_W + (size_t)l * WL_STRIDE;
            if (HAS(4) && (ncc == 0 || C.bx < 16)) { EpiP<OpCmp1> E{OpCmp1{(bf16_t*)(ws + WS_HIDK), (const float*)(ws + WS_CBIAS) + l * 512}, nullptr}; run_gemm(C.lds, (const bf16_t*)(ws + WS_KC), 1024, (const bf16_t*)(wl + W_CK1), 4096, 256, 2048, E, ncc ? 16 : C.G, C.bx); }
            FRESH(); wl = ws + WS_W + (size_t)l * WL_STRIDE;
            if (HAS(5) && (ncc == 0 || (C.bx >= 16 && C.bx < 32))) { EpiP<OpCmp1> E{OpCmp1{(bf16_t*)(ws + WS_HIDV), (const float*)(ws + WS_CBIAS) + l * 512 + 256}, nullptr}; run_gemm(C.lds, (const bf16_t*)(ws + WS_VC), 1024, (const bf16_t*)(wl + W_CV1), 4096, 256, 2048, E, ncc ? 16 : C.G, ncc ? C.bx - 16 : C.bx); }
        }
        SEAM();
        wl = ws + WS_W + (size_t)l * WL_STRIDE;
        if (IN_PH()) {
            FRESH();
            if (HAS(6)) ph_cmp2(C, l);
        }
        SEAM();
        if (HAS(7) && IN_PH()) ph_attn(C, 0);
        SEAM();
        wl = ws + WS_W + (size_t)l * WL_STRIDE;
        if (IN_PH()) {
            if (HAS(8)) { EpiP<OpMerge1> E{OpMerge1{ws + WS_GM, (bf16_t*)(ws + WS_GM + 64 * MiB)}, nullptr}; run_gemm(C.lds, (const bf16_t*)X, 512, (const bf16_t*)(ws + WS_PPF) + (size_t)l * 1024 * 512, MTOK, 1024, 512, E, C.G, C.bx); }
            FRESH(); wl = ws + WS_W + (size_t)l * WL_STRIDE;
            if (HAS(9)) { EpiP<OpMerge2> E{OpMerge2{ws + WS_GM, (bf16_t*)(ws + WS_GM + 64 * MiB)}, nullptr}; run_gemm(C.lds, (const bf16_t*)(ws + WS_Q), 1024, (const bf16_t*)(wl + W_PN), MTOK, 1024, 1024, E, C.G, C.bx); }
        }
        SEAM();
        wl = ws + WS_W + (size_t)l * WL_STRIDE;
        if (HAS(10) && IN_PH()) { EpiResid E{(bf16_t*)(ws + WS_XN), (float*)(ws + WS_SS)}; run_gemm(C.lds, (const bf16_t*)(ws + WS_GM + 64 * MiB), 1024, (const bf16_t*)(wl + W_OUT), MTOK, 1024, 1024, E, C.G, C.bx); }
        SEAM();
        wl = ws + WS_W + (size_t)l * WL_STRIDE;
        if (HAS(11) && IN_PH()) { EpiP<OpFF1, true> E{OpFF1{(bf16_t*)(ws + WS_H)}, (const float*)(ws + WS_SS)}; run_gemm(C.lds, (const bf16_t*)(ws + WS_XN), 1024, (const bf16_t*)(wl + W_FF1), MTOK, DFF, 1024, E, C.G, C.bx); }
        SEAM();
        wl = ws + WS_W + (size_t)l * WL_STRIDE;
        if (HAS(12) && IN_PH()) { EpiResid E{(bf16_t*)(ws + WS_XN), (float*)(ws + WS_SS)}; run_gemm(C.lds, (const bf16_t*)(ws + WS_H), 4096, (const bf16_t*)(wl + W_FF2), MTOK, 1024, DFF, E, C.G, C.bx); }
        SEAM();
    }
    if (IN_PH()) { for (int m = C.gw; m < MTOK; m += C.NGW) rms_row_out((const bf16_t*)(ws + WS_XN) + (size_t)m * 1024, AIN(a, 17), X + (size_t)m * 1024, C.lane); }
#undef IN_PH
#undef SEAM
}

#ifndef MK_PER_PHASE
#define MK_PER_PHASE 0
#endif
extern "C" void kernel_launch(void* const* d_in, const int* in_sizes, int n_in, void* d_out, int out_size, void* d_ws, size_t ws_size, hipStream_t stream) {
    static int grid = 0;
    if (grid == 0) {
        if (n_in != 18 || out_size != MTOK * DM || ws_size < WS_END) { fprintf(stderr, "kernel_launch: unexpected shapes (n_in %d out %d ws %zu)\n", n_in, out_size, ws_size); grid = -1; return; }
        int dev = 0, cus = 0, per_cu = 0;
        (void)hipGetDevice(&dev); (void)hipDeviceGetAttribute(&cus, hipDeviceAttributeMultiprocessorCount, dev);
        if (hipFuncSetAttribute((const void*)mega_fwd, hipFuncAttributeMaxDynamicSharedMemorySize, LDS_BYTES) != hipSuccess) { fprintf(stderr, "kernel_launch: hipFuncSetAttribute failed\n"); grid = -1; return; }
        if (hipOccupancyMaxActiveBlocksPerMultiprocessor(&per_cu, (const void*)mega_fwd, 512, LDS_BYTES) != hipSuccess || per_cu < 1) { fprintf(stderr, "kernel_launch: occupancy query %d\n", per_cu); per_cu = 1; }
        (void)hipGetLastError();
        grid = cus * (per_cu > 1 ? 1 : per_cu);
        if (grid <= 0) grid = 256;
    }
    if (grid < 0) return;
    Args a{};
    for (int i = 0; i < 18; ++i) a.in[i] = (const float*)d_in[i];
    a.out = (float*)d_out; a.ws = (unsigned char*)d_ws;
    for (int i = 0; i < 32; ++i) a.invf[i] = pow(10000.0, -(double)(2 * i) / 64.0);
#if MK_PER_PHASE
    for (int p = 0; p < NPHASE; ++p) { a.ph_lo = p; a.ph_hi = p + 1; hipLaunchKernelGGL(mega_fwd, dim3(grid), dim3(512), LDS_BYTES, stream, a); }
#else
    a.ph_lo = 0; a.ph_hi = NPHASE;
    (void)hipMemsetAsync((unsigned char*)d_ws + WS_BAR, 0, 16384, stream);
    void* args[] = {&a};
    hipError_t e = hipLaunchCooperativeKernel((const void*)mega_fwd, dim3(grid), dim3(512), args, LDS_BYTES, stream);
    if (e != hipSuccess) fprintf(stderr, "cooperative launch failed: %s (grid %d)\n", hipGetErrorString(e), grid);
#endif
}
```

```cpp
#include <hip/hip_runtime.h>
#include <hip/hip_cooperative_groups.h>
#include <cstdio>
#include <cstdint>
#include <cmath>
#include <type_traits>
namespace cg = cooperative_groups;
namespace pg8 {
#define PG8_LAS __attribute__((address_space(3)))
typedef unsigned short bf16_t;
typedef short bf16x8 __attribute__((ext_vector_type(8)));
typedef float f32x4 __attribute__((ext_vector_type(4)));
typedef unsigned u32x4 __attribute__((ext_vector_type(4)));
constexpr int BM = 256, BK = 64, HALF = 128, HTB = HALF * BK * 2  , STAGE_BYTES = 8 * HTB, NXCD = 8, WGM = 8;

__host__ __device__ __forceinline__ int lds_byte(int r, int c) { const int st = (r >> 4) * 2 + (c >> 5), rr = r & 15, cc = c & 31, ob = rr * 64 + cc * 2; return st * 1024 + (ob ^ (((ob >> 9) & 1) << 5)); }
__host__ __device__ __forceinline__ void stage_rc(int b, int& R, int& C) { const int st = b / 1024, sb = b % 1024, swz = sb ^ (((sb >> 9) & 1) << 5); R = (st >> 1) * 16 + swz / 64; C = (st & 1) * 32 + (swz % 64) / 2; }
__host__ __device__ __forceinline__ int perm32(int rho) { const int n = rho >> 4, i = rho & 15; return 8 * (i >> 2) + 4 * n + (i & 3); }

struct Unit { int pm, pn; };
struct Gemm { const bf16_t* A; const bf16_t* Bt; int M, N, K, lda; };

struct StaticOrder {
    int nM, nN, nwg, G, c;
    __host__ __device__ void init(int M, int N, int G_, int c_) { nM = M / BM; nN = N / BM; nwg = nM * nN; G = G_; c = c_; }
    __host__ __device__ bool next(int i, Unit& u) const {
        const long L = (long)i * G + c; if (L >= nwg) return false;
        int wgid = (int)L; { const int q = nwg / NXCD, r = nwg % NXCD, xcd = wgid % NXCD, off = wgid / NXCD; wgid = (xcd < r ? xcd * (q + 1) : r * (q + 1) + (xcd - r) * q) + off; }
        const int nig = WGM * nN, gid = wgid / nig, fm = gid * WGM, gsz = (nM - fm) < WGM ? (nM - fm) : WGM;
        u.pm = fm + ((wgid % nig) % gsz); u.pn = (wgid % nig) / gsz; return true;
    }
    __device__ __forceinline__ void a_ready(const Unit&) const {}
    __device__ __forceinline__ void done(const Unit&) const {}
};

__device__ __forceinline__ unsigned cvt_pk_bf16(float lo, float hi) { unsigned r; asm volatile("v_cvt_pk_bf16_f32 %0, %1, %2" : "=v"(r) : "v"(lo), "v"(hi)); return r; }
typedef float f32x2 __attribute__((ext_vector_type(2)));
template <class Epi, class Sched, bool ALIGN_EPI = false, bool SP2 = false>
__device__ __forceinline__ void gemm_phase(PG8_LAS unsigned char* lds, const Gemm g, const Sched& S, const Epi& E) {
    int tid_ = threadIdx.x; asm volatile("" : "+v"(tid_));
    const int tid = tid_, wid = __builtin_amdgcn_readfirstlane(tid >> 6), lane = tid & 63, wr = wid >> 2, wc = wid & 3, fr = lane & 15, fq = lane >> 4;
    const int K = g.K, nt = K / BK;
    unsigned voffA[2], voffB[2];
#pragma unroll
    for (int i = 0; i < 2; ++i) { int R, C; stage_rc(tid * 16 + i * 8192, R, C); const int Rb = Epi::PERM ? ((R & ~31) + perm32(R & 31)) : R;
        voffA[i] = (unsigned)(R * g.lda + C) * 2u; voffB[i] = (unsigned)(Rb * K + C) * 2u; }
    const size_t kstep = (size_t)(BK * 2);
    const size_t hstepB = (size_t)HALF * K * 2, hstepA = (size_t)HALF * g.lda * 2;
    const size_t tstepA = 2 * hstepA, tstepB = 2 * hstepB;
    const unsigned ldsw = (unsigned)wid * 1024u;
    const int aoff = lds_byte(wr * 64 + fr, fq * 8), boff = lds_byte(wc * 32 + fr, fq * 8);
#define PG8_SA(b, h) (((b) * 2 + (h)) * HTB)
#define PG8_SB(b, h) ((4 + (b) * 2 + (h)) * HTB)
#define PG8_STAGE(bufoff, gbase, voff) do { _Pragma("unroll") for (int _i = 0; _i < 2; ++_i) \
        __builtin_amdgcn_global_load_lds((const unsigned*)((const char*)(gbase) + (voff)[_i]), (PG8_LAS unsigned*)(lds + (bufoff) + ldsw + _i * 8192), 16, 0, 0); } while (0)
#define PG8_LDA(dst, b, h) do { _Pragma("unroll") for (int m = 0; m < 4; ++m) _Pragma("unroll") for (int k = 0; k < 2; ++k) dst[m][k] = *(const PG8_LAS bf16x8*)(lds + PG8_SA(b, h) + aoff + m * 2048 + k * 1024); } while (0)
#define PG8_LDB(dst, b, h) do { _Pragma("unroll") for (int n = 0; n < 2; ++n) _Pragma("unroll") for (int k = 0; k < 2; ++k) dst[n][k] = *(const PG8_LAS bf16x8*)(lds + PG8_SB(b, h) + boff + n * 2048 + k * 1024); } while (0)
#define PG8_MMA(ai, bj, At, Bt) do { __builtin_amdgcn_s_setprio(1); _Pragma("unroll") for (int m = 0; m < 4; ++m) _Pragma("unroll") for (int n = 0; n < 2; ++n) _Pragma("unroll") for (int k = 0; k < 2; ++k) \
        acc[ai][bj][m][n] = __builtin_amdgcn_mfma_f32_16x16x32_bf16(Bt[n][k], At[m][k], acc[ai][bj][m][n], 0, 0, 0); __builtin_amdgcn_s_setprio(0); } while (0)
#define PG8_WAIT_V(n) asm volatile("s_waitcnt vmcnt(" #n ")" ::: "memory")
#define PG8_WAIT_L(n) asm volatile("s_waitcnt lgkmcnt(" #n ")" ::: "memory")
#define PG8_BAR __builtin_amdgcn_s_barrier()
#define PG8_SCHED __builtin_amdgcn_sched_barrier(0)
    Unit cur, nxt; int ui = 0;
    if (!S.next(0, cur)) return;
    f32x4 acc[2][2][4][2];
#pragma unroll
    for (int a = 0; a < 2; ++a)
#pragma unroll
        for (int b = 0; b < 2; ++b)
#pragma unroll
            for (int m = 0; m < 4; ++m)
#pragma unroll
                for (int n = 0; n < 2; ++n) acc[a][b][m][n] = (f32x4){0.f, 0.f, 0.f, 0.f};
    bf16x8 At[4][2], B0[2][2], B1[2][2];
    const char* cA = (const char*)g.A + (size_t)cur.pm * tstepA; const char* cB = (const char*)g.Bt + (size_t)cur.pn * tstepB;
    S.a_ready(cur);
    if constexpr (SP2) {
        PG8_STAGE(PG8_SB(0, 0), cB, voffB); PG8_STAGE(PG8_SB(0, 1), cB + hstepB, voffB); PG8_STAGE(PG8_SA(0, 0), cA, voffA); PG8_STAGE(PG8_SA(0, 1), cA + hstepA, voffA);
        if (wr == 1) PG8_BAR;
        PG8_WAIT_V(2); PG8_BAR;
        PG8_STAGE(PG8_SB(1, 0), cB + kstep, voffB); PG8_STAGE(PG8_SA(1, 0), cA + kstep, voffA); PG8_STAGE(PG8_SB(1, 1), cB + hstepB + kstep, voffB);
        PG8_WAIT_V(6); PG8_BAR;
    } else {
        PG8_STAGE(PG8_SB(0, 0), cB, voffB); PG8_STAGE(PG8_SA(0, 0), cA, voffA); PG8_STAGE(PG8_SB(0, 1), cB + hstepB, voffB); PG8_STAGE(PG8_SA(0, 1), cA + hstepA, voffA);
        if (wr == 1) PG8_BAR;
        PG8_WAIT_V(4); PG8_BAR;
        PG8_STAGE(PG8_SB(1, 0), cB + kstep, voffB); PG8_STAGE(PG8_SA(1, 0), cA + kstep, voffA); PG8_STAGE(PG8_SB(1, 1), cB + hstepB + kstep, voffB);
        PG8_WAIT_V(6); PG8_BAR;
    }
    for (;;) {
        const bool has_next = S.next(ui + 1, nxt);
        const char* nA = has_next ? (const char*)g.A + (size_t)nxt.pm * tstepA : cA; const char* nB = has_next ? (const char*)g.Bt + (size_t)nxt.pn * tstepB : cB;
        for (int t = 0; t < nt; t += 2) {
            const bool last = (t == nt - 2);
            const char* a1 = cA + (size_t)(t + 1) * kstep;
            const char* a2 = last ? nA : cA + (size_t)(t + 2) * kstep; const char* b2 = last ? nB : cB + (size_t)(t + 2) * kstep;
            const char* a3 = a2 + kstep; const char* b3 = b2 + kstep;
            if (last && has_next) S.a_ready(nxt);
            if constexpr (SP2) {
            PG8_LDB(B0, 0, 0); PG8_LDB(B1, 0, 1); PG8_SCHED; PG8_LDA(At, 0, 0); PG8_STAGE(PG8_SA(1, 1), a1 + hstepA, voffA);
            PG8_WAIT_V(8); PG8_WAIT_L(0); PG8_BAR; PG8_MMA(0, 0, At, B0); PG8_MMA(0, 1, At, B1); PG8_BAR; PG8_SCHED;
            PG8_LDA(At, 0, 1); PG8_STAGE(PG8_SB(0, 0), b2, voffB); PG8_STAGE(PG8_SB(0, 1), b2 + hstepB, voffB); PG8_STAGE(PG8_SA(0, 0), a2, voffA);
            PG8_WAIT_V(8); PG8_WAIT_L(0); PG8_BAR; PG8_MMA(1, 0, At, B0); PG8_MMA(1, 1, At, B1); PG8_BAR; PG8_SCHED;
            PG8_LDB(B0, 1, 0); PG8_LDB(B1, 1, 1); PG8_SCHED; PG8_LDA(At, 1, 0); PG8_STAGE(PG8_SA(0, 1), a2 + hstepA, voffA);
            PG8_WAIT_V(8); PG8_WAIT_L(0); PG8_BAR; PG8_MMA(0, 0, At, B0); PG8_MMA(0, 1, At, B1); PG8_BAR; PG8_SCHED;
            PG8_LDA(At, 1, 1); PG8_STAGE(PG8_SB(1, 0), b3, voffB); PG8_STAGE(PG8_SB(1, 1), b3 + hstepB, voffB); PG8_STAGE(PG8_SA(1, 0), a3, voffA);
            PG8_WAIT_V(8); PG8_WAIT_L(0); PG8_BAR; PG8_MMA(1, 0, At, B0); PG8_MMA(1, 1, At, B1); PG8_BAR; PG8_SCHED;
            } else {
            PG8_LDB(B0, 0, 0); PG8_SCHED; PG8_LDA(At, 0, 0); PG8_STAGE(PG8_SA(1, 1), a1 + hstepA, voffA);
            PG8_WAIT_L(8); PG8_BAR; PG8_WAIT_L(0); PG8_MMA(0, 0, At, B0); PG8_BAR; PG8_SCHED;
            PG8_LDB(B1, 0, 1); PG8_STAGE(PG8_SB(0, 0), b2, voffB);
            PG8_BAR; PG8_WAIT_L(0); PG8_MMA(0, 1, At, B1); PG8_BAR;
            PG8_LDA(At, 0, 1); PG8_STAGE(PG8_SA(0, 0), a2, voffA);
            PG8_BAR; PG8_WAIT_L(0); PG8_MMA(1, 0, At, B0); PG8_BAR; PG8_SCHED;
            PG8_STAGE(PG8_SB(0, 1), b2 + hstepB, voffB);
            PG8_WAIT_V(6); PG8_BAR; PG8_MMA(1, 1, At, B1); PG8_BAR;
            PG8_LDB(B0, 1, 0); PG8_SCHED; PG8_LDA(At, 1, 0); PG8_STAGE(PG8_SA(0, 1), a2 + hstepA, voffA);
            PG8_WAIT_L(8); PG8_BAR; PG8_WAIT_L(0); PG8_MMA(0, 0, At, B0); PG8_BAR; PG8_SCHED;
            PG8_LDB(B1, 1, 1); PG8_STAGE(PG8_SB(1, 0), b3, voffB);
            PG8_BAR; PG8_WAIT_L(0); PG8_MMA(0, 1, At, B1); PG8_BAR;
            PG8_LDA(At, 1, 1); PG8_STAGE(PG8_SA(1, 0), a3, voffA);
            PG8_BAR; PG8_WAIT_L(0); PG8_MMA(1, 0, At, B0); PG8_BAR; PG8_SCHED;
            PG8_STAGE(PG8_SB(1, 1), b3 + hstepB, voffB);
            PG8_WAIT_V(6); PG8_BAR; PG8_MMA(1, 1, At, B1); PG8_BAR;
            }
        }
        if constexpr (ALIGN_EPI) { if (wr == 0) PG8_BAR; }
        if constexpr (!Epi::AFTER_DRAIN) { E(acc, cur, wr, wc, fr, fq); S.done(cur); }
        if (!has_next) break;
#pragma unroll
        for (int a = 0; a < 2; ++a)
#pragma unroll
            for (int b = 0; b < 2; ++b)
#pragma unroll
                for (int m = 0; m < 4; ++m)
#pragma unroll
                    for (int n = 0; n < 2; ++n) acc[a][b][m][n] = (f32x4){0.f, 0.f, 0.f, 0.f};
        cur = nxt; cA = nA; cB = nB; ++ui;
        if constexpr (ALIGN_EPI) { if (wr == 1) PG8_BAR; }
    }
    PG8_WAIT_V(0);
    if constexpr (!ALIGN_EPI) { if (wr == 0) PG8_BAR; }
    PG8_BAR;
    if constexpr (Epi::AFTER_DRAIN) { E.fused(acc, cur, wr, wc, fr, fq, lds, wid, lane); S.done(cur); }
#undef PG8_SA
#undef PG8_SB
#undef PG8_STAGE
#undef PG8_LDA
#undef PG8_LDB
#undef PG8_MMA
#undef PG8_WAIT_V
#undef PG8_WAIT_L
#undef PG8_BAR
#undef PG8_SCHED
}
}
#define LAS __attribute__((address_space(3)))
#define XB_TMO      128
#define XB_XCNT(j)  (256  + 64 * (j))
#define XB_XSUB(j)  (1280 + 64 * (j))
#define XB_XGEN(j)  (2304 + 64 * (j))
#define XB_TOP      3328
#define XB_TOPGEN   3392
#define XCD_BAR_WORDS 3456
#define XB_SPIN_CAP (1u << 18)

__device__ __forceinline__ unsigned xb_ld(unsigned* p)              { return __hip_atomic_load(p, __ATOMIC_RELAXED, __HIP_MEMORY_SCOPE_AGENT); }
__device__ __forceinline__ unsigned xb_add(unsigned* p, unsigned v) { return __hip_atomic_fetch_add(p, v, __ATOMIC_RELAXED, __HIP_MEMORY_SCOPE_AGENT); }
__device__ __forceinline__ unsigned xb_xcc_id() { return (unsigned)__builtin_amdgcn_s_getreg((3 << 11) | 20) & 0xFu; }
#define XB_SPIN(cond, bar) do { unsigned _sp = 0; while (cond) { __builtin_amdgcn_s_sleep(1); \
    if ((++_sp & 255u) == 0u) { if (xb_ld(&(bar)[XB_TMO])) break; if (_sp > XB_SPIN_CAP) { atomicAdd(&(bar)[XB_TMO], 1u); break; } } } } while (0)

struct XcdBarrier {
    unsigned* bar; unsigned x;
    volatile LAS unsigned* st;
};

__device__ __forceinline__ XcdBarrier xcd_barrier_post(unsigned* bar, volatile LAS unsigned* st) {
    XcdBarrier b; b.bar = bar; b.x = xb_xcc_id(); b.st = st;
    if (threadIdx.x == 0) (void)xb_add(&bar[XB_XCNT(b.x)], 1u);
    return b;
}
__device__ __forceinline__ void xcd_barrier_complete(unsigned* bar, unsigned x, unsigned& nloc, unsigned& nx) {
    const unsigned G = gridDim.x * gridDim.y * gridDim.z;
    unsigned sum, cnt, mine, sp = 0u;
    for (;;) {
        sum = 0u; cnt = 0u; mine = 0u;
#pragma unroll
        for (unsigned j = 0; j < 16; ++j) { const unsigned c = xb_ld(&bar[XB_XCNT(j)]); sum += c; cnt += (c > 0u) ? 1u : 0u; mine = (j == x) ? c : mine; }
        if (sum == G) break;
        __builtin_amdgcn_s_sleep(1);
        if ((++sp & 255u) == 0u) { if (xb_ld(&bar[XB_TMO])) break; if (sp > XB_SPIN_CAP) { atomicAdd(&bar[XB_TMO], 1u); break; } }
    }
    nloc = mine > 0u ? mine : 1u; nx = cnt > 0u ? cnt : 1u;
}

__device__ __forceinline__ void xcd_barrier(const XcdBarrier& b) {
    asm volatile("s_waitcnt vmcnt(0)" ::: "memory");
    __syncthreads();
    if (threadIdx.x == 0) {
        unsigned* bar = b.bar;
        __builtin_amdgcn_s_waitcnt(0);
        unsigned nloc = b.st[0], nx = b.st[1];
        if (nloc == 0u) { xcd_barrier_complete(bar, b.x, nloc, nx); b.st[0] = nloc; b.st[1] = nx; }
        const unsigned old = xb_add(&bar[XB_XSUB(b.x)], 1u);
        const unsigned gen = old / nloc;
        if (old + 1u == (gen + 1u) * nloc) {
            __builtin_amdgcn_fence(__ATOMIC_RELEASE, "agent");
            asm volatile("s_waitcnt vmcnt(0)" ::: "memory");
            const unsigned og = xb_add(&bar[XB_TOP], 1u);
            const unsigned tg = og / nx;
            if (og + 1u == (tg + 1u) * nx) xb_add(&bar[XB_TOPGEN], 1u);
            else XB_SPIN(xb_ld(&bar[XB_TOPGEN]) == tg, bar);
            __builtin_amdgcn_fence(__ATOMIC_ACQUIRE, "agent");
            xb_add(&bar[XB_XGEN(b.x)], 1u);
            asm volatile("s_waitcnt vmcnt(0)" ::: "memory");
        } else {
            XB_SPIN(xb_ld(&bar[XB_XGEN(b.x)]) == gen, bar);
            __builtin_amdgcn_fence(__ATOMIC_ACQUIRE, "agent");
            asm volatile("s_waitcnt vmcnt(0)" ::: "memory");
        }
    }
    __syncthreads();
}
#undef LAS
using namespace pg8;
#define LAS __attribute__((address_space(3)))
typedef float f32x16 __attribute__((ext_vector_type(16)));
typedef unsigned u32x2 __attribute__((ext_vector_type(2)));
#define LDS_WAIT() asm volatile("s_waitcnt lgkmcnt(0)" ::: "memory")

constexpr int DM = 1024, NBATCH = 8, SEQ = 4096, MTOK = NBATCH * SEQ, DEPTH = 4, NIN = 4400, NPAD = 4608, DFF = 4096;
constexpr size_t MiB = 1u << 20;
constexpr size_t WS_ROPEC = 0, WS_ROPES = 512 * 1024, WS_CBIAS = 1 * MiB, WS_BAR = 1 * MiB + 64 * 1024;
constexpr size_t WS_W = 2 * MiB, WL_STRIDE = 33 * MiB;
constexpr size_t W_IN = 0, W_POOL = 9 * MiB, W_CK1 = W_POOL + MiB / 2, W_CV1 = W_CK1 + MiB, W_PP = W_CV1 + MiB, W_PN = W_PP + MiB,
                 W_OUT = W_PN + 2 * MiB, W_FF1 = W_OUT + 2 * MiB, W_FF2 = W_FF1 + 8 * MiB, W_CK2 = W_FF2 + 8 * MiB, W_CV2 = W_CK2 + 32 * 1024;
constexpr size_t WS_SS = 134 * MiB;
constexpr size_t WS_XN = 136 * MiB;
constexpr size_t WS_CK = 200 * MiB, WS_CVT = WS_CK + MiB / 2, WS_HIDK = 201 * MiB, WS_HIDV = 203 * MiB;
constexpr size_t WS_U = 206 * MiB, WS_Q = 238 * MiB, WS_KC = 302 * MiB, WS_VC = 310 * MiB, WS_KS = 318 * MiB, WS_VS = 326 * MiB, WS_KW = 334 * MiB,
                 WS_VW = 342 * MiB, WS_VST = 350 * MiB, WS_VWT = 358 * MiB, WS_GNSA = 366 * MiB, WS_GM = 370 * MiB;
constexpr size_t WS_H = 206 * MiB;
constexpr size_t WS_PPF = 500 * MiB;
constexpr size_t WS_END = 504 * MiB;
constexpr int LDS_BYTES = 135168;

__device__ __forceinline__ int launder_s(int i) { i = __builtin_amdgcn_readfirstlane(i); asm volatile("" : "+s"(i)); return i; }
#define GAS1 __attribute__((address_space(1)))
#define AIN(a, i) ((const float*)(const GAS1 float*)((a).in[launder_s(i)]))
struct Args { const float* in[18]; float* out; unsigned char* ws; double invf[32]; int ph_lo, ph_hi; };

__device__ __forceinline__ float bf2f(unsigned short u) { return __uint_as_float((unsigned)u << 16); }
__device__ __forceinline__ float bflo(unsigned w) { return __uint_as_float(w << 16); }
__device__ __forceinline__ float bfhi(unsigned w) { return __uint_as_float(w & 0xffff0000u); }
__device__ __forceinline__ unsigned short f2bf(float f) { return (unsigned short)(cvt_pk_bf16(f, f) & 0xffffu); }
__device__ __forceinline__ float wave_sum(float v) {
#pragma unroll
    for (int o = 1; o < 64; o <<= 1) v += __shfl_xor(v, o);
    return v;
}
__device__ __forceinline__ float sigmoidf_(float x) { return __builtin_amdgcn_rcpf(1.0f + __builtin_amdgcn_exp2f(-1.4426950408889634f * x)); }
__device__ __forceinline__ f32x4 sigmoid4(f32x4 v) { return (f32x4){sigmoidf_(v[0]), sigmoidf_(v[1]), sigmoidf_(v[2]), sigmoidf_(v[3])}; }
__device__ __forceinline__ float gelu_tanh(float x) {
    const float y = 0.7978845608028654f * (x + 0.044715f * x * x * x);
    const float e = __builtin_amdgcn_exp2f(2.0f * 1.4426950408889634f * y);
    const float th = 1.0f - 2.0f * __builtin_amdgcn_rcpf(1.0f + e);
    return 0.5f * x * (1.0f + th);
}
__device__ __forceinline__ void store8(bf16_t* dst, f32x4 v0, f32x4 v1) {
    u32x4 w; w.x = cvt_pk_bf16(v0[0], v0[1]); w.y = cvt_pk_bf16(v0[2], v0[3]); w.z = cvt_pk_bf16(v1[0], v1[1]); w.w = cvt_pk_bf16(v1[2], v1[3]);
    *(u32x4*)dst = w;
}

template <class T, class = void> struct has_pair : std::false_type {};
template <class T> struct has_pair<T, std::void_t<decltype(T::HAS_PAIR)>> : std::true_type {};
template <class Op, bool RS = false> struct EpiP {
    static constexpr bool PERM = true, AFTER_DRAIN = false; Op op; const float* ss;
    __device__ __forceinline__ void operator()(const f32x4 (&acc)[2][2][4][2], const Unit& u, int wr, int wc, int fr, int fq) const {
#pragma unroll
        for (int ai = 0; ai < 2; ++ai) {
            const int row0 = u.pm * 256 + ai * 128 + wr * 64 + fr; float r[4] = {1.0f, 1.0f, 1.0f, 1.0f};
            if (RS) { f32x4 t[4][4];
#pragma unroll
                for (int m = 0; m < 4; ++m) { const f32x4* sp = (const f32x4*)(ss + (size_t)(row0 + m * 16) * 16);
#pragma unroll
                    for (int k = 0; k < 4; ++k) t[m][k] = sp[k]; }
#pragma unroll
                for (int m = 0; m < 4; ++m) { const f32x4 q = (t[m][0] + t[m][1]) + (t[m][2] + t[m][3]); r[m] = 1.0f / sqrtf(((q.x + q.y) + (q.z + q.w)) * (1.0f / 1024.0f) + 1e-6f); } }
            if constexpr (has_pair<Op>::value) { if (op.is_pair(u.pn)) {
#pragma unroll
                for (int m = 0; m < 4; ++m) op.apply_pair(u.pn, row0 + m * 16, wc, fq, acc[ai][0][m][0] * r[m], acc[ai][0][m][1] * r[m], acc[ai][1][m][0] * r[m], acc[ai][1][m][1] * r[m]);
                continue; } }
            typename Op::Pre pre[4][2];
#pragma unroll
            for (int m = 0; m < 4; ++m)
#pragma unroll
                for (int bj = 0; bj < 2; ++bj) pre[m][bj] = op.load(u.pn, row0 + m * 16, bj * 128 + wc * 32 + 8 * fq);
#pragma unroll
            for (int m = 0; m < 4; ++m)
#pragma unroll
                for (int bj = 0; bj < 2; ++bj) op.apply(u.pn, row0 + m * 16, bj * 128 + wc * 32 + 8 * fq, acc[ai][bj][m][0] * r[m], acc[ai][bj][m][1] * r[m], pre[m][bj]);
        }
    }
};
struct EpiResid {
    static constexpr bool PERM = true, AFTER_DRAIN = false; bf16_t* xb; float* ss;
    __device__ __forceinline__ void operator()(const f32x4 (&acc)[2][2][4][2], const Unit& u, int wr, int wc, int fr, int fq) const {
#pragma unroll
        for (int ai = 0; ai < 2; ++ai) {
            const int row0 = u.pm * 256 + ai * 128 + wr * 64 + fr; const int col0 = u.pn * 256 + wc * 32 + 8 * fq;
            u32x4 xv[4][2];
#pragma unroll
            for (int m = 0; m < 4; ++m)
#pragma unroll
                for (int bj = 0; bj < 2; ++bj) xv[m][bj] = *(const u32x4*)(xb + (size_t)(row0 + m * 16) * 1024 + col0 + bj * 128);
#pragma unroll
            for (int m = 0; m < 4; ++m) { const int row = row0 + m * 16; float sq = 0.f;
#pragma unroll
                for (int bj = 0; bj < 2; ++bj) { const size_t o = (size_t)row * 1024 + col0 + bj * 128; const u32x4 x = xv[m][bj];
                    const f32x4 v0 = (f32x4){bflo(x.x), bfhi(x.x), bflo(x.y), bfhi(x.y)} + acc[ai][bj][m][0], v1 = (f32x4){bflo(x.z), bfhi(x.z), bflo(x.w), bfhi(x.w)} + acc[ai][bj][m][1];
                    store8(xb + o, v0, v1);
                    sq += ((v0.x * v0.x + v0.y * v0.y) + (v0.z * v0.z + v0.w * v0.w)) + ((v1.x * v1.x + v1.y * v1.y) + (v1.z * v1.z + v1.w * v1.w)); }
                sq += __shfl_xor(sq, 16); sq += __shfl_xor(sq, 32);
                if (fq == 0) ss[(size_t)row * 16 + u.pn * 4 + wc] = sq; }
        }
    }
};
__device__ __forceinline__ constexpr int PIperm(int p) { return (p & ~12) | ((p & 8) >> 1) | ((p & 4) << 1); }
struct NoPre {};
struct OpProj { unsigned char* ws; typedef NoPre Pre; static constexpr bool HAS_PAIR = true;
    __device__ __forceinline__ bool is_pair(int pn) const { return pn == 7 || (pn >= 2 && pn < 6); }
    __device__ __forceinline__ void apply_pair(int pn, int row, int wc, int fq, f32x4 a0, f32x4 a1, f32x4 b0, f32x4 b1) const {
        const unsigned g = wc & 1, d0 = 8 * fq, b = (unsigned)row >> 12, t = row & 4095;
        const unsigned ro = (t * 32 + d0) * 4;
        const unsigned ko = (pn == 7) ? (unsigned)((wc >> 1) ? WS_KW : WS_KS) + (((b * 2 + g) * 4096 + t) * 64 + d0) * 2
                                      : (unsigned)WS_Q + ((unsigned)row * 1024u + (unsigned)((pn - 2) * 4 + wc) * 64u + d0) * 2;
        { const f32x4 c0 = *(const f32x4*)(ws + WS_ROPEC + ro), s0 = *(const f32x4*)(ws + WS_ROPES + ro);
          const f32x4 y1 = a0 * c0 - b0 * s0, y2 = b0 * c0 + a0 * s0; u32x2 w1, w2; w1.x = cvt_pk_bf16(y1[0], y1[1]); w1.y = cvt_pk_bf16(y1[2], y1[3]); w2.x = cvt_pk_bf16(y2[0], y2[1]); w2.y = cvt_pk_bf16(y2[2], y2[3]);
          *(u32x2*)(ws + ko) = w1; *(u32x2*)(ws + ko + 64) = w2; }
        { const f32x4 c1 = *(const f32x4*)(ws + WS_ROPEC + ro + 16), s1 = *(const f32x4*)(ws + WS_ROPES + ro + 16);
          const f32x4 y1 = a1 * c1 - b1 * s1, y2 = b1 * c1 + a1 * s1; u32x2 w1, w2; w1.x = cvt_pk_bf16(y1[0], y1[1]); w1.y = cvt_pk_bf16(y1[2], y1[3]); w2.x = cvt_pk_bf16(y2[0], y2[1]); w2.y = cvt_pk_bf16(y2[2], y2[3]);
          *(u32x2*)(ws + ko + 8) = w1; *(u32x2*)(ws + ko + 72) = w2; }
    }
    __device__ __forceinline__ Pre load(int, int, int) const { return Pre{}; }
    __device__ __forceinline__ void apply(int pn, int row, int lc, f32x4 v0, f32x4 v1, const Pre&) const {
        size_t off; bool sig = false;
        if (pn < 2) off = WS_U + ((size_t)row * 512 + pn * 256 + lc) * 2;
        else if (pn < 6) off = WS_Q + ((size_t)row * 1024 + (pn - 2) * 256 + lc) * 2;
        else if (pn == 6) { const int c = lc & 127, g = c >> 6, dh = c & 63, b = row >> 12, t = row & 4095;
            off = WS_KC + (size_t)(lc >> 7) * (8 * MiB) + (((size_t)((b * 2 + g) * 4096 + t)) * 64 + dh) * 2; }
        else if (pn == 8) {
            const int c = lc & 127, g = c >> 6, dh = c & 63, b = row >> 12, t = row & 4095;
            bf16_t* vt = (bf16_t*)(ws + ((lc >> 7) ? WS_VWT : WS_VST)) + ((size_t)(b * 2 + g) * 64 + (t >> 6)) * 4096 + dh * 64 + PIperm(t & 63);
#pragma unroll
            for (int j = 0; j < 4; ++j) { vt[j * 64] = f2bf(v0[j]); vt[(4 + j) * 64] = f2bf(v1[j]); }
            return; }
        else if (pn == 7) return;
        else if (pn == 9) { if (lc >= 64) return; off = WS_GNSA + ((size_t)row * 64 + lc) * 2; sig = true; }
        else {
            v0 = sigmoid4(v0); v1 = sigmoid4(v1); u32x2 w;
            w.x = (unsigned)(v0[0] * 255.0f + 0.5f) | ((unsigned)(v0[1] * 255.0f + 0.5f) << 8) | ((unsigned)(v0[2] * 255.0f + 0.5f) << 16) | ((unsigned)(v0[3] * 255.0f + 0.5f) << 24);
            w.y = (unsigned)(v1[0] * 255.0f + 0.5f) | ((unsigned)(v1[1] * 255.0f + 0.5f) << 8) | ((unsigned)(v1[2] * 255.0f + 0.5f) << 16) | ((unsigned)(v1[3] * 255.0f + 0.5f) << 24);
            *(u32x2*)(ws + WS_GM + (size_t)row * 2048 + (pn - 10) * 256 + lc) = w; return; }
        if (sig) { v0 = sigmoid4(v0); v1 = sigmoid4(v1); }
        store8((bf16_t*)(ws + off), v0, v1);
    } };
struct OpBf16 { bf16_t* O; int ld; typedef NoPre Pre;
    __device__ __forceinline__ Pre load(int, int, int) const { return Pre{}; }
    __device__ __forceinline__ void apply(int pn, int row, int lc, f32x4 v0, f32x4 v1, const Pre&) const { store8(O + (size_t)row * ld + pn * 256 + lc, v0, v1); } };
struct OpCmp1 { bf16_t* H; const float* bias; struct Pre { f32x4 b0, b1; };
    __device__ __forceinline__ Pre load(int, int, int lc) const { return Pre{*(const f32x4*)(bias + lc), *(const f32x4*)(bias + lc + 4)}; }
    __device__ __forceinline__ void apply(int pn, int row, int lc, f32x4 v0, f32x4 v1, const Pre& p) const {
        v0 += p.b0; v1 += p.b1;
#pragma unroll
        for (int i = 0; i < 4; ++i) { v0[i] = gelu_tanh(v0[i]); v1[i] = gelu_tanh(v1[i]); }
        store8(H + (size_t)row * 256 + lc, v0, v1);
    } };
__device__ __forceinline__ void ungate8(u32x2 g, float (&f)[8]) { constexpr float k = 1.0f / 255.0f;
    f[0] = (float)(g.x & 255u) * k; f[1] = (float)((g.x >> 8) & 255u) * k; f[2] = (float)((g.x >> 16) & 255u) * k; f[3] = (float)(g.x >> 24) * k;
    f[4] = (float)(g.y & 255u) * k; f[5] = (float)((g.y >> 8) & 255u) * k; f[6] = (float)((g.y >> 16) & 255u) * k; f[7] = (float)(g.y >> 24) * k; }
struct OpMerge1 { const unsigned char* G8; bf16_t* MG; struct Pre { u32x2 g; };
    __device__ __forceinline__ Pre load(int pn, int row, int lc) const { return Pre{*(const u32x2*)(G8 + (size_t)row * 2048 + pn * 256 + lc)}; }
    __device__ __forceinline__ void apply(int pn, int row, int lc, f32x4 v0, f32x4 v1, const Pre& p) const {
        float g[8]; ungate8(p.g, g);
#pragma unroll
        for (int i = 0; i < 4; ++i) { v0[i] *= g[i]; v1[i] *= g[4 + i]; }
        store8(MG + (size_t)row * 1024 + pn * 256 + lc, v0, v1);
    } };
struct OpMerge2 { const unsigned char* G8; bf16_t* MG; struct Pre { u32x4 t; u32x2 g; };
    __device__ __forceinline__ Pre load(int pn, int row, int lc) const { return Pre{*(const u32x4*)(MG + (size_t)row * 1024 + pn * 256 + lc), *(const u32x2*)(G8 + (size_t)row * 2048 + 1024 + pn * 256 + lc)}; }
    __device__ __forceinline__ void apply(int pn, int row, int lc, f32x4 v0, f32x4 v1, const Pre& p) const {
        const u32x4 t = p.t; float g[8]; ungate8(p.g, g);
        v0[0] = v0[0] * g[0] + bflo(t.x); v0[1] = v0[1] * g[1] + bfhi(t.x); v0[2] = v0[2] * g[2] + bflo(t.y); v0[3] = v0[3] * g[3] + bfhi(t.y);
        v1[0] = v1[0] * g[4] + bflo(t.z); v1[1] = v1[1] * g[5] + bfhi(t.z); v1[2] = v1[2] * g[6] + bflo(t.w); v1[3] = v1[3] * g[7] + bfhi(t.w);
        store8(MG + (size_t)row * 1024 + pn * 256 + lc, v0, v1);
    } };
struct OpFF1 { bf16_t* H; typedef NoPre Pre;
    __device__ __forceinline__ Pre load(int, int, int) const { return Pre{}; }
    __device__ __forceinline__ void apply(int pn, int row, int lc, f32x4 v0, f32x4 v1, const Pre&) const {
#pragma unroll
        for (int i = 0; i < 4; ++i) { const float a = fmaxf(v0[i], 0.f), b = fmaxf(v1[i], 0.f); v0[i] = a * a; v1[i] = b * b; }
        store8(H + (size_t)row * 4096 + pn * 256 + lc, v0, v1);
    } };
struct EpiNull { static constexpr bool PERM = true, AFTER_DRAIN = false;
    __device__ __forceinline__ void operator()(const f32x4 (&acc)[2][2][4][2], const Unit& u, int wr, int wc, int fr, int fq) const {
#pragma unroll
        for (int ai = 0; ai < 2; ++ai)
#pragma unroll
            for (int bj = 0; bj < 2; ++bj)
#pragma unroll
                for (int m = 0; m < 4; ++m)
#pragma unroll
                    for (int n = 0; n < 2; ++n) asm volatile("" :: "v"(acc[ai][bj][m][n]));
    } };
template <class Epi> __device__ __forceinline__ void run_gemm(LAS unsigned char* lds, const bf16_t* A, int lda, const bf16_t* Bt, int M, int N, int K, const Epi& E, int G, int c) {
    Gemm g{A, Bt, M, N, K, lda}; StaticOrder S; S.init(M, N, G, c);
    gemm_phase<Epi, StaticOrder, true, true>(lds, g, S, E);
}

template <class F> __device__ __forceinline__ void conv_tile(F f, bf16_t* WT, int K, int n0, int k0, LAS float* scr, int lane) {
    float tv[32];
#pragma unroll
    for (int i = 0; i < 32; ++i) tv[i] = f(k0 + 2 * i + (lane >> 5), n0 + (lane & 31));
#pragma unroll
    for (int i = 0; i < 32; ++i) scr[(2 * i + (lane >> 5)) * 33 + (lane & 31)] = tv[i];
    LDS_WAIT(); asm volatile("" ::: "memory");
    const int c = lane & 7;
#pragma unroll
    for (int j = 0; j < 4; ++j) { const int n = (lane >> 3) + 8 * j; const LAS float* s = scr + (8 * c) * 33 + n;
        u32x4 o; o.x = cvt_pk_bf16(s[0 * 33], s[1 * 33]); o.y = cvt_pk_bf16(s[2 * 33], s[3 * 33]); o.z = cvt_pk_bf16(s[4 * 33], s[5 * 33]); o.w = cvt_pk_bf16(s[6 * 33], s[7 * 33]);
        *(u32x4*)(WT + (size_t)(n0 + n) * K + k0 + 8 * c) = o; }
    LDS_WAIT(); asm volatile("" ::: "memory");
}
struct FPlain { const float* W; int N; __device__ __forceinline__ float operator()(int k, int n) const { return W[(size_t)k * N + n]; } };
struct FWin { const float* W; const float* gk; __device__ __forceinline__ float operator()(int k, int p) const {
    int src;
    if (p < 512 || (p >= 1536 && p < 1792)) src = p;
    else if (p < 1536) { const int lc = (p - 512) & 255, tl = (p - 512) >> 8, bj = lc >> 7, wc = (lc >> 5) & 3, r = lc & 31;
        src = 512 + (tl * 4 + wc) * 64 + bj * 32 + r; }
    else if (p < 2048) { const int lc = p - 1792, bj = lc >> 7, wc = (lc >> 5) & 3, r = lc & 31;
        src = ((wc >> 1) ? 2048 : 1792) + (wc & 1) * 64 + bj * 32 + r; }
    else if (p < 2304) { const int lc = p - 2048; src = (lc < 128) ? 1920 + lc : 2176 + (lc - 128); }
    else if (p < 2352) src = p; else if (p < 2560) src = -1; else src = p - 208; return src < 0 ? 0.f : W[(size_t)k * NIN + src] * gk[k]; } };
struct FPlainG { const float* W; int N; const float* gk; __device__ __forceinline__ float operator()(int k, int n) const { return W[(size_t)k * N + n] * gk[k]; } };
struct FPool { const float* W; const float* sc; __device__ __forceinline__ float operator()(int j, int k) const {
    return ((k >> 7) == (j >> 7)) ? W[(k >> 7) * 16384 + (k & 127) * 128 + (j & 127)] * sc[j] : 0.f; } };

__device__ __forceinline__ void rms_row_out(const bf16_t* xrow, const float* g, float* orow, int lane) {
    const u32x2* xr = (const u32x2*)xrow + lane; const f32x4* gr = (const f32x4*)g + lane;
    f32x4 v[4]; float s = 0.f;
#pragma unroll
    for (int j = 0; j < 4; ++j) { const u32x2 w = xr[64 * j]; v[j] = (f32x4){bflo(w.x), bfhi(w.x), bflo(w.y), bfhi(w.y)}; s += (v[j].x * v[j].x + v[j].y * v[j].y) + (v[j].z * v[j].z + v[j].w * v[j].w); }
    const float r = 1.0f / sqrtf(wave_sum(s) * (1.0f / 1024.0f) + 1e-6f);
    f32x4* o = (f32x4*)orow + lane;
#pragma unroll
    for (int j = 0; j < 4; ++j) { const f32x4 gg = gr[64 * j]; o[64 * j] = (v[j] * r) * gg; }
}
struct Ctx { LAS unsigned char* lds; unsigned char* ws; int tid, lane, wave, G, bx, gw, NGW; };

__device__ __forceinline__ void ph_prologue(const Args& a, const Ctx& C) {
    unsigned char* ws = C.ws;
    { float* rc = (float*)(ws + WS_ROPEC); float* rs = (float*)(ws + WS_ROPES);
      for (int idx = C.bx * 512 + C.tid; idx < SEQ * 32; idx += C.G * 512) {
        const int t = idx >> 5, i = idx & 31; const double ang = (double)t * a.invf[i];
        const double k = rint(ang * 0.15915494309189535); double r = fma(-k, 6.283185307179586, ang); r = fma(-k, 2.4492935982947064e-16, r);
        const double r2 = r * r; double s = 1.0, c = 1.0;
#pragma unroll
        for (int n = 15; n >= 1; --n) { s = 1.0 - r2 * (1.0 / (double)((2 * n) * (2 * n + 1))) * s; c = 1.0 - r2 * (1.0 / (double)((2 * n - 1) * (2 * n))) * c; }
        rc[idx] = (float)c; rs[idx] = (float)(r * s);
      } }
    LAS float* scr = (LAS float*)(C.lds + C.wave * 8448);
    constexpr int I_IN = 16 * 144, I_POOL = 8 * 16, I_CK = 32 * 8, I_PP = 8 * 32, I_PN = 16 * 32, I_OUT = 16 * 32, I_FF1 = 16 * 128, I_FF2 = 64 * 32, I_C2 = 4 * 2;
    constexpr int NITEMS = I_IN + I_POOL + 2 * I_CK + I_PP + I_PN + I_OUT + I_FF1 + I_FF2 + 2 * I_C2;
    for (int it = C.gw; it < DEPTH * NITEMS; it += C.NGW) {
        const int l = it / NITEMS; int r = it - l * NITEMS; unsigned char* wl = ws + WS_W + (size_t)l * WL_STRIDE;
        if (r < I_IN) { conv_tile(FWin{AIN(a, 2) + (size_t)l * DM * NIN, AIN(a, 1) + (size_t)l * 1024}, (bf16_t*)(wl + W_IN), 1024, (r % 144) * 32, (r / 144) * 64, scr, C.lane); continue; } r -= I_IN;
        if (r < I_POOL) { conv_tile(FPool{AIN(a, 3) + (size_t)l * 65536, AIN(a, 4) + (size_t)l * 512}, (bf16_t*)(wl + W_POOL), 512, (r % 16) * 32, (r / 16) * 64, scr, C.lane); continue; } r -= I_POOL;
        if (r < I_CK) { conv_tile(FPlain{AIN(a, 7) + (size_t)l * 2048 * 256, 256}, (bf16_t*)(wl + W_CK1), 2048, (r % 8) * 32, (r / 8) * 64, scr, C.lane); continue; } r -= I_CK;
        if (r < I_CK) { conv_tile(FPlain{AIN(a, 9) + (size_t)l * 2048 * 256, 256}, (bf16_t*)(wl + W_CV1), 2048, (r % 8) * 32, (r / 8) * 64, scr, C.lane); continue; } r -= I_CK;
        if (r < I_PP) { conv_tile(FPlain{AIN(a, 11) + (size_t)l * 512 * 1024, 1024}, (bf16_t*)(wl + W_PP), 512, (r % 32) * 32, (r / 32) * 64, scr, C.lane); continue; } r -= I_PP;
        if (r < I_PN) { conv_tile(FPlain{AIN(a, 12) + (size_t)l * 1024 * 1024, 1024}, (bf16_t*)(wl + W_PN), 1024, (r % 32) * 32, (r / 32) * 64, scr, C.lane); continue; } r -= I_PN;
        if (r < I_OUT) { conv_tile(FPlain{AIN(a, 13) + (size_t)l * 1024 * 1024, 1024}, (bf16_t*)(wl + W_OUT), 1024, (r % 32) * 32, (r / 32) * 64, scr, C.lane); continue; } r -= I_OUT;
        if (r < I_FF1) { conv_tile(FPlainG{AIN(a, 15) + (size_t)l * 1024 * 4096, 4096, AIN(a, 14) + (size_t)l * 1024}, (bf16_t*)(wl + W_FF1), 1024, (r % 128) * 32, (r / 128) * 64, scr, C.lane); continue; } r -= I_FF1;
        if (r < I_FF2) { conv_tile(FPlain{AIN(a, 16) + (size_t)l * 4096 * 1024, 1024}, (bf16_t*)(wl + W_FF2), 4096, (r % 32) * 32, (r / 32) * 64, scr, C.lane); continue; } r -= I_FF2;
        if (r < I_C2) { conv_tile(FPlain{AIN(a, 8) + (size_t)l * 256 * 64, 64}, (bf16_t*)(wl + W_CK2), 256, (r % 2) * 32, (r / 2) * 64, scr, C.lane); continue; } r -= I_C2;
        conv_tile(FPlain{AIN(a, 10) + (size_t)l * 256 * 64, 64}, (bf16_t*)(wl + W_CV2), 256, (r % 2) * 32, (r / 2) * 64, scr, C.lane);
    }
    { float* cb = (float*)(ws + WS_CBIAS);
      for (int it = C.gw; it < DEPTH * 512; it += C.NGW) { const int l = it >> 9, kv = (it >> 8) & 1, n = it & 255; const float* pe = AIN(a, kv ? 6 : 5) + (size_t)l * 2048; const float* w1 = AIN(a, kv ? 9 : 7) + (size_t)l * 2048 * 256;
          float s = 0.f; for (int kk = C.lane; kk < 2048; kk += 64) s += pe[kk] * w1[(size_t)kk * 256 + n];
          s = wave_sum(s); if (C.lane == 0) cb[it] = s; } }
    { const float* x = AIN(a, 0); bf16_t* XB = (bf16_t*)(ws + WS_XN); float* SS = (float*)(ws + WS_SS); const int lane = C.lane;
      for (int m = C.gw; m < MTOK; m += C.NGW) {
        const f32x4* xr = (const f32x4*)(x + (size_t)m * 1024) + lane; u32x2* o8 = (u32x2*)(XB + (size_t)m * 1024) + lane; float sq = 0.f;
#pragma unroll
        for (int j = 0; j < 4; ++j) { const f32x4 v = xr[64 * j]; sq += (v.x * v.x + v.y * v.y) + (v.z * v.z + v.w * v.w); u32x2 w; w.x = cvt_pk_bf16(v.x, v.y); w.y = cvt_pk_bf16(v.z, v.w); o8[64 * j] = w; }
        sq = wave_sum(sq); if (lane < 16) SS[(size_t)m * 16 + lane] = (lane == 0) ? sq : 0.f;
      } }
}

__device__ __forceinline__ void vt_tile(const bf16_t* src, bf16_t* dst, int lane) {
    unsigned pk[32];
#pragma unroll
    for (int pos = 0; pos < 64; pos += 2) { const int kv0 = PIperm(pos); const unsigned lo = src[kv0 * 64 + lane], hi = src[(kv0 + 1) * 64 + lane]; pk[pos >> 1] = lo | (hi << 16); }
    u32x4* d = (u32x4*)(dst + lane * 64);
#pragma unroll
    for (int j = 0; j < 8; ++j) d[j] = (u32x4){pk[4 * j], pk[4 * j + 1], pk[4 * j + 2], pk[4 * j + 3]};
}
__device__ __forceinline__ void ph_post(const Ctx& C, bool do_rope, const int pgw, const int pngw, bf16_t* Dbuf) {
    unsigned char* ws = C.ws; const int lane = C.lane;
    const float* rc = (const float*)(ws + WS_ROPEC); const float* rs = (const float*)(ws + WS_ROPES);
    if (do_rope) for (int it = pgw; it < 2 * 16 * 4096 / 8; it += pngw) {
        const int rr = it * 8 + (lane >> 3); bf16_t* base = (bf16_t*)(ws + (rr < 65536 ? WS_KS : WS_KW)); const int r = rr & 65535, t = r & 4095, d0 = (lane & 7) * 4;
        bf16_t* p = base + (size_t)r * 64 + d0; const u32x2 a = *(const u32x2*)p, b = *(const u32x2*)(p + 32);
        const f32x4 c = *(const f32x4*)(rc + t * 32 + d0), s = *(const f32x4*)(rs + t * 32 + d0);
        const float x1[4] = {bflo(a.x), bfhi(a.x), bflo(a.y), bfhi(a.y)}, x2[4] = {bflo(b.x), bfhi(b.x), bflo(b.y), bfhi(b.y)};
        float y1[4], y2[4];
#pragma unroll
        for (int i = 0; i < 4; ++i) { y1[i] = x1[i] * c[i] - x2[i] * s[i]; y2[i] = x2[i] * c[i] + x1[i] * s[i]; }
        u32x2 oa, ob; oa.x = cvt_pk_bf16(y1[0], y1[1]); oa.y = cvt_pk_bf16(y1[2], y1[3]); ob.x = cvt_pk_bf16(y2[0], y2[1]); ob.y = cvt_pk_bf16(y2[2], y2[3]);
        *(u32x2*)p = oa; *(u32x2*)(p + 32) = ob;
    }
    { const bf16_t* U = (const bf16_t*)(ws + WS_U); bf16_t* D = Dbuf;
#define UNPK8(NAME_, VEC_) const float NAME_[8] = {bflo(VEC_[0]), bfhi(VEC_[0]), bflo(VEC_[1]), bfhi(VEC_[1]), bflo(VEC_[2]), bfhi(VEC_[2]), bflo(VEC_[3]), bfhi(VEC_[3])}
      for (int it = pgw; it < MTOK / 32; it += pngw) {
        const int tt0 = it * 32, t0 = tt0 & 4095, w = 2 << (lane >> 4); const bf16_t* up = U + (size_t)tt0 * 512 + lane * 8; bf16_t* dp = D + (size_t)tt0 * 512 + lane * 8;
        float s[8] = {0.f, 0.f, 0.f, 0.f, 0.f, 0.f, 0.f, 0.f};
#pragma unroll
        for (int i = 1; i < 16; ++i) if (i < w && t0 - i >= 0) { const u32x4 v = *(const u32x4*)(up - (ptrdiff_t)i * 512); UNPK8(x, v);
#pragma unroll
            for (int j2 = 0; j2 < 8; ++j2) s[j2] += x[j2]; }
#pragma unroll 8
        for (int k = 0; k < 32; ++k) {
            const int t = t0 + k; const u32x4 v = *(const u32x4*)(up + (size_t)k * 512); UNPK8(x, v);
            const int cnt = (t + 1 < w) ? t + 1 : w; const float inv = 1.0f / (float)cnt; f32x4 d0, d1;
#pragma unroll
            for (int j2 = 0; j2 < 8; ++j2) s[j2] += x[j2];
#pragma unroll
            for (int j2 = 0; j2 < 4; ++j2) { d0[j2] = s[j2] * inv - x[j2]; d1[j2] = s[j2 + 4] * inv - x[j2 + 4]; }
            store8(dp + (size_t)k * 512, d0, d1);
            if (t - w + 1 >= 0) { const u32x4 vo = *(const u32x4*)(up + (ptrdiff_t)(k - w + 1) * 512); UNPK8(y, vo);
#pragma unroll
                for (int j2 = 0; j2 < 8; ++j2) s[j2] -= y[j2]; }
        }
      }
#undef UNPK8
    }
}

__device__ __forceinline__ constexpr int crow_c(int r) { return (r & 3) + 8 * (r >> 2); }
#define MFMA32(a, b, c) __builtin_amdgcn_mfma_f32_32x32x16_bf16((a), (b), (c), 0, 0, 0)
__device__ __forceinline__ void ph_cmp2(const Ctx& C, int l) {
    unsigned char* ws = C.ws; const int lane = C.lane, c = lane & 31, hh = lane >> 5;
    const float* rc = (const float*)(ws + WS_ROPEC); const float* rs = (const float*)(ws + WS_ROPES);
    for (int it = C.bx + C.G * C.wave; it < 256; it += C.G * 8) {
        const int kv = it >> 7, r0 = (it & 127) * 32;
        const bf16_t* hid = (const bf16_t*)(ws + (kv ? WS_HIDV : WS_HIDK)) + (size_t)(r0 + c) * 256 + hh * 8;
        const bf16_t* w2t = (const bf16_t*)(ws + WS_W + (size_t)l * WL_STRIDE + (kv ? W_CV2 : W_CK2)) + hh * 8;
        f32x16 a0 = (f32x16){}, a1 = (f32x16){};
#pragma unroll 4
        for (int ks = 0; ks < 16; ++ks) { const bf16x8 af = *(const bf16x8*)(hid + ks * 16), b0 = *(const bf16x8*)(w2t + (size_t)c * 256 + ks * 16), b1 = *(const bf16x8*)(w2t + (size_t)(c + 32) * 256 + ks * 16);
            a0 = MFMA32(af, b0, a0); a1 = MFMA32(af, b1, a1); }
#pragma unroll
        for (int r = 0; r < 16; ++r) { const int row = r0 + crow_c(r) + 4 * hh, bg = row >> 8, n = row & 255; float v0 = a0[r], v1 = a1[r];
            if (n == 255) { v0 = 0.f; v1 = 0.f; }
            if (kv == 0) { const int pos = (n == 255) ? 0 : 16 * n + 31; const float cc = rc[pos * 32 + c], sn = rs[pos * 32 + c];
                bf16_t* o = (bf16_t*)(ws + WS_CK) + (size_t)row * 64; o[c] = f2bf(v0 * cc - v1 * sn); o[c + 32] = f2bf(v1 * cc + v0 * sn); }
            else { bf16_t* o = (bf16_t*)(ws + WS_CVT) + (size_t)bg * 16384 + (n >> 6) * 4096 + PIperm(n & 63); o[c * 64] = f2bf(v0); o[(c + 32) * 64] = f2bf(v1); } }
    }
}

constexpr int SLABP = 65;
constexpr int AT_KB = 0, AT_VB = 18432, AT_SLAB = 36864, AT_SELM = AT_SLAB + 8 * 32 * SLABP * 4 + 64, AT_UNION = AT_SELM + 256, KPITCH = 144;
constexpr float SM_C = 0.125f * 1.4426950408889634f;
__device__ __forceinline__ void qk_tile(LAS const unsigned char* kb, const bf16x8 (&qf)[4], f32x16& p0, f32x16& p1, int lane) {
    LAS const unsigned char* ka = kb + (lane & 31) * KPITCH + (lane >> 5) * 16;
    p0 = (f32x16){}; p1 = (f32x16){};
#pragma unroll
    for (int ks = 0; ks < 4; ++ks) { const bf16x8 a0 = *(LAS const bf16x8*)(ka + ks * 32), a1 = *(LAS const bf16x8*)(ka + 32 * KPITCH + ks * 32);
        p0 = MFMA32(a0, qf[ks], p0); p1 = MFMA32(a1, qf[ks], p1); }
    __builtin_amdgcn_sched_group_barrier(0x100, 8, 0); __builtin_amdgcn_sched_group_barrier(0x008, 8, 0);
}
typedef float f32x2v __attribute__((ext_vector_type(2)));
__device__ __forceinline__ float fmax3(float a, float b, float c) { return fmaxf(fmaxf(a, b), c); }
__device__ __forceinline__ void attn_tile(LAS const unsigned char* kb, LAS const unsigned char* vb, const bf16x8 (&qf)[4], float& m, float& l, f32x16& o0, f32x16& o1, int lo, int hi_, int lane) {
    const int hh = lane >> 5; f32x16 p0, p1;
    qk_tile(kb, qf, p0, p1, lane);
    const bool lane_full = (lo <= 0) && (hi_ >= 63), lane_empty = lo > hi_;
    const bool simple = __all((lane_full || lane_empty) ? 1 : 0) != 0;
    if (!simple) { const int lo2 = lo - 4 * hh, hi2 = hi_ - 4 * hh;
#pragma unroll
        for (int r = 0; r < 16; ++r) { const int c0 = crow_c(r), c1 = c0 + 32; p0[r] = (c0 >= lo2 && c0 <= hi2) ? p0[r] : -INFINITY; p1[r] = (c1 >= lo2 && c1 <= hi2) ? p1[r] : -INFINITY; } }
    float mxa = fmax3(p0[0], p0[1], p1[0]), mxb = fmax3(p0[2], p0[3], p1[1]); mxa = fmax3(mxa, p1[2], p1[3]);
#pragma unroll
    for (int r = 4; r < 16; r += 4) { mxa = fmax3(mxa, p0[r], p0[r + 1]); mxb = fmax3(mxb, p0[r + 2], p0[r + 3]); mxa = fmax3(mxa, p1[r], p1[r + 1]); mxb = fmax3(mxb, p1[r + 2], p1[r + 3]); }
    float mx = fmaxf(mxa, mxb);
    const bool dead = simple && lane_empty;
    if (dead) mx = -INFINITY;
    mx = fmaxf(mx, __shfl_xor(mx, 32));
    const float mx2 = mx * SM_C;
    if (__any((mx2 > m + 8.0f) ? 1 : 0)) {
        const float mn = fmaxf(m, mx2), alpha = __builtin_amdgcn_exp2f(m - mn);
        l *= alpha; m = mn;
#pragma unroll
        for (int r = 0; r < 16; ++r) { o0[r] *= alpha; o1[r] *= alpha; }
    }
    const float neg = dead ? -INFINITY : -m;
    float sa = 0.f, sb = 0.f;
#pragma unroll
    for (int r = 0; r < 16; r += 2) {
        p0[r] = __builtin_amdgcn_exp2f(__builtin_fmaf(p0[r], SM_C, neg)); p0[r + 1] = __builtin_amdgcn_exp2f(__builtin_fmaf(p0[r + 1], SM_C, neg));
        p1[r] = __builtin_amdgcn_exp2f(__builtin_fmaf(p1[r], SM_C, neg)); p1[r + 1] = __builtin_amdgcn_exp2f(__builtin_fmaf(p1[r + 1], SM_C, neg));
        sa += p0[r] + p0[r + 1]; sb += p1[r] + p1[r + 1];
    }
    l += sa + sb;
    bf16x8 pf[4];
#pragma unroll
    for (int s = 0; s < 2; ++s) {
        u32x4 w0, w1;
        w0.x = cvt_pk_bf16(p0[8 * s + 0], p0[8 * s + 1]); w0.y = cvt_pk_bf16(p0[8 * s + 2], p0[8 * s + 3]); w0.z = cvt_pk_bf16(p0[8 * s + 4], p0[8 * s + 5]); w0.w = cvt_pk_bf16(p0[8 * s + 6], p0[8 * s + 7]);
        w1.x = cvt_pk_bf16(p1[8 * s + 0], p1[8 * s + 1]); w1.y = cvt_pk_bf16(p1[8 * s + 2], p1[8 * s + 3]); w1.z = cvt_pk_bf16(p1[8 * s + 4], p1[8 * s + 5]); w1.w = cvt_pk_bf16(p1[8 * s + 6], p1[8 * s + 7]);
        pf[s] = __builtin_bit_cast(bf16x8, w0); pf[2 + s] = __builtin_bit_cast(bf16x8, w1);
    }
    LAS const unsigned char* va = vb + (lane & 31) * KPITCH + hh * 16;
#pragma unroll
    for (int ts = 0; ts < 4; ++ts) {
        const bf16x8 v0 = *(LAS const bf16x8*)(va + ts * 32), v1 = *(LAS const bf16x8*)(va + 32 * KPITCH + ts * 32);
        o0 = MFMA32(v0, pf[ts], o0); o1 = MFMA32(v1, pf[ts], o1);
    }
    __builtin_amdgcn_sched_group_barrier(0x100, 8, 1); __builtin_amdgcn_sched_group_barrier(0x008, 8, 1);
}
template <int MODE>
__device__ __forceinline__ void run_branch(LAS unsigned char* lds, const unsigned char* Kg, const unsigned char* Vg, unsigned long long tiles, const bf16x8 (&qf)[4],
                                           float& m, float& l, f32x16& o0, f32x16& o1, int cur, int tq, int nvalid, unsigned long long selm, int tid, int lane) {
    const int soff = (tid >> 3) * KPITCH + (tid & 7) * 16;
    unsigned long long rem = tiles;
    int T = __ffsll(rem) - 1; rem &= rem - 1;
    u32x4 kr = *(const u32x4*)(Kg + (size_t)T * 8192 + tid * 16), vr = *(const u32x4*)(Vg + (size_t)T * 8192 + tid * 16);
    *(LAS u32x4*)(lds + AT_KB + soff) = kr; *(LAS u32x4*)(lds + AT_VB + soff) = vr;
    __syncthreads();
    int bi = 0;
    for (;;) {
        const bool more = rem != 0ull;
        const int Tn = more ? (__ffsll(rem) - 1) : T; rem &= rem - 1;
        kr = *(const u32x4*)(Kg + (size_t)Tn * 8192 + tid * 16); vr = *(const u32x4*)(Vg + (size_t)Tn * 8192 + tid * 16);
        int lo, hi_;
        if (MODE == 0) { lo = 0; hi_ = nvalid - 64 * T - 1; }
        else if (MODE == 1) { const bool sb = ((selm >> T) & 1ull) != 0; lo = sb ? 0 : 1; hi_ = sb ? (T < cur ? 63 : tq) : 0; }
        else { lo = (T == cur - 8) ? tq + 1 : 0; hi_ = (T == cur) ? tq : 63; }
        attn_tile(lds + AT_KB + bi * 9216, lds + AT_VB + bi * 9216, qf, m, l, o0, o1, lo, hi_, lane);
        *(LAS u32x4*)(lds + AT_KB + (bi ^ 1) * 9216 + soff) = kr; *(LAS u32x4*)(lds + AT_VB + (bi ^ 1) * 9216 + soff) = vr;
        __syncthreads();
        if (!more) break;
        T = Tn; bi ^= 1;
    }
}
__device__ __forceinline__ void ph_attn(const Ctx& C, size_t yoff) {
    unsigned char* ws = C.ws; LAS unsigned char* lds = C.lds; const int tid = C.tid, lane = C.lane, w = C.wave, q = lane & 31, hh = lane >> 5;
    bf16_t* Q = (bf16_t*)(ws + WS_Q); const bf16_t* GN = (const bf16_t*)(ws + WS_GNSA);
    LAS float* slab = (LAS float*)(lds + AT_SLAB); LAS unsigned long long* selmp = (LAS unsigned long long*)(lds + AT_SELM); LAS unsigned* unionp = (LAS unsigned*)(lds + AT_UNION);
    const int vcu = (C.G % 8 == 0) ? (C.bx % 8) * (C.G / 8) + C.bx / 8 : C.bx;
    for (int it = vcu; it < 2048; it += C.G) {
        int bg, qb;
        if (C.G == 256) { const int i = it >> 8, v = it & 255, s = v & 15; bg = v >> 4; qb = 32 * (i >> 1) + ((i & 1) ? 31 - s : s); }
        else { bg = it & 15; qb = it >> 4; }
        const int b = bg >> 1, g = bg & 1, h = g * 8 + w, t0 = qb * 32, cur = t0 >> 6, t = t0 + q, tq = t & 63;
        const size_t tokrow = (size_t)b * 4096 + t;
        bf16_t* qp = Q + tokrow * 1024 + h * 64;
        bf16x8 qf[4];
#pragma unroll
        for (int ks = 0; ks < 4; ++ks) qf[ks] = *(const bf16x8*)(qp + ks * 16 + hh * 8);
        const float gc = bf2f(GN[tokrow * 64 + h * 3 + 0]), gs = bf2f(GN[tokrow * 64 + h * 3 + 1]), gwn = bf2f(GN[tokrow * 64 + h * 3 + 2]);
        if (tid == 0) { unionp[0] = 0u; unionp[1] = 0u; }
        const int nvalid = (t >= 31) ? ((t - 15) >> 4) : 0; const int nvmax = (t0 + 16) >> 4; const int ntile = (nvmax + 63) >> 6;
        const unsigned char* CKg = ws + WS_CK + (size_t)bg * 32768; const unsigned char* CVg = ws + WS_CVT + (size_t)bg * 32768;
        float m = -1e30f, l = 0.f; f32x16 o0 = (f32x16){}, o1 = (f32x16){};
        run_branch<0>(lds, CKg, CVg, (1ull << ntile) - 1ull, qf, m, l, o0, o1, cur, tq, nvalid, 0ull, tid, lane);
        l += __shfl_xor(l, 32);
        const float invl = (l > 0.f) ? 1.0f / l : 0.f;
        f32x16 out0 = o0 * (gc * invl), out1 = o1 * (gc * invl);
        if (cur - 2 > 13) { const int soff = (tid >> 3) * KPITCH + (tid & 7) * 16; float carry = 0.f;
          u32x4 kpre = *(const u32x4*)(CKg + tid * 16);
          for (int T = 0; T < ntile; ++T) {
            *(LAS u32x4*)(lds + AT_KB + (T & 1) * 9216 + soff) = kpre;
            kpre = *(const u32x4*)(CKg + (size_t)((T + 1 < ntile) ? T + 1 : T) * 8192 + tid * 16);
            __syncthreads();
            f32x16 p0, p1; qk_tile(lds + AT_KB + (T & 1) * 9216, qf, p0, p1, lane);
            const int nrel = nvalid - 64 * T - 4 * hh;
#pragma unroll
            for (int r = 0; r < 16; ++r) { const int c0 = crow_c(r);
                p0[r] = (c0 < nrel) ? __builtin_amdgcn_exp2f(p0[r] * SM_C - m) * invl : 0.f; p1[r] = (c0 + 32 < nrel) ? __builtin_amdgcn_exp2f(p1[r] * SM_C - m) * invl : 0.f; }
            float g4[8], last[8], oth[8];
#pragma unroll
            for (int i = 0; i < 8; ++i) { const int r0 = 4 * (i & 3); if (i < 4) { g4[i] = (p0[r0] + p0[r0 + 1]) + (p0[r0 + 2] + p0[r0 + 3]); last[i] = p0[r0 + 3]; } else { g4[i] = (p1[r0] + p1[r0 + 1]) + (p1[r0 + 2] + p1[r0 + 3]); last[i] = p1[r0 + 3]; } }
#pragma unroll
            for (int i = 0; i < 8; ++i) oth[i] = __shfl_xor(last[i], 32);
#pragma unroll
            for (int i = 0; i < 8; ++i) { const float add = hh ? oth[i] : (i ? oth[i > 0 ? i - 1 : 0] : carry); slab[(w * 32 + q) * SLABP + 16 * T + 2 * i + hh] = g4[i] + add; }
            carry = oth[7];
          }
          __syncthreads(); }
        {
            const int J = lane; const bool cand = (J >= 1) && (J <= cur - 2); const bool forced = (J <= cur) && (J == 0 || J >= cur - 1);
            const unsigned long long candm = __ballot(cand ? 1 : 0), forcedm = __ballot(forced ? 1 : 0);
            unsigned vb[4]; unsigned long long selq[4];
#pragma unroll
            for (int qq = 0; qq < 4; ++qq) { const int qi = 4 * w + qq; float v = 0.f;
#pragma unroll
                for (int w2 = 0; w2 < 8; ++w2) v += slab[(w2 * 32 + qi) * SLABP + J];
                vb[qq] = cand ? __float_as_uint(v) : 0u; selq[qq] = candm; }
            if (cur - 2 > 13) {
                unsigned th[4] = {0u, 0u, 0u, 0u};
#pragma unroll 1
                for (int bit = 30; bit >= 0; --bit) {
#pragma unroll
                    for (int qq = 0; qq < 4; ++qq) { const unsigned trial = th[qq] | (1u << bit); const unsigned long long mm = __ballot((vb[qq] >= trial) ? 1 : 0) & candm; th[qq] = (__popcll(mm) >= 13) ? trial : th[qq]; }
                }
                const unsigned long long below = (lane == 0) ? 0ull : (~0ull >> (64 - lane));
#pragma unroll
                for (int qq = 0; qq < 4; ++qq) { const unsigned long long mgt = __ballot((vb[qq] > th[qq]) ? 1 : 0) & candm, meq = __ballot((vb[qq] == th[qq]) ? 1 : 0) & candm;
                    const int need = 13 - __popcll(mgt), rank = __popcll(meq & below);
                    selq[qq] = __ballot((cand && (vb[qq] > th[qq] || (vb[qq] == th[qq] && rank < need))) ? 1 : 0); }
            }
#pragma unroll
            for (int qq = 0; qq < 4; ++qq) { const unsigned long long mk = selq[qq] | forcedm;
                if (lane == 0) { selmp[4 * w + qq] = mk; atomicOr((unsigned*)&unionp[0], (unsigned)mk); atomicOr((unsigned*)&unionp[1], (unsigned)(mk >> 32)); } }
        }
        __syncthreads();
        const unsigned long long selm = selmp[q];
        const unsigned ulo = __builtin_amdgcn_readfirstlane(unionp[0]), uhi = __builtin_amdgcn_readfirstlane(unionp[1]);
        const unsigned long long uni = ((unsigned long long)uhi << 32) | ulo;
        m = -1e30f; l = 0.f; o0 = (f32x16){}; o1 = (f32x16){};
        run_branch<1>(lds, ws + WS_KS + (size_t)bg * 524288, ws + WS_VST + (size_t)bg * 524288, uni, qf, m, l, o0, o1, cur, tq, 0, selm, tid, lane);
        { l += __shfl_xor(l, 32); const float f = gs / l; out0 += o0 * f; out1 += o1 * f; }
        m = -1e30f; l = 0.f; o0 = (f32x16){}; o1 = (f32x16){};
        { const int j0 = cur - 8 > 0 ? cur - 8 : 0; const unsigned long long wm = ((cur == 63) ? ~0ull : ((1ull << (cur + 1)) - 1ull)) & ~((1ull << j0) - 1ull);
          run_branch<2>(lds, ws + WS_KW + (size_t)bg * 524288, ws + WS_VWT + (size_t)bg * 524288, wm, qf, m, l, o0, o1, cur, tq, 0, 0ull, tid, lane); }
        { l += __shfl_xor(l, 32); const float f = gwn / l; out0 += o0 * f; out1 += o1 * f; }
#pragma unroll
        for (int i = 0; i < 4; ++i) {
            u32x2 a0, a1; a0.x = cvt_pk_bf16(out0[4 * i], out0[4 * i + 1]); a0.y = cvt_pk_bf16(out0[4 * i + 2], out0[4 * i + 3]); a1.x = cvt_pk_bf16(out1[4 * i], out1[4 * i + 1]); a1.y = cvt_pk_bf16(out1[4 * i + 2], out1[4 * i + 3]);
            bf16_t* yp = (bf16_t*)((unsigned char*)qp + yoff); *(u32x2*)(yp + 8 * i + 4 * hh) = a0; *(u32x2*)(yp + 32 + 8 * i + 4 * hh) = a1;
        }
    }
}

constexpr int NPHASE = 8 * DEPTH + 3;
#ifndef ONLY_MASK
#define ONLY_MASK 0xffff
#endif
#define HAS(k) ((ONLY_MASK >> (k)) & 1)
__global__ void __launch_bounds__(512, 2) mega_fwd(Args a) {
    extern __shared__ __attribute__((aligned(16))) unsigned char lds_raw[];
    Ctx C; C.lds = (LAS unsigned char*)lds_raw; C.ws = a.ws; C.tid = threadIdx.x; C.lane = C.tid & 63; C.wave = __builtin_amdgcn_readfirstlane(C.tid >> 6);
    C.G = gridDim.x; C.bx = blockIdx.x; C.gw = C.bx * 8 + C.wave; C.NGW = C.G * 8;
    cg::grid_group grid = cg::this_grid();
    { volatile LAS unsigned* st = (volatile LAS unsigned*)(C.lds + LDS_BYTES - 64); if (C.tid < 16) st[C.tid] = 0u; __syncthreads(); }
    XcdBarrier xbar = xcd_barrier_post((unsigned*)(a.ws + WS_BAR), (volatile LAS unsigned*)(C.lds + LDS_BYTES - 64));
    unsigned char* ws = a.ws; float* X = a.out;
    int ph = 0;
#define IN_PH() (ph >= a.ph_lo && ph < a.ph_hi)
#define FRESH() do { int t_ = threadIdx.x; asm volatile("" : "+v"(t_)); C.tid = t_; C.lane = t_ & 63; C.wave = __builtin_amdgcn_readfirstlane(t_ >> 6); C.gw = C.bx * 8 + C.wave; \
    unsigned wl_ = __builtin_amdgcn_readfirstlane((unsigned)(unsigned long long)a.ws), wh_ = __builtin_amdgcn_readfirstlane((unsigned)((unsigned long long)a.ws >> 32)); asm volatile("" : "+s"(wl_), "+s"(wh_)); \
    ws = (unsigned char*)(GAS1 unsigned char*)(((unsigned long long)wh_ << 32) | wl_); C.ws = ws; \
    unsigned xl_ = __builtin_amdgcn_readfirstlane((unsigned)(unsigned long long)a.out), xh_ = __builtin_amdgcn_readfirstlane((unsigned)((unsigned long long)a.out >> 32)); asm volatile("" : "+s"(xl_), "+s"(xh_)); \
    X = (float*)(GAS1 float*)(((unsigned long long)xh_ << 32) | xl_); } while (0)
#define SEAM() do { ++ph; if (ph > a.ph_lo && ph < a.ph_hi) { if (ph == 1) grid.sync(); else xcd_barrier(xbar); } FRESH(); } while (0)
    FRESH();
    if (HAS(0) && IN_PH()) ph_prologue(a, C);
    SEAM();
    if (IN_PH() && C.bx < 8 * DEPTH) {
        const int l = C.bx >> 3; unsigned char* wl = ws + WS_W + (size_t)l * WL_STRIDE;
        EpiP<OpBf16> E{OpBf16{(bf16_t*)(ws + WS_PPF) + (size_t)l * 1024 * 512, 512}, nullptr};
        run_gemm(C.lds, (const bf16_t*)(wl + W_PP), 512, (const bf16_t*)(wl + W_POOL), 1024, 512, 512, E, 8, C.bx & 7);
    }
    SEAM();
    for (int l = 0; l < DEPTH; ++l) {
        const float* xin = (l == 0) ? AIN(a, 0) : X;
        unsigned char* wl = ws + WS_W + (size_t)l * WL_STRIDE;
        if (HAS(1) && IN_PH()) {
            EpiP<OpProj, true> E{OpProj{ws}, (const float*)(ws + WS_SS)};
            run_gemm(C.lds, (const bf16_t*)(ws + WS_XN), 1024, (const bf16_t*)(wl + W_IN), MTOK, NPAD, 1024, E, C.G, C.bx);
        }
        SEAM();
        if (IN_PH()) {
            const int ncc = (C.G >= 64) ? 32 : 0;
            if (HAS(2) && (ncc == 0 || C.bx >= ncc)) ph_post(C, false, (C.bx - ncc) * 8 + C.wave, (C.G - ncc) * 8, (bf16_t*)X);
            FRESH(); wl = ws + WS_W + (size_t)l * WL_STRIDE;
            if (HAS(4) && (ncc == 0 || C.bx < 16)) { EpiP<OpCmp1> E{OpCmp1{(bf16_t*)(ws + WS_HIDK), (const float*)(ws + WS_CBIAS) + l * 512}, nullptr}; run_gemm(C.lds, (const bf16_t*)(ws + WS_KC), 1024, (const bf16_t*)(wl + W_CK1), 4096, 256, 2048, E, ncc ? 16 : C.G, C.bx); }
            FRESH(); wl = ws + WS_W + (size_t)l * WL_STRIDE;
            if (HAS(5) && (ncc == 0 || (C.bx >= 16 && C.bx < 32))) { EpiP<OpCmp1> E{OpCmp1{(bf16_t*)(ws + WS_HIDV), (const float*)(ws + WS_CBIAS) + l * 512 + 256}, nullptr}; run_gemm(C.lds, (const bf16_t*)(ws + WS_VC), 1024, (const bf16_t*)(wl + W_CV1), 4096, 256, 2048, E, ncc ? 16 : C.G, ncc ? C.bx - 16 : C.bx); }
        }
        SEAM();
        wl = ws + WS_W + (size_t)l * WL_STRIDE;
        if (IN_PH()) {
            FRESH();
            if (HAS(6)) ph_cmp2(C, l);
        }
        SEAM();
        if (HAS(7) && IN_PH()) ph_attn(C, 0);
        SEAM();
        wl = ws + WS_W + (size_t)l * WL_STRIDE;
        if (IN_PH()) {
            if (HAS(8)) { EpiP<OpMerge1> E{OpMerge1{ws + WS_GM, (bf16_t*)(ws + WS_GM + 64 * MiB)}, nullptr}; run_gemm(C.lds, (const bf16_t*)X, 512, (const bf16_t*)(ws + WS_PPF) + (size_t)l * 1024 * 512, MTOK, 1024, 512, E, C.G, C.bx); }
            FRESH(); wl = ws + WS_W + (size_t)l * WL_STRIDE;
            if (HAS(9)) { EpiP<OpMerge2> E{OpMerge2{ws + WS_GM, (bf16_t*)(ws + WS_GM + 64 * MiB)}, nullptr}; run_gemm(C.lds, (const bf16_t*)(ws + WS_Q), 1024, (const bf16_t*)(wl + W_PN), MTOK, 1024, 1024, E, C.G, C.bx); }
        }
        SEAM();
        wl = ws + WS_W + (size_t)l * WL_STRIDE;
        if (HAS(10) && IN_PH()) { EpiResid E{(bf16_t*)(ws + WS_XN), (float*)(ws + WS_SS)}; run_gemm(C.lds, (const bf16_t*)(ws + WS_GM + 64 * MiB), 1024, (const bf16_t*)(wl + W_OUT), MTOK, 1024, 1024, E, C.G, C.bx); }
        SEAM();
        wl = ws + WS_W + (size_t)l * WL_STRIDE;
        if (HAS(11) && IN_PH()) { EpiP<OpFF1, true> E{OpFF1{(bf16_t*)(ws + WS_H)}, (const float*)(ws + WS_SS)}; run_gemm(C.lds, (const bf16_t*)(ws + WS_XN), 1024, (const bf16_t*)(wl + W_FF1), MTOK, DFF, 1024, E, C.G, C.bx); }
        SEAM();
        wl = ws + WS_W + (size_t)l * WL_STRIDE;
        if (HAS(12) && IN_PH()) { EpiResid E{(bf16_t*)(ws + WS_XN), (float*)(ws + WS_SS)}; run_gemm(C.lds, (const bf16_t*)(ws + WS_H), 4096, (const bf16_t*)(wl + W_FF2), MTOK, 1024, DFF, E, C.G, C.bx); }
        SEAM();
    }
    if (IN_PH()) { for (int m = C.gw; m < MTOK; m += C.NGW) rms_row_out((const bf16_t*)(ws + WS_XN) + (size_t)m * 1024, AIN(a, 17), X + (size_t)m * 1024, C.lane); }
#undef IN_PH
#undef SEAM
}

#ifndef MK_PER_PHASE
#define MK_PER_PHASE 0
#endif
extern "C" void kernel_launch(void* const* d_in, const int* in_sizes, int n_in, void* d_out, int out_size, void* d_ws, size_t ws_size, hipStream_t stream) {
    static int grid = 0;
    if (grid == 0) {
        if (n_in != 18 || out_size != MTOK * DM || ws_size < WS_END) { fprintf(stderr, "kernel_launch: unexpected shapes (n_in %d out %d ws %zu)\n", n_in, out_size, ws_size); grid = -1; return; }
        int dev = 0, cus = 0, per_cu = 0;
        (void)hipGetDevice(&dev); (void)hipDeviceGetAttribute(&cus, hipDeviceAttributeMultiprocessorCount, dev);
        if (hipFuncSetAttribute((const void*)mega_fwd, hipFuncAttributeMaxDynamicSharedMemorySize, LDS_BYTES) != hipSuccess) { fprintf(stderr, "kernel_launch: hipFuncSetAttribute failed\n"); grid = -1; return; }
        if (hipOccupancyMaxActiveBlocksPerMultiprocessor(&per_cu, (const void*)mega_fwd, 512, LDS_BYTES) != hipSuccess || per_cu < 1) { fprintf(stderr, "kernel_launch: occupancy query %d\n", per_cu); per_cu = 1; }
        (void)hipGetLastError();
        grid = cus * (per_cu > 1 ? 1 : per_cu);
        if (grid <= 0) grid = 256;
    }
    if (grid < 0) return;
    Args a{};
    for (int i = 0; i < 18; ++i) a.in[i] = (const float*)d_in[i];
    a.out = (float*)d_out; a.ws = (unsigned char*)d_ws;
    for (int i = 0; i < 32; ++i) a.invf[i] = pow(10000.0, -(double)(2 * i) / 64.0);
#if MK_PER_PHASE
    for (int p = 0; p < NPHASE; ++p) { a.ph_lo = p; a.ph_hi = p + 1; hipLaunchKernelGGL(mega_fwd, dim3(grid), dim3(512), LDS_BYTES, stream, a); }
#else
    a.ph_lo = 0; a.ph_hi = NPHASE;
    (void)hipMemsetAsync((unsigned char*)d_ws + WS_BAR, 0, 16384, stream);
    void* args[] = {&a};
    hipError_t e = hipLaunchCooperativeKernel((const void*)mega_fwd, dim3(grid), dim3(512), args, LDS_BYTES, stream);
    if (e != hipSuccess) fprintf(stderr, "cooperative launch failed: %s (grid %d)\n", hipGetErrorString(e), grid);
#endif
}
```

```cpp
#include <hip/hip_runtime.h>
#include <hip/hip_cooperative_groups.h>
#include <cstdio>
#include <cstdint>
#include <cmath>
#include <type_traits>
namespace cg = cooperative_groups;
namespace pg8 {
#define PG8_LAS __attribute__((address_space(3)))
typedef unsigned short bf16_t;
typedef short bf16x8 __attribute__((ext_vector_type(8)));
typedef float f32x4 __attribute__((ext_vector_type(4)));
typedef unsigned u32x4 __attribute__((ext_vector_type(4)));
constexpr int BM = 256, BK = 64, HALF = 128, HTB = HALF * BK * 2  , STAGE_BYTES = 8 * HTB, NXCD = 8, WGM = 8;

__host__ __device__ __forceinline__ int lds_byte(int r, int c) { const int st = (r >> 4) * 2 + (c >> 5), rr = r & 15, cc = c & 31, ob = rr * 64 + cc * 2; return st * 1024 + (ob ^ (((ob >> 9) & 1) << 5)); }
__host__ __device__ __forceinline__ void stage_rc(int b, int& R, int& C) { const int st = b / 1024, sb = b % 1024, swz = sb ^ (((sb >> 9) & 1) << 5); R = (st >> 1) * 16 + swz / 64; C = (st & 1) * 32 + (swz % 64) / 2; }
__host__ __device__ __forceinline__ int perm32(int rho) { const int n = rho >> 4, i = rho & 15; return 8 * (i >> 2) + 4 * n + (i & 3); }

struct Unit { int pm, pn; };
struct Gemm { const bf16_t* A; const bf16_t* Bt; int M, N, K, lda; };

struct StaticOrder {
    int nM, nN, nwg, G, c;
    __host__ __device__ void init(int M, int N, int G_, int c_) { nM = M / BM; nN = N / BM; nwg = nM * nN; G = G_; c = c_; }
    __host__ __device__ bool next(int i, Unit& u) const {
        const long L = (long)i * G + c; if (L >= nwg) return false;
        int wgid = (int)L; { const int q = nwg / NXCD, r = nwg % NXCD, xcd = wgid % NXCD, off = wgid / NXCD; wgid = (xcd < r ? xcd * (q + 1) : r * (q + 1) + (xcd - r) * q) + off; }
        const int nig = WGM * nN, gid = wgid / nig, fm = gid * WGM, gsz = (nM - fm) < WGM ? (nM - fm) : WGM;
        u.pm = fm + ((wgid % nig) % gsz); u.pn = (wgid % nig) / gsz; return true;
    }
    __device__ __forceinline__ void a_ready(const Unit&) const {}
    __device__ __forceinline__ void done(const Unit&) const {}
};

__device__ __forceinline__ unsigned cvt_pk_bf16(float lo, float hi) { unsigned r; asm volatile("v_cvt_pk_bf16_f32 %0, %1, %2" : "=v"(r) : "v"(lo), "v"(hi)); return r; }
typedef float f32x2 __attribute__((ext_vector_type(2)));
template <class Epi, class Sched, bool ALIGN_EPI = false, bool SP2 = false>
__device__ __forceinline__ void gemm_phase(PG8_LAS unsigned char* lds, const Gemm g, const Sched& S, const Epi& E) {
    int tid_ = threadIdx.x; asm volatile("" : "+v"(tid_));
    const int tid = tid_, wid = __builtin_amdgcn_readfirstlane(tid >> 6), lane = tid & 63, wr = wid >> 2, wc = wid & 3, fr = lane & 15, fq = lane >> 4;
    const int K = g.K, nt = K / BK;
    unsigned voffA[2], voffB[2];
#pragma unroll
    for (int i = 0; i < 2; ++i) { int R, C; stage_rc(tid * 16 + i * 8192, R, C); const int Rb = Epi::PERM ? ((R & ~31) + perm32(R & 31)) : R;
        voffA[i] = (unsigned)(R * g.lda + C) * 2u; voffB[i] = (unsigned)(Rb * K + C) * 2u; }
    const size_t kstep = (size_t)(BK * 2);
    const size_t hstepB = (size_t)HALF * K * 2, hstepA = (size_t)HALF * g.lda * 2;
    const size_t tstepA = 2 * hstepA, tstepB = 2 * hstepB;
    const unsigned ldsw = (unsigned)wid * 1024u;
    const int aoff = lds_byte(wr * 64 + fr, fq * 8), boff = lds_byte(wc * 32 + fr, fq * 8);
#define PG8_SA(b, h) (((b) * 2 + (h)) * HTB)
#define PG8_SB(b, h) ((4 + (b) * 2 + (h)) * HTB)
#define PG8_STAGE(bufoff, gbase, voff) do { _Pragma("unroll") for (int _i = 0; _i < 2; ++_i) \
        __builtin_amdgcn_global_load_lds((const unsigned*)((const char*)(gbase) + (voff)[_i]), (PG8_LAS unsigned*)(lds + (bufoff) + ldsw + _i * 8192), 16, 0, 0); } while (0)
#define PG8_LDA(dst, b, h) do { _Pragma("unroll") for (int m = 0; m < 4; ++m) _Pragma("unroll") for (int k = 0; k < 2; ++k) dst[m][k] = *(const PG8_LAS bf16x8*)(lds + PG8_SA(b, h) + aoff + m * 2048 + k * 1024); } while (0)
#define PG8_LDB(dst, b, h) do { _Pragma("unroll") for (int n = 0; n < 2; ++n) _Pragma("unroll") for (int k = 0; k < 2; ++k) dst[n][k] = *(const PG8_LAS bf16x8*)(lds + PG8_SB(b, h) + boff + n * 2048 + k * 1024); } while (0)
#define PG8_MMA(ai, bj, At, Bt) do { __builtin_amdgcn_s_setprio(1); _Pragma("unroll") for (int m = 0; m < 4; ++m) _Pragma("unroll") for (int n = 0; n < 2; ++n) _Pragma("unroll") for (int k = 0; k < 2; ++k) \
        acc[ai][bj][m][n] = __builtin_amdgcn_mfma_f32_16x16x32_bf16(Bt[n][k], At[m][k], acc[ai][bj][m][n], 0, 0, 0); __builtin_amdgcn_s_setprio(0); } while (0)
#define PG8_WAIT_V(n) asm volatile("s_waitcnt vmcnt(" #n ")" ::: "memory")
#define PG8_WAIT_L(n) asm volatile("s_waitcnt lgkmcnt(" #n ")" ::: "memory")
#define PG8_BAR __builtin_amdgcn_s_barrier()
#define PG8_SCHED __builtin_amdgcn_sched_barrier(0)
    Unit cur, nxt; int ui = 0;
    if (!S.next(0, cur)) return;
    f32x4 acc[2][2][4][2];
#pragma unroll
    for (int a = 0; a < 2; ++a)
#pragma unroll
        for (int b = 0; b < 2; ++b)
#pragma unroll
            for (int m = 0; m < 4; ++m)
#pragma unroll
                for (int n = 0; n < 2; ++n) acc[a][b][m][n] = (f32x4){0.f, 0.f, 0.f, 0.f};
    bf16x8 At[4][2], B0[2][2], B1[2][2];
    const char* cA = (const char*)g.A + (size_t)cur.pm * tstepA; const char* cB = (const char*)g.Bt + (size_t)cur.pn * tstepB;
    S.a_ready(cur);
    if constexpr (SP2) {
        PG8_STAGE(PG8_SB(0, 0), cB, voffB); PG8_STAGE(PG8_SB(0, 1), cB + hstepB, voffB); PG8_STAGE(PG8_SA(0, 0), cA, voffA); PG8_STAGE(PG8_SA(0, 1), cA + hstepA, voffA);
        if (wr == 1) PG8_BAR;
        PG8_WAIT_V(2); PG8_BAR;
        PG8_STAGE(PG8_SB(1, 0), cB + kstep, voffB); PG8_STAGE(PG8_SA(1, 0), cA + kstep, voffA); PG8_STAGE(PG8_SB(1, 1), cB + hstepB + kstep, voffB);
        PG8_WAIT_V(6); PG8_BAR;
    } else {
        PG8_STAGE(PG8_SB(0, 0), cB, voffB); PG8_STAGE(PG8_SA(0, 0), cA, voffA); PG8_STAGE(PG8_SB(0, 1), cB + hstepB, voffB); PG8_STAGE(PG8_SA(0, 1), cA + hstepA, voffA);
        if (wr == 1) PG8_BAR;
        PG8_WAIT_V(4); PG8_BAR;
        PG8_STAGE(PG8_SB(1, 0), cB + kstep, voffB); PG8_STAGE(PG8_SA(1, 0), cA + kstep, voffA); PG8_STAGE(PG8_SB(1, 1), cB + hstepB + kstep, voffB);
        PG8_WAIT_V(6); PG8_BAR;
    }
    for (;;) {
        const bool has_next = S.next(ui + 1, nxt);
        const char* nA = has_next ? (const char*)g.A + (size_t)nxt.pm * tstepA : cA; const char* nB = has_next ? (const char*)g.Bt + (size_t)nxt.pn * tstepB : cB;
        for (int t = 0; t < nt; t += 2) {
            const bool last = (t == nt - 2);
            const char* a1 = cA + (size_t)(t + 1) * kstep;
            const char* a2 = last ? nA : cA + (size_t)(t + 2) * kstep; const char* b2 = last ? nB : cB + (size_t)(t + 2) * kstep;
            const char* a3 = a2 + kstep; const char* b3 = b2 + kstep;
            if (last && has_next) S.a_ready(nxt);
            if constexpr (SP2) {
            PG8_LDB(B0, 0, 0); PG8_LDB(B1, 0, 1); PG8_SCHED; PG8_LDA(At, 0, 0); PG8_STAGE(PG8_SA(1, 1), a1 + hstepA, voffA);
            PG8_WAIT_V(8); PG8_WAIT_L(0); PG8_BAR; PG8_MMA(0, 0, At, B0); PG8_MMA(0, 1, At, B1); PG8_BAR; PG8_SCHED;
            PG8_LDA(At, 0, 1); PG8_STAGE(PG8_SB(0, 0), b2, voffB); PG8_STAGE(PG8_SB(0, 1), b2 + hstepB, voffB); PG8_STAGE(PG8_SA(0, 0), a2, voffA);
            PG8_WAIT_V(8); PG8_WAIT_L(0); PG8_BAR; PG8_MMA(1, 0, At, B0); PG8_MMA(1, 1, At, B1); PG8_BAR; PG8_SCHED;
            PG8_LDB(B0, 1, 0); PG8_LDB(B1, 1, 1); PG8_SCHED; PG8_LDA(At, 1, 0); PG8_STAGE(PG8_SA(0, 1), a2 + hstepA, voffA);
            PG8_WAIT_V(8); PG8_WAIT_L(0); PG8_BAR; PG8_MMA(0, 0, At, B0); PG8_MMA(0, 1, At, B1); PG8_BAR; PG8_SCHED;
            PG8_LDA(At, 1, 1); PG8_STAGE(PG8_SB(1, 0), b3, voffB); PG8_STAGE(PG8_SB(1, 1), b3 + hstepB, voffB); PG8_STAGE(PG8_SA(1, 0), a3, voffA);
            PG8_WAIT_V(8); PG8_WAIT_L(0); PG8_BAR; PG8_MMA(1, 0, At, B0); PG8_MMA(1, 1, At, B1); PG8_BAR; PG8_SCHED;
            } else {
            PG8_LDB(B0, 0, 0); PG8_SCHED; PG8_LDA(At, 0, 0); PG8_STAGE(PG8_SA(1, 1), a1 + hstepA, voffA);
            PG8_WAIT_L(8); PG8_BAR; PG8_WAIT_L(0); PG8_MMA(0, 0, At, B0); PG8_BAR; PG8_SCHED;
            PG8_LDB(B1, 0, 1); PG8_STAGE(PG8_SB(0, 0), b2, voffB);
            PG8_BAR; PG8_WAIT_L(0); PG8_MMA(0, 1, At, B1); PG8_BAR;
            PG8_LDA(At, 0, 1); PG8_STAGE(PG8_SA(0, 0), a2, voffA);
            PG8_BAR; PG8_WAIT_L(0); PG8_MMA(1, 0, At, B0); PG8_BAR; PG8_SCHED;
            PG8_STAGE(PG8_SB(0, 1), b2 + hstepB, voffB);
            PG8_WAIT_V(6); PG8_BAR; PG8_MMA(1, 1, At, B1); PG8_BAR;
            PG8_LDB(B0, 1, 0); PG8_SCHED; PG8_LDA(At, 1, 0); PG8_STAGE(PG8_SA(0, 1), a2 + hstepA, voffA);
            PG8_WAIT_L(8); PG8_BAR; PG8_WAIT_L(0); PG8_MMA(0, 0, At, B0); PG8_BAR; PG8_SCHED;
            PG8_LDB(B1, 1, 1); PG8_STAGE(PG8_SB(1, 0), b3, voffB);
            PG8_BAR; PG8_WAIT_L(0); PG8_MMA(0, 1, At, B1); PG8_BAR;
            PG8_LDA(At, 1, 1); PG8_STAGE(PG8_SA(1, 0), a3, voffA);
            PG8_BAR; PG8_WAIT_L(0); PG8_MMA(1, 0, At, B0); PG8_BAR; PG8_SCHED;
            PG8_STAGE(PG8_SB(1, 1), b3 + hstepB, voffB);
            PG8_WAIT_V(6); PG8_BAR; PG8_MMA(1, 1, At, B1); PG8_BAR;
            }
        }
        if constexpr (ALIGN_EPI) { if (wr == 0) PG8_BAR; }
        if constexpr (!Epi::AFTER_DRAIN) { E(acc, cur, wr, wc, fr, fq); S.done(cur); }
        if (!has_next) break;
#pragma unroll
        for (int a = 0; a < 2; ++a)
#pragma unroll
            for (int b = 0; b < 2; ++b)
#pragma unroll
                for (int m = 0; m < 4; ++m)
#pragma unroll
                    for (int n = 0; n < 2; ++n) acc[a][b][m][n] = (f32x4){0.f, 0.f, 0.f, 0.f};
        cur = nxt; cA = nA; cB = nB; ++ui;
        if constexpr (ALIGN_EPI) { if (wr == 1) PG8_BAR; }
    }
    PG8_WAIT_V(0);
    if constexpr (!ALIGN_EPI) { if (wr == 0) PG8_BAR; }
    PG8_BAR;
    if constexpr (Epi::AFTER_DRAIN) { E.fused(acc, cur, wr, wc, fr, fq, lds, wid, lane); S.done(cur); }
#undef PG8_SA
#undef PG8_SB
#undef PG8_STAGE
#undef PG8_LDA
#undef PG8_LDB
#undef PG8_MMA
#undef PG8_WAIT_V
#undef PG8_WAIT_L
#undef PG8_BAR
#undef PG8_SCHED
}
}
#define LAS __attribute__((address_space(3)))
#define XB_TMO      128
#define XB_XCNT(j)  (256  + 64 * (j))
#define XB_XSUB(j)  (1280 + 64 * (j))
#define XB_XGEN(j)  (2304 + 64 * (j))
#define XB_TOP      3328
#define XB_TOPGEN   3392
#define XCD_BAR_WORDS 3456
#define XB_SPIN_CAP (1u << 18)

__device__ __forceinline__ unsigned xb_ld(unsigned* p)              { return __hip_atomic_load(p, __ATOMIC_RELAXED, __HIP_MEMORY_SCOPE_AGENT); }
__device__ __forceinline__ unsigned xb_add(unsigned* p, unsigned v) { return __hip_atomic_fetch_add(p, v, __ATOMIC_RELAXED, __HIP_MEMORY_SCOPE_AGENT); }
__device__ __forceinline__ unsigned xb_xcc_id() { return (unsigned)__builtin_amdgcn_s_getreg((3 << 11) | 20) & 0xFu; }
#define XB_SPIN(cond, bar) do { unsigned _sp = 0; while (cond) { __builtin_amdgcn_s_sleep(1); \
    if ((++_sp & 255u) == 0u) { if (xb_ld(&(bar)[XB_TMO])) break; if (_sp > XB_SPIN_CAP) { atomicAdd(&(bar)[XB_TMO], 1u); break; } } } } while (0)

struct XcdBarrier {
    unsigned* bar; unsigned x;
    volatile LAS unsigned* st;
};

__device__ __forceinline__ XcdBarrier xcd_barrier_post(unsigned* bar, volatile LAS unsigned* st) {
    XcdBarrier b; b.bar = bar; b.x = xb_xcc_id(); b.st = st;
    if (threadIdx.x == 0) (void)xb_add(&bar[XB_XCNT(b.x)], 1u);
    return b;
}
__device__ __forceinline__ void xcd_barrier_complete(unsigned* bar, unsigned x, unsigned& nloc, unsigned& nx) {
    const unsigned G = gridDim.x * gridDim.y * gridDim.z;
    unsigned sum, cnt, mine, sp = 0u;
    for (;;) {
        sum = 0u; cnt = 0u; mine = 0u;
#pragma unroll
        for (unsigned j = 0; j < 16; ++j) { const unsigned c = xb_ld(&bar[XB_XCNT(j)]); sum += c; cnt += (c > 0u) ? 1u : 0u; mine = (j == x) ? c : mine; }
        if (sum == G) break;
        __builtin_amdgcn_s_sleep(1);
        if ((++sp & 255u) == 0u) { if (xb_ld(&bar[XB_TMO])) break; if (sp > XB_SPIN_CAP) { atomicAdd(&bar[XB_TMO], 1u); break; } }
    }
    nloc = mine > 0u ? mine : 1u; nx = cnt > 0u ? cnt : 1u;
}

__device__ __forceinline__ void xcd_barrier(const XcdBarrier& b) {
    asm volatile("s_waitcnt vmcnt(0)" ::: "memory");
    __syncthreads();
    if (threadIdx.x == 0) {
        unsigned* bar = b.bar;
        __builtin_amdgcn_s_waitcnt(0);
        unsigned nloc = b.st[0], nx = b.st[1];
        if (nloc == 0u) { xcd_barrier_complete(bar, b.x, nloc, nx); b.st[0] = nloc; b.st[1] = nx; }
        const unsigned old = xb_add(&bar[XB_XSUB(b.x)], 1u);
        const unsigned gen = old / nloc;
        if (old + 1u == (gen + 1u) * nloc) {
            __builtin_amdgcn_fence(__ATOMIC_RELEASE, "agent");
            asm volatile("s_waitcnt vmcnt(0)" ::: "memory");
            const unsigned og = xb_add(&bar[XB_TOP], 1u);
            const unsigned tg = og / nx;
            if (og + 1u == (tg + 1u) * nx) xb_add(&bar[XB_TOPGEN], 1u);
            else XB_SPIN(xb_ld(&bar[XB_TOPGEN]) == tg, bar);
            __builtin_amdgcn_fence(__ATOMIC_ACQUIRE, "agent");
            xb_add(&bar[XB_XGEN(b.x)], 1u);
            asm volatile("s_waitcnt vmcnt(0)" ::: "memory");
        } else {
            XB_SPIN(xb_ld(&bar[XB_XGEN(b.x)]) == gen, bar);
            __builtin_amdgcn_fence(__ATOMIC_ACQUIRE, "agent");
            asm volatile("s_waitcnt vmcnt(0)" ::: "memory");
        }
    }
    __syncthreads();
}
#undef LAS
using namespace pg8;
#define LAS __attribute__((address_space(3)))
typedef float f32x16 __attribute__((ext_vector_type(16)));
typedef unsigned u32x2 __attribute__((ext_vector_type(2)));
#define LDS_WAIT() asm volatile("s_waitcnt lgkmcnt(0)" ::: "memory")

constexpr int DM = 1024, NBATCH = 8, SEQ = 4096, MTOK = NBATCH * SEQ, DEPTH = 4, NIN = 4400, NPAD = 4608, DFF = 4096;
constexpr size_t MiB = 1u << 20;
constexpr size_t WS_ROPEC = 0, WS_ROPES = 512 * 1024, WS_CBIAS = 1 * MiB, WS_BAR = 1 * MiB + 64 * 1024;
constexpr size_t WS_W = 2 * MiB, WL_STRIDE = 33 * MiB;
constexpr size_t W_IN = 0, W_POOL = 9 * MiB, W_CK1 = W_POOL + MiB / 2, W_CV1 = W_CK1 + MiB, W_PP = W_CV1 + MiB, W_PN = W_PP + MiB,
                 W_OUT = W_PN + 2 * MiB, W_FF1 = W_OUT + 2 * MiB, W_FF2 = W_FF1 + 8 * MiB, W_CK2 = W_FF2 + 8 * MiB, W_CV2 = W_CK2 + 32 * 1024;
constexpr size_t WS_SS = 134 * MiB;
constexpr size_t WS_XN = 136 * MiB;
constexpr size_t WS_CK = 200 * MiB, WS_CVT = WS_CK + MiB / 2, WS_HIDK = 201 * MiB, WS_HIDV = 203 * MiB;
constexpr size_t WS_U = 206 * MiB, WS_Q = 238 * MiB, WS_KC = 302 * MiB, WS_VC = 310 * MiB, WS_KS = 318 * MiB, WS_VS = 326 * MiB, WS_KW = 334 * MiB,
                 WS_VW = 342 * MiB, WS_VST = 350 * MiB, WS_VWT = 358 * MiB, WS_GNSA = 366 * MiB, WS_GM = 370 * MiB;
constexpr size_t WS_H = 206 * MiB;
constexpr size_t WS_PPF = 500 * MiB;
constexpr size_t WS_END = 504 * MiB;
constexpr int LDS_BYTES = 135168;

__device__ __forceinline__ int launder_s(int i) { i = __builtin_amdgcn_readfirstlane(i); asm volatile("" : "+s"(i)); return i; }
#define GAS1 __attribute__((address_space(1)))
#define AIN(a, i) ((const float*)(const GAS1 float*)((a).in[launder_s(i)]))
struct Args { const float* in[18]; float* out; unsigned char* ws; double invf[32]; int ph_lo, ph_hi; };

__device__ __forceinline__ float bf2f(unsigned short u) { return __uint_as_float((unsigned)u << 16); }
__device__ __forceinline__ float bflo(unsigned w) { return __uint_as_float(w << 16); }
__device__ __forceinline__ float bfhi(unsigned w) { return __uint_as_float(w & 0xffff0000u); }
__device__ __forceinline__ unsigned short f2bf(float f) { return (unsigned short)(cvt_pk_bf16(f, f) & 0xffffu); }
__device__ __forceinline__ float wave_sum(float v) {
#pragma unroll
    for (int o = 1; o < 64; o <<= 1) v += __shfl_xor(v, o);
    return v;
}
__device__ __forceinline__ float sigmoidf_(float x) { return __builtin_amdgcn_rcpf(1.0f + __builtin_amdgcn_exp2f(-1.4426950408889634f * x)); }
__device__ __forceinline__ f32x4 sigmoid4(f32x4 v) { return (f32x4){sigmoidf_(v[0]), sigmoidf_(v[1]), sigmoidf_(v[2]), sigmoidf_(v[3])}; }
__device__ __forceinline__ float gelu_tanh(float x) {
    const float y = 0.7978845608028654f * (x + 0.044715f * x * x * x);
    const float e = __builtin_amdgcn_exp2f(2.0f * 1.4426950408889634f * y);
    const float th = 1.0f - 2.0f * __builtin_amdgcn_rcpf(1.0f + e);
    return 0.5f * x * (1.0f + th);
}
__device__ __forceinline__ void store8(bf16_t* dst, f32x4 v0, f32x4 v1) {
    u32x4 w; w.x = cvt_pk_bf16(v0[0], v0[1]); w.y = cvt_pk_bf16(v0[2], v0[3]); w.z = cvt_pk_bf16(v1[0], v1[1]); w.w = cvt_pk_bf16(v1[2], v1[3]);
    *(u32x4*)dst = w;
}

template <class T, class = void> struct has_pair : std::false_type {};
template <class T> struct has_pair<T, std::void_t<decltype(T::HAS_PAIR)>> : std::true_type {};
template <class Op, bool RS = false> struct EpiP {
    static constexpr bool PERM = true, AFTER_DRAIN = false; Op op; const float* ss;
    __device__ __forceinline__ void operator()(const f32x4 (&acc)[2][2][4][2], const Unit& u, int wr, int wc, int fr, int fq) const {
#pragma unroll
        for (int ai = 0; ai < 2; ++ai) {
            const int row0 = u.pm * 256 + ai * 128 + wr * 64 + fr; float r[4] = {1.0f, 1.0f, 1.0f, 1.0f};
            if (RS) { f32x4 t[4][4];
#pragma unroll
                for (int m = 0; m < 4; ++m) { const f32x4* sp = (const f32x4*)(ss + (size_t)(row0 + m * 16) * 16);
#pragma unroll
                    for (int k = 0; k < 4; ++k) t[m][k] = sp[k]; }
#pragma unroll
                for (int m = 0; m < 4; ++m) { const f32x4 q = (t[m][0] + t[m][1]) + (t[m][2] + t[m][3]); r[m] = 1.0f / sqrtf(((q.x + q.y) + (q.z + q.w)) * (1.0f / 1024.0f) + 1e-6f); } }
            if constexpr (has_pair<Op>::value) { if (op.is_pair(u.pn)) {
#pragma unroll
                for (int m = 0; m < 4; ++m) op.apply_pair(u.pn, row0 + m * 16, wc, fq, acc[ai][0][m][0] * r[m], acc[ai][0][m][1] * r[m], acc[ai][1][m][0] * r[m], acc[ai][1][m][1] * r[m]);
                continue; } }
            typename Op::Pre pre[4][2];
#pragma unroll
            for (int m = 0; m < 4; ++m)
#pragma unroll
                for (int bj = 0; bj < 2; ++bj) pre[m][bj] = op.load(u.pn, row0 + m * 16, bj * 128 + wc * 32 + 8 * fq);
#pragma unroll
            for (int m = 0; m < 4; ++m)
#pragma unroll
                for (int bj = 0; bj < 2; ++bj) op.apply(u.pn, row0 + m * 16, bj * 128 + wc * 32 + 8 * fq, acc[ai][bj][m][0] * r[m], acc[ai][bj][m][1] * r[m], pre[m][bj]);
        }
    }
};
struct EpiResid {
    static constexpr bool PERM = true, AFTER_DRAIN = false; bf16_t* xb; float* ss;
    __device__ __forceinline__ void operator()(const f32x4 (&acc)[2][2][4][2], const Unit& u, int wr, int wc, int fr, int fq) const {
#pragma unroll
        for (int ai = 0; ai < 2; ++ai) {
            const int row0 = u.pm * 256 + ai * 128 + wr * 64 + fr; const int col0 = u.pn * 256 + wc * 32 + 8 * fq;
            u32x4 xv[4][2];
#pragma unroll
            for (int m = 0; m < 4; ++m)
#pragma unroll
                for (int bj = 0; bj < 2; ++bj) xv[m][bj] = *(const u32x4*)(xb + (size_t)(row0 + m * 16) * 1024 + col0 + bj * 128);
#pragma unroll
            for (int m = 0; m < 4; ++m) { const int row = row0 + m * 16; float sq = 0.f;
#pragma unroll
                for (int bj = 0; bj < 2; ++bj) { const size_t o = (size_t)row * 1024 + col0 + bj * 128; const u32x4 x = xv[m][bj];
                    const f32x4 v0 = (f32x4){bflo(x.x), bfhi(x.x), bflo(x.y), bfhi(x.y)} + acc[ai][bj][m][0], v1 = (f32x4){bflo(x.z), bfhi(x.z), bflo(x.w), bfhi(x.w)} + acc[ai][bj][m][1];
                    store8(xb + o, v0, v1);
                    sq += ((v0.x * v0.x + v0.y * v0.y) + (v0.z * v0.z + v0.w * v0.w)) + ((v1.x * v1.x + v1.y * v1.y) + (v1.z * v1.z + v1.w * v1.w)); }
                sq += __shfl_xor(sq, 16); sq += __shfl_xor(sq, 32);
                if (fq == 0) ss[(size_t)row * 16 + u.pn * 4 + wc] = sq; }
        }
    }
};
__device__ __forceinline__ constexpr int PIperm(int p) { return (p & ~12) | ((p & 8) >> 1) | ((p & 4) << 1); }
struct NoPre {};
struct OpProj { unsigned char* ws; typedef NoPre Pre; static constexpr bool HAS_PAIR = true;
    __device__ __forceinline__ bool is_pair(int pn) const { return pn == 7 || (pn >= 2 && pn < 6); }
    __device__ __forceinline__ void apply_pair(int pn, int row, int wc, int fq, f32x4 a0, f32x4 a1, f32x4 b0, f32x4 b1) const {
        const unsigned g = wc & 1, d0 = 8 * fq, b = (unsigned)row >> 12, t = row & 4095;
        const unsigned ro = (t * 32 + d0) * 4;
        const unsigned ko = (pn == 7) ? (unsigned)((wc >> 1) ? WS_KW : WS_KS) + (((b * 2 + g) * 4096 + t) * 64 + d0) * 2
                                      : (unsigned)WS_Q + ((unsigned)row * 1024u + (unsigned)((pn - 2) * 4 + wc) * 64u + d0) * 2;
        { const f32x4 c0 = *(const f32x4*)(ws + WS_ROPEC + ro), s0 = *(const f32x4*)(ws + WS_ROPES + ro);
          const f32x4 y1 = a0 * c0 - b0 * s0, y2 = b0 * c0 + a0 * s0; u32x2 w1, w2; w1.x = cvt_pk_bf16(y1[0], y1[1]); w1.y = cvt_pk_bf16(y1[2], y1[3]); w2.x = cvt_pk_bf16(y2[0], y2[1]); w2.y = cvt_pk_bf16(y2[2], y2[3]);
          *(u32x2*)(ws + ko) = w1; *(u32x2*)(ws + ko + 64) = w2; }
        { const f32x4 c1 = *(const f32x4*)(ws + WS_ROPEC + ro + 16), s1 = *(const f32x4*)(ws + WS_ROPES + ro + 16);
          const f32x4 y1 = a1 * c1 - b1 * s1, y2 = b1 * c1 + a1 * s1; u32x2 w1, w2; w1.x = cvt_pk_bf16(y1[0], y1[1]); w1.y = cvt_pk_bf16(y1[2], y1[3]); w2.x = cvt_pk_bf16(y2[0], y2[1]); w2.y = cvt_pk_bf16(y2[2], y2[3]);
          *(u32x2*)(ws + ko + 8) = w1; *(u32x2*)(ws + ko + 72) = w2; }
    }
    __device__ __forceinline__ Pre load(int, int, int) const { return Pre{}; }
    __device__ __forceinline__ void apply(int pn, int row, int lc, f32x4 v0, f32x4 v1, const Pre&) const {
        size_t off; bool sig = false;
        if (pn < 2) off = WS_U + ((size_t)row * 512 + pn * 256 + lc) * 2;
        else if (pn < 6) off = WS_Q + ((size_t)row * 1024 + (pn - 2) * 256 + lc) * 2;
        else if (pn == 6) { const int c = lc & 127, g = c >> 6, dh = c & 63, b = row >> 12, t = row & 4095;
            off = WS_KC + (size_t)(lc >> 7) * (8 * MiB) + (((size_t)((b * 2 + g) * 4096 + t)) * 64 + dh) * 2; }
        else if (pn == 8) {
            const int c = lc & 127, g = c >> 6, dh = c & 63, b = row >> 12, t = row & 4095;
            bf16_t* vt = (bf16_t*)(ws + ((lc >> 7) ? WS_VWT : WS_VST)) + ((size_t)(b * 2 + g) * 64 + (t >> 6)) * 4096 + dh * 64 + PIperm(t & 63);
#pragma unroll
            for (int j = 0; j < 4; ++j) { vt[j * 64] = f2bf(v0[j]); vt[(4 + j) * 64] = f2bf(v1[j]); }
            return; }
        else if (pn == 7) return;
        else if (pn == 9) { if (lc >= 64) return; off = WS_GNSA + ((size_t)row * 64 + lc) * 2; sig = true; }
        else {
            v0 = sigmoid4(v0); v1 = sigmoid4(v1); u32x2 w;
            w.x = (unsigned)(v0[0] * 255.0f + 0.5f) | ((unsigned)(v0[1] * 255.0f + 0.5f) << 8) | ((unsigned)(v0[2] * 255.0f + 0.5f) << 16) | ((unsigned)(v0[3] * 255.0f + 0.5f) << 24);
            w.y = (unsigned)(v1[0] * 255.0f + 0.5f) | ((unsigned)(v1[1] * 255.0f + 0.5f) << 8) | ((unsigned)(v1[2] * 255.0f + 0.5f) << 16) | ((unsigned)(v1[3] * 255.0f + 0.5f) << 24);
            *(u32x2*)(ws + WS_GM + (size_t)row * 2048 + (pn - 10) * 256 + lc) = w; return; }
        if (sig) { v0 = sigmoid4(v0); v1 = sigmoid4(v1); }
        store8((bf16_t*)(ws + off), v0, v1);
    } };
struct OpBf16 { bf16_t* O; int ld; typedef NoPre Pre;
    __device__ __forceinline__ Pre load(int, int, int) const { return Pre{}; }
    __device__ __forceinline__ void apply(int pn, int row, int lc, f32x4 v0, f32x4 v1, const Pre&) const { store8(O + (size_t)row * ld + pn * 256 + lc, v0, v1); } };
struct OpCmp1 { bf16_t* H; const float* bias; struct Pre { f32x4 b0, b1; };
    __device__ __forceinline__ Pre load(int, int, int lc) const { return Pre{*(const f32x4*)(bias + lc), *(const f32x4*)(bias + lc + 4)}; }
    __device__ __forceinline__ void apply(int pn, int row, int lc, f32x4 v0, f32x4 v1, const Pre& p) const {
        v0 += p.b0; v1 += p.b1;
#pragma unroll
        for (int i = 0; i < 4; ++i) { v0[i] = gelu_tanh(v0[i]); v1[i] = gelu_tanh(v1[i]); }
        store8(H + (size_t)row * 256 + lc, v0, v1);
    } };
__device__ __forceinline__ void ungate8(u32x2 g, float (&f)[8]) { constexpr float k = 1.0f / 255.0f;
    f[0] = (float)(g.x & 255u) * k; f[1] = (float)((g.x >> 8) & 255u) * k; f[2] = (float)((g.x >> 16) & 255u) * k; f[3] = (float)(g.x >> 24) * k;
    f[4] = (float)(g.y & 255u) * k; f[5] = (float)((g.y >> 8) & 255u) * k; f[6] = (float)((g.y >> 16) & 255u) * k; f[7] = (float)(g.y >> 24) * k; }
struct OpMerge1 { const unsigned char* G8; bf16_t* MG; struct Pre { u32x2 g; };
    __device__ __forceinline__ Pre load(int pn, int row, int lc) const { return Pre{*(const u32x2*)(G8 + (size_t)row * 2048 + pn * 256 + lc)}; }
    __device__ __forceinline__ void apply(int pn, int row, int lc, f32x4 v0, f32x4 v1, const Pre& p) const {
        float g[8]; ungate8(p.g, g);
#pragma unroll
        for (int i = 0; i < 4; ++i) { v0[i] *= g[i]; v1[i] *= g[4 + i]; }
        store8(MG + (size_t)row * 1024 + pn * 256 + lc, v0, v1);
    } };
struct OpMerge2 { const unsigned char* G8; bf16_t* MG; struct Pre { u32x4 t; u32x2 g; };
    __device__ __forceinline__ Pre load(int pn, int row, int lc) const { return Pre{*(const u32x4*)(MG + (size_t)row * 1024 + pn * 256 + lc), *(const u32x2*)(G8 + (size_t)row * 2048 + 1024 + pn * 256 + lc)}; }
    __device__ __forceinline__ void apply(int pn, int row, int lc, f32x4 v0, f32x4 v1, const Pre& p) const {
        const u32x4 t = p.t; float g[8]; ungate8(p.g, g);
        v0[0] = v0[0] * g[0] + bflo(t.x); v0[1] = v0[1] * g[1] + bfhi(t.x); v0[2] = v0[2] * g[2] + bflo(t.y); v0[3] = v0[3] * g[3] + bfhi(t.y);
        v1[0] = v1[0] * g[4] + bflo(t.z); v1[1] = v1[1] * g[5] + bfhi(t.z); v1[2] = v1[2] * g[6] + bflo(t.w); v1[3] = v1[3] * g[7] + bfhi(t.w);
        store8(MG + (size_t)row * 1024 + pn * 256 + lc, v0, v1);
    } };
struct OpFF1 { bf16_t* H; typedef NoPre Pre;
    __device__ __forceinline__ Pre load(int, int, int) const { return Pre{}; }
    __device__ __forceinline__ void apply(int pn, int row, int lc, f32x4 v0, f32x4 v1, const Pre&) const {
#pragma unroll
        for (int i = 0; i < 4; ++i) { const float a = fmaxf(v0[i], 0.f), b = fmaxf(v1[i], 0.f); v0[i] = a * a; v1[i] = b * b; }
        store8(H + (size_t)row * 4096 + pn * 256 + lc, v0, v1);
    } };
struct EpiNull { static constexpr bool PERM = true, AFTER_DRAIN = false;
    __device__ __forceinline__ void operator()(const f32x4 (&acc)[2][2][4][2], const Unit& u, int wr, int wc, int fr, int fq) const {
#pragma unroll
        for (int ai = 0; ai < 2; ++ai)
#pragma unroll
            for (int bj = 0; bj < 2; ++bj)
#pragma unroll
                for (int m = 0; m < 4; ++m)
#pragma unroll
                    for (int n = 0; n < 2; ++n) asm volatile("" :: "v"(acc[ai][bj][m][n]));
    } };
template <class Epi> __device__ __forceinline__ void run_gemm(LAS unsigned char* lds, const bf16_t* A, int lda, const bf16_t* Bt, int M, int N, int K, const Epi& E, int G, int c) {
    Gemm g{A, Bt, M, N, K, lda}; StaticOrder S; S.init(M, N, G, c);
    gemm_phase<Epi, StaticOrder, true, true>(lds, g, S, E);
}

template <class F> __device__ __forceinline__ void conv_tile(F f, bf16_t* WT, int K, int n0, int k0, LAS float* scr, int lane) {
    float tv[32];
#pragma unroll
    for (int i = 0; i < 32; ++i) tv[i] = f(k0 + 2 * i + (lane >> 5), n0 + (lane & 31));
#pragma unroll
    for (int i = 0; i < 32; ++i) scr[(2 * i + (lane >> 5)) * 33 + (lane & 31)] = tv[i];
    LDS_WAIT(); asm volatile("" ::: "memory");
    const int c = lane & 7;
#pragma unroll
    for (int j = 0; j < 4; ++j) { const int n = (lane >> 3) + 8 * j; const LAS float* s = scr + (8 * c) * 33 + n;
        u32x4 o; o.x = cvt_pk_bf16(s[0 * 33], s[1 * 33]); o.y = cvt_pk_bf16(s[2 * 33], s[3 * 33]); o.z = cvt_pk_bf16(s[4 * 33], s[5 * 33]); o.w = cvt_pk_bf16(s[6 * 33], s[7 * 33]);
        *(u32x4*)(WT + (size_t)(n0 + n) * K + k0 + 8 * c) = o; }
    LDS_WAIT(); asm volatile("" ::: "memory");
}
struct FPlain { const float* W; int N; __device__ __forceinline__ float operator()(int k, int n) const { return W[(size_t)k * N + n]; } };
struct FWin { const float* W; const float* gk; __device__ __forceinline__ float operator()(int k, int p) const {
    int src;
    if (p < 512 || (p >= 1536 && p < 1792)) src = p;
    else if (p < 1536) { const int lc = (p - 512) & 255, tl = (p - 512) >> 8, bj = lc >> 7, wc = (lc >> 5) & 3, r = lc & 31;
        src = 512 + (tl * 4 + wc) * 64 + bj * 32 + r; }
    else if (p < 2048) { const int lc = p - 1792, bj = lc >> 7, wc = (lc >> 5) & 3, r = lc & 31;
        src = ((wc >> 1) ? 2048 : 1792) + (wc & 1) * 64 + bj * 32 + r; }
    else if (p < 2304) { const int lc = p - 2048; src = (lc < 128) ? 1920 + lc : 2176 + (lc - 128); }
    else if (p < 2352) src = p; else if (p < 2560) src = -1; else src = p - 208; return src < 0 ? 0.f : W[(size_t)k * NIN + src] * gk[k]; } };
struct FPlainG { const float* W; int N; const float* gk; __device__ __forceinline__ float operator()(int k, int n) const { return W[(size_t)k * N + n] * gk[k]; } };
struct FPool { const float* W; const float* sc; __device__ __forceinline__ float operator()(int j, int k) const {
    return ((k >> 7) == (j >> 7)) ? W[(k >> 7) * 16384 + (k & 127) * 128 + (j & 127)] * sc[j] : 0.f; } };

__device__ __forceinline__ void rms_row_out(const bf16_t* xrow, const float* g, float* orow, int lane) {
    const u32x2* xr = (const u32x2*)xrow + lane; const f32x4* gr = (const f32x4*)g + lane;
    f32x4 v[4]; float s = 0.f;
#pragma unroll
    for (int j = 0; j < 4; ++j) { const u32x2 w = xr[64 * j]; v[j] = (f32x4){bflo(w.x), bfhi(w.x), bflo(w.y), bfhi(w.y)}; s += (v[j].x * v[j].x + v[j].y * v[j].y) + (v[j].z * v[j].z + v[j].w * v[j].w); }
    const float r = 1.0f / sqrtf(wave_sum(s) * (1.0f / 1024.0f) + 1e-6f);
    f32x4* o = (f32x4*)orow + lane;
#pragma unroll
    for (int j = 0; j < 4; ++j) { const f32x4 gg = gr[64 * j]; o[64 * j] = (v[j] * r) * gg; }
}
struct Ctx { LAS unsigned char* lds; unsigned char* ws; int tid, lane, wave, G, bx, gw, NGW; };

__device__ __forceinline__ void ph_prologue(const Args& a, const Ctx& C) {
    unsigned char* ws = C.ws;
    { float* rc = (float*)(ws + WS_ROPEC); float* rs = (float*)(ws + WS_ROPES);
      for (int idx = C.bx * 512 + C.tid; idx < SEQ * 32; idx += C.G * 512) {
        const int t = idx >> 5, i = idx & 31; const double ang = (double)t * a.invf[i];
        const double k = rint(ang * 0.15915494309189535); double r = fma(-k, 6.283185307179586, ang); r = fma(-k, 2.4492935982947064e-16, r);
        const double r2 = r * r; double s = 1.0, c = 1.0;
#pragma unroll
        for (int n = 15; n >= 1; --n) { s = 1.0 - r2 * (1.0 / (double)((2 * n) * (2 * n + 1))) * s; c = 1.0 - r2 * (1.0 / (double)((2 * n - 1) * (2 * n))) * c; }
        rc[idx] = (float)c; rs[idx] = (float)(r * s);
      } }
    LAS float* scr = (LAS float*)(C.lds + C.wave * 8448);
    constexpr int I_IN = 16 * 144, I_POOL = 8 * 16, I_CK = 32 * 8, I_PP = 8 * 32, I_PN = 16 * 32, I_OUT = 16 * 32, I_FF1 = 16 * 128, I_FF2 = 64 * 32, I_C2 = 4 * 2;
    constexpr int NITEMS = I_IN + I_POOL + 2 * I_CK + I_PP + I_PN + I_OUT + I_FF1 + I_FF2 + 2 * I_C2;
    for (int it = C.gw; it < DEPTH * NITEMS; it += C.NGW) {
        const int l = it / NITEMS; int r = it - l * NITEMS; unsigned char* wl = ws + WS_W + (size_t)l * WL_STRIDE;
        if (r < I_IN) { conv_tile(FWin{AIN(a, 2) + (size_t)l * DM * NIN, AIN(a, 1) + (size_t)l * 1024}, (bf16_t*)(wl + W_IN), 1024, (r % 144) * 32, (r / 144) * 64, scr, C.lane); continue; } r -= I_IN;
        if (r < I_POOL) { conv_tile(FPool{AIN(a, 3) + (size_t)l * 65536, AIN(a, 4) + (size_t)l * 512}, (bf16_t*)(wl + W_POOL), 512, (r % 16) * 32, (r / 16) * 64, scr, C.lane); continue; } r -= I_POOL;
        if (r < I_CK) { conv_tile(FPlain{AIN(a, 7) + (size_t)l * 2048 * 256, 256}, (bf16_t*)(wl + W_CK1), 2048, (r % 8) * 32, (r / 8) * 64, scr, C.lane); continue; } r -= I_CK;
        if (r < I_CK) { conv_tile(FPlain{AIN(a, 9) + (size_t)l * 2048 * 256, 256}, (bf16_t*)(wl + W_CV1), 2048, (r % 8) * 32, (r / 8) * 64, scr, C.lane); continue; } r -= I_CK;
        if (r < I_PP) { conv_tile(FPlain{AIN(a, 11) + (size_t)l * 512 * 1024, 1024}, (bf16_t*)(wl + W_PP), 512, (r % 32) * 32, (r / 32) * 64, scr, C.lane); continue; } r -= I_PP;
        if (r < I_PN) { conv_tile(FPlain{AIN(a, 12) + (size_t)l * 1024 * 1024, 1024}, (bf16_t*)(wl + W_PN), 1024, (r % 32) * 32, (r / 32) * 64, scr, C.lane); continue; } r -= I_PN;
        if (r < I_OUT) { conv_tile(FPlain{AIN(a, 13) + (size_t)l * 1024 * 1024, 1024}, (bf16_t*)(wl + W_OUT), 1024, (r % 32) * 32, (r / 32) * 64, scr, C.lane); continue; } r -= I_OUT;
        if (r < I_FF1) { conv_tile(FPlainG{AIN(a, 15) + (size_t)l * 1024 * 4096, 4096, AIN(a, 14) + (size_t)l * 1024}, (bf16_t*)(wl + W_FF1), 1024, (r % 128) * 32, (r / 128) * 64, scr, C.lane); continue; } r -= I_FF1;
        if (r < I_FF2) { conv_tile(FPlain{AIN(a, 16) + (size_t)l * 4096 * 1024, 1024}, (bf16_t*)(wl + W_FF2), 4096, (r % 32) * 32, (r / 32) * 64, scr, C.lane); continue; } r -= I_FF2;
        if (r < I_C2) { conv_tile(FPlain{AIN(a, 8) + (size_t)l * 256 * 64, 64}, (bf16_t*)(wl + W_CK2), 256, (r % 2) * 32, (r / 2) * 64, scr, C.lane); continue; } r -= I_C2;
        conv_tile(FPlain{AIN(a, 10) + (size_t)l * 256 * 64, 64}, (bf16_t*)(wl + W_CV2), 256, (r % 2) * 32, (r / 2) * 64, scr, C.lane);
    }
    { float* cb = (float*)(ws + WS_CBIAS);
      for (int it = C.gw; it < DEPTH * 512; it += C.NGW) { const int l = it >> 9, kv = (it >> 8) & 1, n = it & 255; const float* pe = AIN(a, kv ? 6 : 5) + (size_t)l * 2048; const float* w1 = AIN(a, kv ? 9 : 7) + (size_t)l * 2048 * 256;
          float s = 0.f; for (int kk = C.lane; kk < 2048; kk += 64) s += pe[kk] * w1[(size_t)kk * 256 + n];
          s = wave_sum(s); if (C.lane == 0) cb[it] = s; } }
    { const float* x = AIN(a, 0); bf16_t* XB = (bf16_t*)(ws + WS_XN); float* SS = (float*)(ws + WS_SS); const int lane = C.lane;
      for (int m = C.gw; m < MTOK; m += C.NGW) {
        const f32x4* xr = (const f32x4*)(x + (size_t)m * 1024) + lane; u32x2* o8 = (u32x2*)(XB + (size_t)m * 1024) + lane; float sq = 0.f;
#pragma unroll
        for (int j = 0; j < 4; ++j) { const f32x4 v = xr[64 * j]; sq += (v.x * v.x + v.y * v.y) + (v.z * v.z + v.w * v.w); u32x2 w; w.x = cvt_pk_bf16(v.x, v.y); w.y = cvt_pk_bf16(v.z, v.w); o8[64 * j] = w; }
        sq = wave_sum(sq); if (lane < 16) SS[(size_t)m * 16 + lane] = (lane == 0) ? sq : 0.f;
      } }
}

__device__ __forceinline__ void vt_tile(const bf16_t* src, bf16_t* dst, int lane) {
    unsigned pk[32];
#pragma unroll
    for (int pos = 0; pos < 64; pos += 2) { const int kv0 = PIperm(pos); const unsigned lo = src[kv0 * 64 + lane], hi = src[(kv0 + 1) * 64 + lane]; pk[pos >> 1] = lo | (hi << 16); }
    u32x4* d = (u32x4*)(dst + lane * 64);
#pragma unroll
    for (int j = 0; j < 8; ++j) d[j] = (u32x4){pk[4 * j], pk[4 * j + 1], pk[4 * j + 2], pk[4 * j + 3]};
}
__device__ __forceinline__ void ph_post(const Ctx& C, bool do_rope, const int pgw, const int pngw, bf16_t* Dbuf) {
    unsigned char* ws = C.ws; const int lane = C.lane;
    const float* rc = (const float*)(ws + WS_ROPEC); const float* rs = (const float*)(ws + WS_ROPES);
    if (do_rope) for (int it = pgw; it < 2 * 16 * 4096 / 8; it += pngw) {
        const int rr = it * 8 + (lane >> 3); bf16_t* base = (bf16_t*)(ws + (rr < 65536 ? WS_KS : WS_KW)); const int r = rr & 65535, t = r & 4095, d0 = (lane & 7) * 4;
        bf16_t* p = base + (size_t)r * 64 + d0; const u32x2 a = *(const u32x2*)p, b = *(const u32x2*)(p + 32);
        const f32x4 c = *(const f32x4*)(rc + t * 32 + d0), s = *(const f32x4*)(rs + t * 32 + d0);
        const float x1[4] = {bflo(a.x), bfhi(a.x), bflo(a.y), bfhi(a.y)}, x2[4] = {bflo(b.x), bfhi(b.x), bflo(b.y), bfhi(b.y)};
        float y1[4], y2[4];
#pragma unroll
        for (int i = 0; i < 4; ++i) { y1[i] = x1[i] * c[i] - x2[i] * s[i]; y2[i] = x2[i] * c[i] + x1[i] * s[i]; }
        u32x2 oa, ob; oa.x = cvt_pk_bf16(y1[0], y1[1]); oa.y = cvt_pk_bf16(y1[2], y1[3]); ob.x = cvt_pk_bf16(y2[0], y2[1]); ob.y = cvt_pk_bf16(y2[2], y2[3]);
        *(u32x2*)p = oa; *(u32x2*)(p + 32) = ob;
    }
    { const bf16_t* U = (const bf16_t*)(ws + WS_U); bf16_t* D = Dbuf;
#define UNPK8(NAME_, VEC_) const float NAME_[8] = {bflo(VEC_[0]), bfhi(VEC_[0]), bflo(VEC_[1]), bfhi(VEC_[1]), bflo(VEC_[2]), bfhi(VEC_[2]), bflo(VEC_[3]), bfhi(VEC_[3])}
      for (int it = pgw; it < MTOK / 32; it += pngw) {
        const int tt0 = it * 32, t0 = tt0 & 4095, w = 2 << (lane >> 4); const bf16_t* up = U + (size_t)tt0 * 512 + lane * 8; bf16_t* dp = D + (size_t)tt0 * 512 + lane * 8;
        float s[8] = {0.f, 0.f, 0.f, 0.f, 0.f, 0.f, 0.f, 0.f};
#pragma unroll
        for (int i = 1; i < 16; ++i) if (i < w && t0 - i >= 0) { const u32x4 v = *(const u32x4*)(up - (ptrdiff_t)i * 512); UNPK8(x, v);
#pragma unroll
            for (int j2 = 0; j2 < 8; ++j2) s[j2] += x[j2]; }
#pragma unroll 8
        for (int k = 0; k < 32; ++k) {
            const int t = t0 + k; const u32x4 v = *(const u32x4*)(up + (size_t)k * 512); UNPK8(x, v);
            const int cnt = (t + 1 < w) ? t + 1 : w; const float inv = 1.0f / (float)cnt; f32x4 d0, d1;
#pragma unroll
            for (int j2 = 0; j2 < 8; ++j2) s[j2] += x[j2];
#pragma unroll
            for (int j2 = 0; j2 < 4; ++j2) { d0[j2] = s[j2] * inv - x[j2]; d1[j2] = s[j2 + 4] * inv - x[j2 + 4]; }
            store8(dp + (size_t)k * 512, d0, d1);
            if (t - w + 1 >= 0) { const u32x4 vo = *(const u32x4*)(up + (ptrdiff_t)(k - w + 1) * 512); UNPK8(y, vo);
#pragma unroll
                for (int j2 = 0; j2 < 8; ++j2) s[j2] -= y[j2]; }
        }
      }
#undef UNPK8
    }
}

__device__ __forceinline__ constexpr int crow_c(int r) { return (r & 3) + 8 * (r >> 2); }
#define MFMA32(a, b, c) __builtin_amdgcn_mfma_f32_32x32x16_bf16((a), (b), (c), 0, 0, 0)
__device__ __forceinline__ void ph_cmp2(const Ctx& C, int l) {
    unsigned char* ws = C.ws; const int lane = C.lane, c = lane & 31, hh = lane >> 5;
    const float* rc = (const float*)(ws + WS_ROPEC); const float* rs = (const float*)(ws + WS_ROPES);
    for (int it = C.bx + C.G * C.wave; it < 256; it += C.G * 8) {
        const int kv = it >> 7, r0 = (it & 127) * 32;
        const bf16_t* hid = (const bf16_t*)(ws + (kv ? WS_HIDV : WS_HIDK)) + (size_t)(r0 + c) * 256 + hh * 8;
        const bf16_t* w2t = (const bf16_t*)(ws + WS_W + (size_t)l * WL_STRIDE + (kv ? W_CV2 : W_CK2)) + hh * 8;
        f32x16 a0 = (f32x16){}, a1 = (f32x16){};
#pragma unroll 4
        for (int ks = 0; ks < 16; ++ks) { const bf16x8 af = *(const bf16x8*)(hid + ks * 16), b0 = *(const bf16x8*)(w2t + (size_t)c * 256 + ks * 16), b1 = *(const bf16x8*)(w2t + (size_t)(c + 32) * 256 + ks * 16);
            a0 = MFMA32(af, b0, a0); a1 = MFMA32(af, b1, a1); }
#pragma unroll
        for (int r = 0; r < 16; ++r) { const int row = r0 + crow_c(r) + 4 * hh, bg = row >> 8, n = row & 255; float v0 = a0[r], v1 = a1[r];
            if (n == 255) { v0 = 0.f; v1 = 0.f; }
            if (kv == 0) { const int pos = (n == 255) ? 0 : 16 * n + 31; const float cc = rc[pos * 32 + c], sn = rs[pos * 32 + c];
                bf16_t* o = (bf16_t*)(ws + WS_CK) + (size_t)row * 64; o[c] = f2bf(v0 * cc - v1 * sn); o[c + 32] = f2bf(v1 * cc + v0 * sn); }
            else { bf16_t* o = (bf16_t*)(ws + WS_CVT) + (size_t)bg * 16384 + (n >> 6) * 4096 + PIperm(n & 63); o[c * 64] = f2bf(v0); o[(c + 32) * 64] = f2bf(v1); } }
    }
}

constexpr int SLABP = 65;
constexpr int AT_KB = 0, AT_VB = 18432, AT_SLAB = 36864, AT_SELM = AT_SLAB + 8 * 32 * SLABP * 4 + 64, AT_UNION = AT_SELM + 256, KPITCH = 144;
constexpr float SM_C = 0.125f * 1.4426950408889634f;
__device__ __forceinline__ void qk_tile(LAS const unsigned char* kb, const bf16x8 (&qf)[4], f32x16& p0, f32x16& p1, int lane) {
    LAS const unsigned char* ka = kb + (lane & 31) * KPITCH + (lane >> 5) * 16;
    p0 = (f32x16){}; p1 = (f32x16){};
#pragma unroll
    for (int ks = 0; ks < 4; ++ks) { const bf16x8 a0 = *(LAS const bf16x8*)(ka + ks * 32), a1 = *(LAS const bf16x8*)(ka + 32 * KPITCH + ks * 32);
        p0 = MFMA32(a0, qf[ks], p0); p1 = MFMA32(a1, qf[ks], p1); }
    __builtin_amdgcn_sched_group_barrier(0x100, 8, 0); __builtin_amdgcn_sched_group_barrier(0x008, 8, 0);
}
typedef float f32x2v __attribute__((ext_vector_type(2)));
__device__ __forceinline__ float fmax3(float a, float b, float c) { return fmaxf(fmaxf(a, b), c); }
__device__ __forceinline__ void attn_tile(LAS const unsigned char* kb, LAS const unsigned char* vb, const bf16x8 (&qf)[4], float& m, float& l, f32x16& o0, f32x16& o1, int lo, int hi_, int lane) {
    const int hh = lane >> 5; f32x16 p0, p1;
    qk_tile(kb, qf, p0, p1, lane);
    const bool lane_full = (lo <= 0) && (hi_ >= 63), lane_empty = lo > hi_;
    const bool simple = __all((lane_full || lane_empty) ? 1 : 0) != 0;
    if (!simple) { const int lo2 = lo - 4 * hh, hi2 = hi_ - 4 * hh;
#pragma unroll
        for (int r = 0; r < 16; ++r) { const int c0 = crow_c(r), c1 = c0 + 32; p0[r] = (c0 >= lo2 && c0 <= hi2) ? p0[r] : -INFINITY; p1[r] = (c1 >= lo2 && c1 <= hi2) ? p1[r] : -INFINITY; } }
    float mxa = fmax3(p0[0], p0[1], p1[0]), mxb = fmax3(p0[2], p0[3], p1[1]); mxa = fmax3(mxa, p1[2], p1[3]);
#pragma unroll
    for (int r = 4; r < 16; r += 4) { mxa = fmax3(mxa, p0[r], p0[r + 1]); mxb = fmax3(mxb, p0[r + 2], p0[r + 3]); mxa = fmax3(mxa, p1[r], p1[r + 1]); mxb = fmax3(mxb, p1[r + 2], p1[r + 3]); }
    float mx = fmaxf(mxa, mxb);
    const bool dead = simple && lane_empty;
    if (dead) mx = -INFINITY;
    mx = fmaxf(mx, __shfl_xor(mx, 32));
    const float mx2 = mx * SM_C;
    if (__any((mx2 > m + 8.0f) ? 1 : 0)) {
        const float mn = fmaxf(m, mx2), alpha = __builtin_amdgcn_exp2f(m - mn);
        l *= alpha; m = mn;
#pragma unroll
        for (int r = 0; r < 16; ++r) { o0[r] *= alpha; o1[r] *= alpha; }
    }
    const float neg = dead ? -INFINITY : -m;
    float sa = 0.f, sb = 0.f;
#pragma unroll
    for (int r = 0; r < 16; r += 2) {
        p0[r] = __builtin_amdgcn_exp2f(__builtin_fmaf(p0[r], SM_C, neg)); p0[r + 1] = __builtin_amdgcn_exp2f(__builtin_fmaf(p0[r + 1], SM_C, neg));
        p1[r] = __builtin_amdgcn_exp2f(__builtin_fmaf(p1[r], SM_C, neg)); p1[r + 1] = __builtin_amdgcn_exp2f(__builtin_fmaf(p1[r + 1], SM_C, neg));
        sa += p0[r] + p0[r + 1]; sb += p1[r] + p1[r + 1];
    }
    l += sa + sb;
    bf16x8 pf[4];
#pragma unroll
    for (int s = 0; s < 2; ++s) {
        u32x4 w0, w1;
        w0.x = cvt_pk_bf16(p0[8 * s + 0], p0[8 * s + 1]); w0.y = cvt_pk_bf16(p0[8 * s + 2], p0[8 * s + 3]); w0.z = cvt_pk_bf16(p0[8 * s + 4], p0[8 * s + 5]); w0.w = cvt_pk_bf16(p0[8 * s + 6], p0[8 * s + 7]);
        w1.x = cvt_pk_bf16(p1[8 * s + 0], p1[8 * s + 1]); w1.y = cvt_pk_bf16(p1[8 * s + 2], p1[8 * s + 3]); w1.z = cvt_pk_bf16(p1[8 * s + 4], p1[8 * s + 5]); w1.w = cvt_pk_bf16(p1[8 * s + 6], p1[8 * s + 7]);
        pf[s] = __builtin_bit_cast(bf16x8, w0); pf[2 + s] = __builtin_bit_cast(bf16x8, w1);
    }
    LAS const unsigned char* va = vb + (lane & 31) * KPITCH + hh * 16;
#pragma unroll
    for (int ts = 0; ts < 4; ++ts) {
        const bf16x8 v0 = *(LAS const bf16x8*)(va + ts * 32), v1 = *(LAS const bf16x8*)(va + 32 * KPITCH + ts * 32);
        o0 = MFMA32(v0, pf[ts], o0); o1 = MFMA32(v1, pf[ts], o1);
    }
    __builtin_amdgcn_sched_group_barrier(0x100, 8, 1); __builtin_amdgcn_sched_group_barrier(0x008, 8, 1);
}
template <int MODE>
__device__ __forceinline__ void run_branch(LAS unsigned char* lds, const unsigned char* Kg, const unsigned char* Vg, unsigned long long tiles, const bf16x8 (&qf)[4],
                                           float& m, float& l, f32x16& o0, f32x16& o1, int cur, int tq, int nvalid, unsigned long long selm, int tid, int lane) {
    const int soff = (tid >> 3) * KPITCH + (tid & 7) * 16;
    unsigned long long rem = tiles;
    int T = __ffsll(rem) - 1; rem &= rem - 1;
    u32x4 kr = *(const u32x4*)(Kg + (size_t)T * 8192 + tid * 16), vr = *(const u32x4*)(Vg + (size_t)T * 8192 + tid * 16);
    *(LAS u32x4*)(lds + AT_KB + soff) = kr; *(LAS u32x4*)(lds + AT_VB + soff) = vr;
    __syncthreads();
    int bi = 0;
    for (;;) {
        const bool more = rem != 0ull;
        const int Tn = more ? (__ffsll(rem) - 1) : T; rem &= rem - 1;
        kr = *(const u32x4*)(Kg + (size_t)Tn * 8192 + tid * 16); vr = *(const u32x4*)(Vg + (size_t)Tn * 8192 + tid * 16);
        int lo, hi_;
        if (MODE == 0) { lo = 0; hi_ = nvalid - 64 * T - 1; }
        else if (MODE == 1) { const bool sb = ((selm >> T) & 1ull) != 0; lo = sb ? 0 : 1; hi_ = sb ? (T < cur ? 63 : tq) : 0; }
        else { lo = (T == cur - 8) ? tq + 1 : 0; hi_ = (T == cur) ? tq : 63; }
        attn_tile(lds + AT_KB + bi * 9216, lds + AT_VB + bi * 9216, qf, m, l, o0, o1, lo, hi_, lane);
        *(LAS u32x4*)(lds + AT_KB + (bi ^ 1) * 9216 + soff) = kr; *(LAS u32x4*)(lds + AT_VB + (bi ^ 1) * 9216 + soff) = vr;
        __syncthreads();
        if (!more) break;
        T = Tn; bi ^= 1;
    }
}
__device__ __forceinline__ void ph_attn(const Ctx& C, size_t yoff) {
    unsigned char* ws = C.ws; LAS unsigned char* lds = C.lds; const int tid = C.tid, lane = C.lane, w = C.wave, q = lane & 31, hh = lane >> 5;
    bf16_t* Q = (bf16_t*)(ws + WS_Q); const bf16_t* GN = (const bf16_t*)(ws + WS_GNSA);
    LAS float* slab = (LAS float*)(lds + AT_SLAB); LAS unsigned long long* selmp = (LAS unsigned long long*)(lds + AT_SELM); LAS unsigned* unionp = (LAS unsigned*)(lds + AT_UNION);
    const int vcu = (C.G % 8 == 0) ? (C.bx % 8) * (C.G / 8) + C.bx / 8 : C.bx;
    for (int it = vcu; it < 2048; it += C.G) {
        int bg, qb;
        if (C.G == 256) { const int i = it >> 8, v = it & 255, s = v & 15; bg = v >> 4; qb = 32 * (i >> 1) + ((i & 1) ? 31 - s : s); }
        else { bg = it & 15; qb = it >> 4; }
        const int b = bg >> 1, g = bg & 1, h = g * 8 + w, t0 = qb * 32, cur = t0 >> 6, t = t0 + q, tq = t & 63;
        const size_t tokrow = (size_t)b * 4096 + t;
        bf16_t* qp = Q + tokrow * 1024 + h * 64;
        bf16x8 qf[4];
#pragma unroll
        for (int ks = 0; ks < 4; ++ks) qf[ks] = *(const bf16x8*)(qp + ks * 16 + hh * 8);
        const float gc = bf2f(GN[tokrow * 64 + h * 3 + 0]), gs = bf2f(GN[tokrow * 64 + h * 3 + 1]), gwn = bf2f(GN[tokrow * 64 + h * 3 + 2]);
        if (tid == 0) { unionp[0] = 0u; unionp[1] = 0u; }
        const int nvalid = (t >= 31) ? ((t - 15) >> 4) : 0; const int nvmax = (t0 + 16) >> 4; const int ntile = (nvmax + 63) >> 6;
        const unsigned char* CKg = ws + WS_CK + (size_t)bg * 32768; const unsigned char* CVg = ws + WS_CVT + (size_t)bg * 32768;
        float m = -1e30f, l = 0.f; f32x16 o0 = (f32x16){}, o1 = (f32x16){};
        run_branch<0>(lds, CKg, CVg, (1ull << ntile) - 1ull, qf, m, l, o0, o1, cur, tq, nvalid, 0ull, tid, lane);
        l += __shfl_xor(l, 32);
        const float invl = (l > 0.f) ? 1.0f / l : 0.f;
        f32x16 out0 = o0 * (gc * invl), out1 = o1 * (gc * invl);
        if (cur - 2 > 13) { const int soff = (tid >> 3) * KPITCH + (tid & 7) * 16; float carry = 0.f;
          u32x4 kpre = *(const u32x4*)(CKg + tid * 16);
          for (int T = 0; T < ntile; ++T) {
            *(LAS u32x4*)(lds + AT_KB + (T & 1) * 9216 + soff) = kpre;
            kpre = *(const u32x4*)(CKg + (size_t)((T + 1 < ntile) ? T + 1 : T) * 8192 + tid * 16);
            __syncthreads();
            f32x16 p0, p1; qk_tile(lds + AT_KB + (T & 1) * 9216, qf, p0, p1, lane);
            const int nrel = nvalid - 64 * T - 4 * hh;
#pragma unroll
            for (int r = 0; r < 16; ++r) { const int c0 = crow_c(r);
                p0[r] = (c0 < nrel) ? __builtin_amdgcn_exp2f(p0[r] * SM_C - m) * invl : 0.f; p1[r] = (c0 + 32 < nrel) ? __builtin_amdgcn_exp2f(p1[r] * SM_C - m) * invl : 0.f; }
            float g4[8], last[8], oth[8];
#pragma unroll
            for (int i = 0; i < 8; ++i) { const int r0 = 4 * (i & 3); if (i < 4) { g4[i] = (p0[r0] + p0[r0 + 1]) + (p0[r0 + 2] + p0[r0 + 3]); last[i] = p0[r0 + 3]; } else { g4[i] = (p1[r0] + p1[r0 + 1]) + (p1[r0 + 2] + p1[r0 + 3]); last[i] = p1[r0 + 3]; } }
#pragma unroll
            for (int i = 0; i < 8; ++i) oth[i] = __shfl_xor(last[i], 32);
#pragma unroll
            for (int i = 0; i < 8; ++i) { const float add = hh ? oth[i] : (i ? oth[i > 0 ? i - 1 : 0] : carry); slab[(w * 32 + q) * SLABP + 16 * T + 2 * i + hh] = g4[i] + add; }
            carry = oth[7];
          }
          __syncthreads(); }
        {
            const int J = lane; const bool cand = (J >= 1) && (J <= cur - 2); const bool forced = (J <= cur) && (J == 0 || J >= cur - 1);
            const unsigned long long candm = __ballot(cand ? 1 : 0), forcedm = __ballot(forced ? 1 : 0);
            unsigned vb[4]; unsigned long long selq[4];
#pragma unroll
            for (int qq = 0; qq < 4; ++qq) { const int qi = 4 * w + qq; float v = 0.f;
#pragma unroll
                for (int w2 = 0; w2 < 8; ++w2) v += slab[(w2 * 32 + qi) * SLABP + J];
                vb[qq] = cand ? __float_as_uint(v) : 0u; selq[qq] = candm; }
            if (cur - 2 > 13) {
                unsigned th[4] = {0u, 0u, 0u, 0u};
#pragma unroll 1
                for (int bit = 30; bit >= 0; --bit) {
#pragma unroll
                    for (int qq = 0; qq < 4; ++qq) { const unsigned trial = th[qq] | (1u << bit); const unsigned long long mm = __ballot((vb[qq] >= trial) ? 1 : 0) & candm; th[qq] = (__popcll(mm) >= 13) ? trial : th[qq]; }
                }
                const unsigned long long below = (lane == 0) ? 0ull : (~0ull >> (64 - lane));
#pragma unroll
                for (int qq = 0; qq < 4; ++qq) { const unsigned long long mgt = __ballot((vb[qq] > th[qq]) ? 1 : 0) & candm, meq = __ballot((vb[qq] == th[qq]) ? 1 : 0) & candm;
                    const int need = 13 - __popcll(mgt), rank = __popcll(meq & below);
                    selq[qq] = __ballot((cand && (vb[qq] > th[qq] || (vb[qq] == th[qq] && rank < need))) ? 1 : 0); }
            }
#pragma unroll
            for (int qq = 0; qq < 4; ++qq) { const unsigned long long mk = selq[qq] | forcedm;
                if (lane == 0) { selmp[4 * w + qq] = mk; atomicOr((unsigned*)&unionp[0], (unsigned)mk); atomicOr((unsigned*)&unionp[1], (unsigned)(mk >> 32)); } }
        }
        __syncthreads();
        const unsigned long long selm = selmp[q];
        const unsigned ulo = __builtin_amdgcn_readfirstlane(unionp[0]), uhi = __builtin_amdgcn_readfirstlane(unionp[1]);
        const unsigned long long uni = ((unsigned long long)uhi << 32) | ulo;
        m = -1e30f; l = 0.f; o0 = (f32x16){}; o1 = (f32x16){};
        run_branch<1>(lds, ws + WS_KS + (size_t)bg * 524288, ws + WS_VST + (size_t)bg * 524288, uni, qf, m, l, o0, o1, cur, tq, 0, selm, tid, lane);
        { l += __shfl_xor(l, 32); const float f = gs / l; out0 += o0 * f; out1 += o1 * f; }
        m = -1e30f; l = 0.f; o0 = (f32x16){}; o1 = (f32x16){};
        { const int j0 = cur - 8 > 0 ? cur - 8 : 0; const unsigned long long wm = ((cur == 63) ? ~0ull : ((1ull << (cur + 1)) - 1ull)) & ~((1ull << j0) - 1ull);
          run_branch<2>(lds, ws + WS_KW + (size_t)bg * 524288, ws + WS_VWT + (size_t)bg * 524288, wm, qf, m, l, o0, o1, cur, tq, 0, 0ull, tid, lane); }
        { l += __shfl_xor(l, 32); const float f = gwn / l; out0 += o0 * f; out1 += o1 * f; }
#pragma unroll
        for (int i = 0; i < 4; ++i) {
            u32x2 a0, a1; a0.x = cvt_pk_bf16(out0[4 * i], out0[4 * i + 1]); a0.y = cvt_pk_bf16(out0[4 * i + 2], out0[4 * i + 3]); a1.x = cvt_pk_bf16(out1[4 * i], out1[4 * i + 1]); a1.y = cvt_pk_bf16(out1[4 * i + 2], out1[4 * i + 3]);
            bf16_t* yp = (bf16_t*)((unsigned char*)qp + yoff); *(u32x2*)(yp + 8 * i + 4 * hh) = a0; *(u32x2*)(yp + 32 + 8 * i + 4 * hh) = a1;
        }
    }
}

constexpr int NPHASE = 8 * DEPTH + 2;
#ifndef ONLY_MASK
#define ONLY_MASK 0xffff
#endif
#define HAS(k) ((ONLY_MASK >> (k)) & 1)
__global__ void __launch_bounds__(512, 2) mega_fwd(Args a) {
    extern __shared__ __attribute__((aligned(16))) unsigned char lds_raw[];
    Ctx C; C.lds = (LAS unsigned char*)lds_raw; C.ws = a.ws; C.tid = threadIdx.x; C.lane = C.tid & 63; C.wave = __builtin_amdgcn_readfirstlane(C.tid >> 6);
    C.G = gridDim.x; C.bx = blockIdx.x; C.gw = C.bx * 8 + C.wave; C.NGW = C.G * 8;
    cg::grid_group grid = cg::this_grid();
    { volatile LAS unsigned* st = (volatile LAS unsigned*)(C.lds + LDS_BYTES - 64); if (C.tid < 16) st[C.tid] = 0u; __syncthreads(); }
    XcdBarrier xbar = xcd_barrier_post((unsigned*)(a.ws + WS_BAR), (volatile LAS unsigned*)(C.lds + LDS_BYTES - 64));
    unsigned char* ws = a.ws; float* X = a.out;
    int ph = 0;
#define IN_PH() (ph >= a.ph_lo && ph < a.ph_hi)
#define FRESH() do { int t_ = threadIdx.x; asm volatile("" : "+v"(t_)); C.tid = t_; C.lane = t_ & 63; C.wave = __builtin_amdgcn_readfirstlane(t_ >> 6); C.gw = C.bx * 8 + C.wave; \
    unsigned wl_ = __builtin_amdgcn_readfirstlane((unsigned)(unsigned long long)a.ws), wh_ = __builtin_amdgcn_readfirstlane((unsigned)((unsigned long long)a.ws >> 32)); asm volatile("" : "+s"(wl_), "+s"(wh_)); \
    ws = (unsigned char*)(GAS1 unsigned char*)(((unsigned long long)wh_ << 32) | wl_); C.ws = ws; \
    unsigned xl_ = __builtin_amdgcn_readfirstlane((unsigned)(unsigned long long)a.out), xh_ = __builtin_amdgcn_readfirstlane((unsigned)((unsigned long long)a.out >> 32)); asm volatile("" : "+s"(xl_), "+s"(xh_)); \
    X = (float*)(GAS1 float*)(((unsigned long long)xh_ << 32) | xl_); } while (0)
#define SEAM() do { ++ph; if (ph > a.ph_lo && ph < a.ph_hi) { if (ph == 1) grid.sync(); else xcd_barrier(xbar); } FRESH(); } while (0)
    FRESH();
    if (HAS(0) && IN_PH()) ph_prologue(a, C);
    SEAM();
    for (int l = 0; l < DEPTH; ++l) {
        const float* xin = (l == 0) ? AIN(a, 0) : X;
        unsigned char* wl = ws + WS_W + (size_t)l * WL_STRIDE;
        if (HAS(1) && IN_PH()) {
            EpiP<OpProj, true> E{OpProj{ws}, (const float*)(ws + WS_SS)};
            run_gemm(C.lds, (const bf16_t*)(ws + WS_XN), 1024, (const bf16_t*)(wl + W_IN), MTOK, NPAD, 1024, E, C.G, C.bx);
        }
        SEAM();
        if (IN_PH()) {
            const int ncc = (C.G >= 64) ? 32 : 0;
            if (l == 0 && C.bx >= ncc && C.bx < ncc + 8 * DEPTH) {
                const int ll = (C.bx - ncc) >> 3; unsigned char* wq = ws + WS_W + (size_t)ll * WL_STRIDE;
                EpiP<OpBf16> E{OpBf16{(bf16_t*)(ws + WS_PPF) + (size_t)ll * 1024 * 512, 512}, nullptr};
                run_gemm(C.lds, (const bf16_t*)(wq + W_PP), 512, (const bf16_t*)(wq + W_POOL), 1024, 512, 512, E, 8, (C.bx - ncc) & 7);
                FRESH(); wl = ws + WS_W + (size_t)l * WL_STRIDE;
            }
            if (HAS(2) && (ncc == 0 || C.bx >= ncc)) ph_post(C, false, (C.bx - ncc) * 8 + C.wave, (C.G - ncc) * 8, (bf16_t*)X);
            FRESH(); wl = ws + WS_W + (size_t)l * WL_STRIDE;
            if (HAS(4) && (ncc == 0 || C.bx < 16)) { EpiP<OpCmp1> E{OpCmp1{(bf16_t*)(ws + WS_HIDK), (const float*)(ws + WS_CBIAS) + l * 512}, nullptr}; run_gemm(C.lds, (const bf16_t*)(ws + WS_KC), 1024, (const bf16_t*)(wl + W_CK1), 4096, 256, 2048, E, ncc ? 16 : C.G, C.bx); }
            FRESH(); wl = ws + WS_W + (size_t)l * WL_STRIDE;
            if (HAS(5) && (ncc == 0 || (C.bx >= 16 && C.bx < 32))) { EpiP<OpCmp1> E{OpCmp1{(bf16_t*)(ws + WS_HIDV), (const float*)(ws + WS_CBIAS) + l * 512 + 256}, nullptr}; run_gemm(C.lds, (const bf16_t*)(ws + WS_VC), 1024, (const bf16_t*)(wl + W_CV1), 4096, 256, 2048, E, ncc ? 16 : C.G, ncc ? C.bx - 16 : C.bx); }
        }
        SEAM();
        wl = ws + WS_W + (size_t)l * WL_STRIDE;
        if (IN_PH()) {
            FRESH();
            if (HAS(6)) ph_cmp2(C, l);
        }
        SEAM();
        if (HAS(7) && IN_PH()) ph_attn(C, 0);
        SEAM();
        wl = ws + WS_W + (size_t)l * WL_STRIDE;
        if (IN_PH()) {
            if (HAS(8)) { EpiP<OpMerge1> E{OpMerge1{ws + WS_GM, (bf16_t*)(ws + WS_GM + 64 * MiB)}, nullptr}; run_gemm(C.lds, (const bf16_t*)X, 512, (const bf16_t*)(ws + WS_PPF) + (size_t)l * 1024 * 512, MTOK, 1024, 512, E, C.G, C.bx); }
            FRESH(); wl = ws + WS_W + (size_t)l * WL_STRIDE;
            if (HAS(9)) { EpiP<OpMerge2> E{OpMerge2{ws + WS_GM, (bf16_t*)(ws + WS_GM + 64 * MiB)}, nullptr}; run_gemm(C.lds, (const bf16_t*)(ws + WS_Q), 1024, (const bf16_t*)(wl + W_PN), MTOK, 1024, 1024, E, C.G, C.bx); }
        }
        SEAM();
        wl = ws + WS_W + (size_t)l * WL_STRIDE;
        if (HAS(10) && IN_PH()) { EpiResid E{(bf16_t*)(ws + WS_XN), (float*)(ws + WS_SS)}; run_gemm(C.lds, (const bf16_t*)(ws + WS_GM + 64 * MiB), 1024, (const bf16_t*)(wl + W_OUT), MTOK, 1024, 1024, E, C.G, C.bx); }
        SEAM();
        wl = ws + WS_W + (size_t)l * WL_STRIDE;
        if (HAS(11) && IN_PH()) { EpiP<OpFF1, true> E{OpFF1{(bf16_t*)(ws + WS_H)}, (const float*)(ws + WS_SS)}; run_gemm(C.lds, (const bf16_t*)(ws + WS_XN), 1024, (const bf16_t*)(wl + W_FF1), MTOK, DFF, 1024, E, C.G, C.bx); }
        SEAM();
        wl = ws + WS_W + (size_t)l * WL_STRIDE;
        if (HAS(12) && IN_PH()) { EpiResid E{(bf16_t*)(ws + WS_XN), (float*)(ws + WS_SS)}; run_gemm(C.lds, (const bf16_t*)(ws + WS_H), 4096, (const bf16_t*)(wl + W_FF2), MTOK, 1024, DFF, E, C.G, C.bx); }
        SEAM();
    }
    if (IN_PH()) { for (int m = C.gw; m < MTOK; m += C.NGW) rms_row_out((const bf16_t*)(ws + WS_XN) + (size_t)m * 1024, AIN(a, 17), X + (size_t)m * 1024, C.lane); }
#undef IN_PH
#undef SEAM
}

#ifndef MK_PER_PHASE
#define MK_PER_PHASE 0
#endif
extern "C" void kernel_launch(void* const* d_in, const int* in_sizes, int n_in, void* d_out, int out_size, void* d_ws, size_t ws_size, hipStream_t stream) {
    static int grid = 0;
    if (grid == 0) {
        if (n_in != 18 || out_size != MTOK * DM || ws_size < WS_END) { fprintf(stderr, "kernel_launch: unexpected shapes (n_in %d out %d ws %zu)\n", n_in, out_size, ws_size); grid = -1; return; }
        int dev = 0, cus = 0, per_cu = 0;
        (void)hipGetDevice(&dev); (void)hipDeviceGetAttribute(&cus, hipDeviceAttributeMultiprocessorCount, dev);
        if (hipFuncSetAttribute((const void*)mega_fwd, hipFuncAttributeMaxDynamicSharedMemorySize, LDS_BYTES) != hipSuccess) { fprintf(stderr, "kernel_launch: hipFuncSetAttribute failed\n"); grid = -1; return; }
        if (hipOccupancyMaxActiveBlocksPerMultiprocessor(&per_cu, (const void*)mega_fwd, 512, LDS_BYTES) != hipSuccess || per_cu < 1) { fprintf(stderr, "kernel_launch: occupancy query %d\n", per_cu); per_cu = 1; }
        (void)hipGetLastError();
        grid = cus * (per_cu > 1 ? 1 : per_cu);
        if (grid <= 0) grid = 256;
    }
    if (grid < 0) return;
    Args a{};
    for (int i = 0; i < 18; ++i) a.in[i] = (const float*)d_in[i];
    a.out = (float*)d_out; a.ws = (unsigned char*)d_ws;
    for (int i = 0; i < 32; ++i) a.invf[i] = pow(10000.0, -(double)(2 * i) / 64.0);
#if MK_PER_PHASE
    for (int p = 0; p < NPHASE; ++p) { a.ph_lo = p; a.ph_hi = p + 1; hipLaunchKernelGGL(mega_fwd, dim3(grid), dim3(512), LDS_BYTES, stream, a); }
#else
    a.ph_lo = 0; a.ph_hi = NPHASE;
    (void)hipMemsetAsync((unsigned char*)d_ws + WS_BAR, 0, 16384, stream);
    void* args[] = {&a};
    hipError_t e = hipLaunchCooperativeKernel((const void*)mega_fwd, dim3(grid), dim3(512), args, LDS_BYTES, stream);
    if (e != hipSuccess) fprintf(stderr, "cooperative launch failed: %s (grid %d)\n", hipGetErrorString(e), grid);
#endif
}
```
